# Optimizing an MI355X kernel written in HIP

```python
import math
import jax, jax.numpy as jnp
from jax import lax
import numpy as np

D_MODEL = 1024
BATCH = 1
SEQ = 16384
DEPTH = 1

GRID_W = 64
MEM_LEN = 256
HEAD_DIM = 64
N_Q_HEADS = D_MODEL // HEAD_DIM
N_KV_HEADS = 4
GQA_GROUP = N_Q_HEADS // N_KV_HEADS
Q_WIDTH = N_Q_HEADS * HEAD_DIM
KV_WIDTH = N_KV_HEADS * HEAD_DIM
N_FOURIER_GROUPS = 4
FOURIER_GROUP_DIM = 128
FOURIER_WIDTH = N_FOURIER_GROUPS * FOURIER_GROUP_DIM
IN_WIDTH = Q_WIDTH + 2 * KV_WIDTH + FOURIER_WIDTH + 2 * D_MODEL
ROPE_AXIS_DIM = HEAD_DIM // 2
ROPE_THETA = 10000.0
Q_BLOCK = 128
N_CROSS_HEADS = 4
CROSS_HEAD_DIM = 64
CROSS_WIDTH = N_CROSS_HEADS * CROSS_HEAD_DIM
D_FF = 2816
RMS_EPS = 1e-6

kernel_name = "hybrid_fnet_axial_gqa_macaron_encoder"


def rmsnorm(x, g):
    xf = x.astype(jnp.float32)
    y = xf * lax.rsqrt(jnp.mean(xf * xf, axis=-1, keepdims=True) + RMS_EPS)
    return (y * g.astype(jnp.float32)).astype(x.dtype)


def swiglu(x, w_gate, w_up, w_down):
    return (jax.nn.silu(x @ w_gate) * (x @ w_up)) @ w_down


def axial_rope_tables(S, dtype):
    rows = S // GRID_W
    row = jnp.repeat(jnp.arange(rows, dtype=jnp.float32), GRID_W)
    col = jnp.tile(jnp.arange(GRID_W, dtype=jnp.float32), rows)
    inv = 1.0 / (ROPE_THETA ** (jnp.arange(0, ROPE_AXIS_DIM, 2, dtype=jnp.float32) / ROPE_AXIS_DIM))
    ang_r = row[:, None] * inv[None, :]
    ang_c = col[:, None] * inv[None, :]
    return (jnp.cos(ang_r).astype(dtype), jnp.sin(ang_r).astype(dtype),
            jnp.cos(ang_c).astype(dtype), jnp.sin(ang_c).astype(dtype))


def _rotate(x, cos, sin):
    S, F = cos.shape
    shape = (1, S) + (1,) * (x.ndim - 3) + (F,)
    c = cos.reshape(shape)
    s = sin.reshape(shape)
    x1, x2 = x[..., :F], x[..., F:]
    return jnp.concatenate([x1 * c - x2 * s, x2 * c + x1 * s], axis=-1)


def apply_axial_rope(x, tables):
    cr, sr, cc, sc = tables
    xr = _rotate(x[..., :ROPE_AXIS_DIM], cr, sr)
    xc = _rotate(x[..., ROPE_AXIS_DIM:], cc, sc)
    return jnp.concatenate([xr, xc], axis=-1)


def fourier_mixer(f):
    B, S, _ = f.shape
    fg = f.reshape(B, S, N_FOURIER_GROUPS, FOURIER_GROUP_DIM).astype(jnp.float32)
    y = jnp.real(jnp.fft.fft2(fg, axes=(1, 3), norm="ortho"))
    return y.reshape(B, S, FOURIER_WIDTH).astype(f.dtype)


def gqa_axial_attention(q, k, v, q_gain, k_gain, tables):
    B, S, _ = q.shape
    q = rmsnorm(q.reshape(B, S, N_KV_HEADS, GQA_GROUP, HEAD_DIM), q_gain)
    k = rmsnorm(k.reshape(B, S, N_KV_HEADS, HEAD_DIM), k_gain)
    v = v.reshape(B, S, N_KV_HEADS, HEAD_DIM)
    q = apply_axial_rope(q, tables)
    k = apply_axial_rope(k, tables)
    scale = 1.0 / math.sqrt(HEAD_DIM)
    nb = S // Q_BLOCK
    qb = q.reshape(B, nb, Q_BLOCK, N_KV_HEADS, GQA_GROUP, HEAD_DIM).transpose(1, 0, 2, 3, 4, 5)

    def attend(qblk):
        s = jnp.einsum('bqkgd,bskd->bkgqs', qblk, k).astype(jnp.float32) * scale
        p = jax.nn.softmax(s, axis=-1).astype(v.dtype)
        return jnp.einsum('bkgqs,bskd->bqkgd', p, v)

    o = lax.map(attend, qb)
    return o.transpose(1, 0, 2, 3, 4, 5).reshape(B, S, Q_WIDTH)


def memory_cross_attention(h_n, mem_n, w_cq, w_ck, w_cv, w_co):
    B, S, _ = h_n.shape
    M = mem_n.shape[1]
    q = (h_n @ w_cq).reshape(B, S, N_CROSS_HEADS, CROSS_HEAD_DIM)
    k = (mem_n @ w_ck).reshape(B, M, N_CROSS_HEADS, CROSS_HEAD_DIM)
    v = (mem_n @ w_cv).reshape(B, M, N_CROSS_HEADS, CROSS_HEAD_DIM)
    s = jnp.einsum('bshd,bmhd->bhsm', q, k).astype(jnp.float32) * (1.0 / math.sqrt(CROSS_HEAD_DIM))
    p = jax.nn.softmax(s, axis=-1).astype(v.dtype)
    o = jnp.einsum('bhsm,bmhd->bshd', p, v).reshape(B, S, CROSS_WIDTH)
    return o @ w_co


def setup_inputs(seed: int = 0) -> dict:
    key = jax.random.key(seed)
    ks = iter(jax.random.split(key, 32))
    f32 = jnp.float32

    def dense(shape):
        return jax.random.normal(next(ks), (DEPTH,) + shape, f32) * (shape[0] ** -0.5)

    def gain(shape):
        return 1.0 + 0.1 * jax.random.normal(next(ks), shape, f32)

    return {
        "x": jax.random.normal(next(ks), (BATCH, SEQ, D_MODEL), f32),
        "mem": jax.random.normal(next(ks), (BATCH, MEM_LEN, D_MODEL), f32),
        "g_ffn1": gain((DEPTH, D_MODEL)),
        "w1_gate": dense((D_MODEL, D_FF)),
        "w1_up": dense((D_MODEL, D_FF)),
        "w1_down": dense((D_FF, D_MODEL)),
        "g_mix": gain((DEPTH, D_MODEL)),
        "w_in": dense((D_MODEL, IN_WIDTH)),
        "q_gain": gain((DEPTH, HEAD_DIM)),
        "k_gain": gain((DEPTH, HEAD_DIM)),
        "w_fourier_branch": dense((FOURIER_WIDTH, D_MODEL)),
        "w_attn_branch": dense((Q_WIDTH, D_MODEL)),
        "w_out": dense((D_MODEL, D_MODEL)),
        "g_cross": gain((DEPTH, D_MODEL)),
        "g_mem": gain((DEPTH, D_MODEL)),
        "w_cq": dense((D_MODEL, CROSS_WIDTH)),
        "w_ck": dense((D_MODEL, CROSS_WIDTH)),
        "w_cv": dense((D_MODEL, CROSS_WIDTH)),
        "w_co": dense((CROSS_WIDTH, D_MODEL)),
        "g_ffn2": gain((DEPTH, D_MODEL)),
        "w2_gate": dense((D_MODEL, D_FF)),
        "w2_up": dense((D_MODEL, D_FF)),
        "w2_down": dense((D_FF, D_MODEL)),
        "g_final": gain((D_MODEL,)),
    }


def reference(x, mem, g_ffn1, w1_gate, w1_up, w1_down, g_mix, w_in, q_gain, k_gain,
              w_fourier_branch, w_attn_branch, w_out, g_cross, g_mem, w_cq, w_ck, w_cv,
              w_co, g_ffn2, w2_gate, w2_up, w2_down, g_final):
    S = x.shape[1]
    tables = axial_rope_tables(S, x.dtype)
    split_at = [Q_WIDTH, Q_WIDTH + KV_WIDTH, Q_WIDTH + 2 * KV_WIDTH,
                Q_WIDTH + 2 * KV_WIDTH + FOURIER_WIDTH,
                Q_WIDTH + 2 * KV_WIDTH + FOURIER_WIDTH + D_MODEL]
    h = x
    for l in range(DEPTH):
        h = h + 0.5 * swiglu(rmsnorm(h, g_ffn1[l]), w1_gate[l], w1_up[l], w1_down[l])

        n = rmsnorm(h, g_mix[l])
        p = n @ w_in[l]
        q, k, v, f, gate_f, gate_a = jnp.split(p, split_at, axis=-1)
        y_f = fourier_mixer(f) @ w_fourier_branch[l]
        y_a = gqa_axial_attention(q, k, v, q_gain[l], k_gain[l], tables) @ w_attn_branch[l]
        merged = jax.nn.sigmoid(gate_f) * y_f + jax.nn.sigmoid(gate_a) * y_a
        h = h + merged @ w_out[l]

        h = h + memory_cross_attention(rmsnorm(h, g_cross[l]), rmsnorm(mem, g_mem[l]),
                                       w_cq[l], w_ck[l], w_cv[l], w_co[l])

        h = h + 0.5 * swiglu(rmsnorm(h, g_ffn2[l]), w2_gate[l], w2_up[l], w2_down[l])
    return rmsnorm(h, g_final)
```

```cpp
#include <hip/hip_runtime.h>
#include <hip/hip_cooperative_groups.h>
#include <cstdio>
#include <cstdint>
namespace pg8 {
#define PG8_LAS __attribute__((address_space(3)))
typedef unsigned short bf16_t;
typedef short bf16x8 __attribute__((ext_vector_type(8)));
typedef float f32x4 __attribute__((ext_vector_type(4)));
typedef unsigned u32x4 __attribute__((ext_vector_type(4)));
constexpr int BM = 256, BK = 64, HALF = 128, HTB = HALF * BK * 2  , STAGE_BYTES = 8 * HTB, NXCD = 8, WGM = 8;

__host__ __device__ __forceinline__ int lds_byte(int r, int c) { const int st = (r >> 4) * 2 + (c >> 5), rr = r & 15, cc = c & 31, ob = rr * 64 + cc * 2; return st * 1024 + (ob ^ (((ob >> 9) & 1) << 5)); }
__host__ __device__ __forceinline__ void stage_rc(int b, int& R, int& C) { const int st = b / 1024, sb = b % 1024, swz = sb ^ (((sb >> 9) & 1) << 5); R = (st >> 1) * 16 + swz / 64; C = (st & 1) * 32 + (swz % 64) / 2; }
__host__ __device__ __forceinline__ int perm32(int rho) { const int n = rho >> 4, i = rho & 15; return 8 * (i >> 2) + 4 * n + (i & 3); }

struct Unit { int pm, pn; };
struct Gemm { const bf16_t* A; const bf16_t* Bt; int M, N, K; };

struct StaticOrder {
    int nM, nN, nwg, G, c;
    __host__ __device__ void init(int M, int N, int G_, int c_) { nM = M / BM; nN = N / BM; nwg = nM * nN; G = G_; c = c_; }
    __host__ __device__ bool next(int i, Unit& u) const {
        const long L = (long)i * G + c; if (L >= nwg) return false;
        int wgid = (int)L; { const int q = nwg / NXCD, r = nwg % NXCD, xcd = wgid % NXCD, off = wgid / NXCD; wgid = (xcd < r ? xcd * (q + 1) : r * (q + 1) + (xcd - r) * q) + off; }
        const int nig = WGM * nN, gid = wgid / nig, fm = gid * WGM, gsz = (nM - fm) < WGM ? (nM - fm) : WGM;
        u.pm = fm + ((wgid % nig) % gsz); u.pn = (wgid % nig) / gsz; return true;
    }
    __device__ __forceinline__ void a_ready(const Unit&) const {}
    __device__ __forceinline__ void done(const Unit&) const {}
};

__device__ __forceinline__ unsigned cvt_pk_bf16(float lo, float hi) { unsigned r; asm volatile("v_cvt_pk_bf16_f32 %0, %1, %2" : "=v"(r) : "v"(lo), "v"(hi)); return r; }
__device__ __forceinline__ float bflo(unsigned u) { return __uint_as_float(u << 16); }
__device__ __forceinline__ float bfhi(unsigned u) { return __uint_as_float(u & 0xffff0000u); }
__device__ __forceinline__ float sigmoid_f(float x) { return __builtin_amdgcn_rcpf(1.0f + __builtin_amdgcn_exp2f(-1.4426950408889634f * x)); }
__device__ __forceinline__ u32x4 pack8(const f32x4 a, const f32x4 b) { u32x4 w; w.x = cvt_pk_bf16(a[0], a[1]); w.y = cvt_pk_bf16(a[2], a[3]); w.z = cvt_pk_bf16(b[0], b[1]); w.w = cvt_pk_bf16(b[2], b[3]); return w; }
constexpr float RMS_EPS = 1e-6f;
__device__ __forceinline__ float rowscale(const float* p, int row, int mode) { const float v = p[row]; return mode ? __builtin_amdgcn_rsqf(v * (1.0f / 1024.0f) + RMS_EPS) : v; }

struct EpiSwiGLU {
    static constexpr bool PERM = true, AFTER_DRAIN = false;
    bf16_t* H; int ldh; const float* rs; int rs_mode;
    __device__ __forceinline__ void operator()(const f32x4 (&acc)[2][2][4][2], const Unit& u, int wr, int wc, int fr, int fq) const {
        const int row0 = u.pm * BM + wr * 64 + fr, col0 = u.pn * HALF + wc * 32 + 8 * fq;
#pragma unroll
        for (int ai = 0; ai < 2; ++ai)
#pragma unroll
            for (int m = 0; m < 4; ++m) {
                const int row = row0 + ai * HALF + m * 16; const float r = rowscale(rs, row, rs_mode);
                f32x4 o[2];
#pragma unroll
                for (int n = 0; n < 2; ++n) {
                    const f32x4 g = acc[ai][0][m][n] * r, up = acc[ai][1][m][n] * r;
#pragma unroll
                    for (int j = 0; j < 4; ++j) o[n][j] = g[j] * sigmoid_f(g[j]) * up[j];
                }
                *(u32x4*)(H + (size_t)row * ldh + col0) = pack8(o[0], o[1]);
            }
    }
};
struct EpiResid {
    static constexpr bool PERM = true, AFTER_DRAIN = false;
    const float* base; float* out; bf16_t* ob; float* ss; float scale; int ldc;
    __device__ __forceinline__ void operator()(const f32x4 (&acc)[2][2][4][2], const Unit& u, int wr, int wc, int fr, int fq) const {
        const int row0 = u.pm * BM + wr * 64 + fr, col0 = u.pn * BM + wc * 32 + 8 * fq;
#pragma unroll
        for (int ai = 0; ai < 2; ++ai)
#pragma unroll
            for (int m = 0; m < 4; ++m) {
                const int row = row0 + ai * HALF + m * 16; float s = 0.f;
#pragma unroll
                for (int bj = 0; bj < 2; ++bj) {
                    const size_t off = (size_t)row * ldc + col0 + bj * HALF;
                    const f32x4 b0 = *(const f32x4*)(base + off), b1 = *(const f32x4*)(base + off + 4);
                    const f32x4 o0 = b0 + acc[ai][bj][m][0] * scale, o1 = b1 + acc[ai][bj][m][1] * scale;
                    *(f32x4*)(out + off) = o0; *(f32x4*)(out + off + 4) = o1;
                    if (ob) *(u32x4*)(ob + off) = pack8(o0, o1);
                    s += (o0[0] * o0[0] + o0[1] * o0[1]) + (o0[2] * o0[2] + o0[3] * o0[3]) + (o1[0] * o1[0] + o1[1] * o1[1]) + (o1[2] * o1[2] + o1[3] * o1[3]);
                }
                if (ss) { s += __shfl_xor(s, 16); s += __shfl_xor(s, 32); if (fq == 0) atomicAdd(ss + row, s); }
            }
    }
};
struct EpiRoute {
    static constexpr bool PERM = true, AFTER_DRAIN = false;
    bf16_t* dst[6]; const float* rs; int rs_mode; int is_win;
    int ld0;
    __device__ __forceinline__ void operator()(const f32x4 (&acc)[2][2][4][2], const Unit& u, int wr, int wc, int fr, int fq) const {
        const int pn = u.pn; bf16_t* bp; int ldc, colt;
        if (!is_win) { bp = dst[0]; ldc = ld0; colt = pn * BM; }
        else if (pn < 4) { bp = dst[0]; ldc = 1024; colt = pn * BM; }
        else if (pn == 4) { bp = dst[1]; ldc = 256; colt = 0; }
        else if (pn == 5) { bp = dst[2]; ldc = 256; colt = 0; }
        else if (pn < 8) { bp = dst[3]; ldc = 512; colt = (pn - 6) * BM; }
        else if (pn < 12) { bp = dst[4]; ldc = 1024; colt = (pn - 8) * BM; }
        else { bp = dst[5]; ldc = 1024; colt = (pn - 12) * BM; }
        const int row0 = u.pm * BM + wr * 64 + fr, col0 = colt + wc * 32 + 8 * fq;
#pragma unroll
        for (int ai = 0; ai < 2; ++ai)
#pragma unroll
            for (int m = 0; m < 4; ++m) {
                const int row = row0 + ai * HALF + m * 16; const float r = rowscale(rs, row, rs_mode);
#pragma unroll
                for (int bj = 0; bj < 2; ++bj)
                    *(u32x4*)(bp + (size_t)row * ldc + col0 + bj * HALF) = pack8(acc[ai][bj][m][0] * r, acc[ai][bj][m][1] * r);
            }
    }
};
struct EpiGate {
    static constexpr bool PERM = true, AFTER_DRAIN = false;
    bf16_t* G; const bf16_t* T; int mode;
    __device__ __forceinline__ void operator()(const f32x4 (&acc)[2][2][4][2], const Unit& u, int wr, int wc, int fr, int fq) const {
        const int row0 = u.pm * BM + wr * 64 + fr, col0 = u.pn * BM + wc * 32 + 8 * fq;
#pragma unroll
        for (int ai = 0; ai < 2; ++ai)
#pragma unroll
            for (int m = 0; m < 4; ++m) {
                const int row = row0 + ai * HALF + m * 16;
#pragma unroll
                for (int bj = 0; bj < 2; ++bj) {
                    const size_t off = (size_t)row * 1024 + col0 + bj * HALF;
                    const u32x4 gv = *(const u32x4*)(G + off);
                    f32x4 g0 = {bflo(gv.x), bfhi(gv.x), bflo(gv.y), bfhi(gv.y)}, g1 = {bflo(gv.z), bfhi(gv.z), bflo(gv.w), bfhi(gv.w)};
                    f32x4 o0, o1;
#pragma unroll
                    for (int j = 0; j < 4; ++j) { o0[j] = sigmoid_f(g0[j]) * acc[ai][bj][m][0][j]; o1[j] = sigmoid_f(g1[j]) * acc[ai][bj][m][1][j]; }
                    if (mode == 2) { const u32x4 tv = *(const u32x4*)(T + off);
                        o0 += (f32x4){bflo(tv.x), bfhi(tv.x), bflo(tv.y), bfhi(tv.y)}; o1 += (f32x4){bflo(tv.z), bfhi(tv.z), bflo(tv.w), bfhi(tv.w)}; }
                    *(u32x4*)(G + off) = pack8(o0, o1);
                }
            }
    }
};
template <class Epi, class Sched, bool ALIGN_EPI = false, bool SP2 = false>
__device__ __forceinline__ void gemm_phase(PG8_LAS unsigned char* lds, const Gemm g, const Sched& S, const Epi& E) {
    const int tid = threadIdx.x, wid = __builtin_amdgcn_readfirstlane(tid >> 6), lane = tid & 63, wr = wid >> 2, wc = wid & 3, fr = lane & 15, fq = lane >> 4;
    const int K = g.K, nt = K / BK;
    unsigned voffA[2], voffB[2];
#pragma unroll
    for (int i = 0; i < 2; ++i) { int R, C; stage_rc(tid * 16 + i * 8192, R, C); const int Rb = Epi::PERM ? ((R & ~31) + perm32(R & 31)) : R;
        voffA[i] = (unsigned)(R * K + C) * 2u; voffB[i] = (unsigned)(Rb * K + C) * 2u; }
    const size_t kstep = (size_t)(BK * 2);
    const size_t hstep = (size_t)HALF * K * 2;
    const size_t tstep = 2 * hstep;
    const unsigned ldsw = (unsigned)wid * 1024u;
    const int aoff = lds_byte(wr * 64 + fr, fq * 8), boff = lds_byte(wc * 32 + fr, fq * 8);
#define PG8_SA(b, h) (((b) * 2 + (h)) * HTB)
#define PG8_SB(b, h) ((4 + (b) * 2 + (h)) * HTB)
#define PG8_STAGE(bufoff, gbase, voff) do { _Pragma("unroll") for (int _i = 0; _i < 2; ++_i) \
        __builtin_amdgcn_global_load_lds((const unsigned*)((const char*)(gbase) + (voff)[_i]), (PG8_LAS unsigned*)(lds + (bufoff) + ldsw + _i * 8192), 16, 0, 0); } while (0)
#define PG8_LDA(dst, b, h) do { _Pragma("unroll") for (int m = 0; m < 4; ++m) _Pragma("unroll") for (int k = 0; k < 2; ++k) dst[m][k] = *(const PG8_LAS bf16x8*)(lds + PG8_SA(b, h) + aoff + m * 2048 + k * 1024); } while (0)
#define PG8_LDB(dst, b, h) do { _Pragma("unroll") for (int n = 0; n < 2; ++n) _Pragma("unroll") for (int k = 0; k < 2; ++k) dst[n][k] = *(const PG8_LAS bf16x8*)(lds + PG8_SB(b, h) + boff + n * 2048 + k * 1024); } while (0)
#define PG8_MMA(ai, bj, At, Bt) do { __builtin_amdgcn_s_setprio(1); _Pragma("unroll") for (int m = 0; m < 4; ++m) _Pragma("unroll") for (int n = 0; n < 2; ++n) _Pragma("unroll") for (int k = 0; k < 2; ++k) \
        acc[ai][bj][m][n] = __builtin_amdgcn_mfma_f32_16x16x32_bf16(Bt[n][k], At[m][k], acc[ai][bj][m][n], 0, 0, 0); __builtin_amdgcn_s_setprio(0); } while (0)
#define PG8_WAIT_V(n) asm volatile("s_waitcnt vmcnt(" #n ")" ::: "memory")
#define PG8_WAIT_L(n) asm volatile("s_waitcnt lgkmcnt(" #n ")" ::: "memory")
#define PG8_BAR __builtin_amdgcn_s_barrier()
#define PG8_SCHED __builtin_amdgcn_sched_barrier(0)
    Unit cur, nxt; int ui = 0;
    if (!S.next(0, cur)) return;
    f32x4 acc[2][2][4][2];
#pragma unroll
    for (int a = 0; a < 2; ++a)
#pragma unroll
        for (int b = 0; b < 2; ++b)
#pragma unroll
            for (int m = 0; m < 4; ++m)
#pragma unroll
                for (int n = 0; n < 2; ++n) acc[a][b][m][n] = (f32x4){0.f, 0.f, 0.f, 0.f};
    bf16x8 At[4][2], B0[2][2], B1[2][2];
    const char* cA = (const char*)g.A + (size_t)cur.pm * tstep; const char* cB = (const char*)g.Bt + (size_t)cur.pn * tstep;
    S.a_ready(cur);
    if constexpr (SP2) {
        PG8_STAGE(PG8_SB(0, 0), cB, voffB); PG8_STAGE(PG8_SB(0, 1), cB + hstep, voffB); PG8_STAGE(PG8_SA(0, 0), cA, voffA); PG8_STAGE(PG8_SA(0, 1), cA + hstep, voffA);
        if (wr == 1) PG8_BAR;
        PG8_WAIT_V(2); PG8_BAR;
        PG8_STAGE(PG8_SB(1, 0), cB + kstep, voffB); PG8_STAGE(PG8_SA(1, 0), cA + kstep, voffA); PG8_STAGE(PG8_SB(1, 1), cB + hstep + kstep, voffB);
        PG8_WAIT_V(6); PG8_BAR;
    } else {
        PG8_STAGE(PG8_SB(0, 0), cB, voffB); PG8_STAGE(PG8_SA(0, 0), cA, voffA); PG8_STAGE(PG8_SB(0, 1), cB + hstep, voffB); PG8_STAGE(PG8_SA(0, 1), cA + hstep, voffA);
        if (wr == 1) PG8_BAR;
        PG8_WAIT_V(4); PG8_BAR;
        PG8_STAGE(PG8_SB(1, 0), cB + kstep, voffB); PG8_STAGE(PG8_SA(1, 0), cA + kstep, voffA); PG8_STAGE(PG8_SB(1, 1), cB + hstep + kstep, voffB);
        PG8_WAIT_V(6); PG8_BAR;
    }
    for (;;) {
        const bool has_next = S.next(ui + 1, nxt);
        const char* nA = has_next ? (const char*)g.A + (size_t)nxt.pm * tstep : cA; const char* nB = has_next ? (const char*)g.Bt + (size_t)nxt.pn * tstep : cB;
        for (int t = 0; t < nt; t += 2) {
            const bool last = (t == nt - 2);
            const char* a1 = cA + (size_t)(t + 1) * kstep;
            const char* a2 = last ? nA : cA + (size_t)(t + 2) * kstep; const char* b2 = last ? nB : cB + (size_t)(t + 2) * kstep;
            const char* a3 = a2 + kstep; const char* b3 = b2 + kstep;
            if (last && has_next) S.a_ready(nxt);
            if constexpr (SP2) {
            PG8_LDB(B0, 0, 0); PG8_LDB(B1, 0, 1); PG8_SCHED; PG8_LDA(At, 0, 0); PG8_STAGE(PG8_SA(1, 1), a1 + hstep, voffA);
            PG8_WAIT_V(8); PG8_WAIT_L(0); PG8_BAR; PG8_MMA(0, 0, At, B0); PG8_MMA(0, 1, At, B1); PG8_BAR; PG8_SCHED;
            PG8_LDA(At, 0, 1); PG8_STAGE(PG8_SB(0, 0), b2, voffB); PG8_STAGE(PG8_SB(0, 1), b2 + hstep, voffB); PG8_STAGE(PG8_SA(0, 0), a2, voffA);
            PG8_WAIT_V(8); PG8_WAIT_L(0); PG8_BAR; PG8_MMA(1, 0, At, B0); PG8_MMA(1, 1, At, B1); PG8_BAR; PG8_SCHED;
            PG8_LDB(B0, 1, 0); PG8_LDB(B1, 1, 1); PG8_SCHED; PG8_LDA(At, 1, 0); PG8_STAGE(PG8_SA(0, 1), a2 + hstep, voffA);
            PG8_WAIT_V(8); PG8_WAIT_L(0); PG8_BAR; PG8_MMA(0, 0, At, B0); PG8_MMA(0, 1, At, B1); PG8_BAR; PG8_SCHED;
            PG8_LDA(At, 1, 1); PG8_STAGE(PG8_SB(1, 0), b3, voffB); PG8_STAGE(PG8_SB(1, 1), b3 + hstep, voffB); PG8_STAGE(PG8_SA(1, 0), a3, voffA);
            PG8_WAIT_V(8); PG8_WAIT_L(0); PG8_BAR; PG8_MMA(1, 0, At, B0); PG8_MMA(1, 1, At, B1); PG8_BAR; PG8_SCHED;
            } else {
            PG8_LDB(B0, 0, 0); PG8_SCHED; PG8_LDA(At, 0, 0); PG8_STAGE(PG8_SA(1, 1), a1 + hstep, voffA);
            PG8_WAIT_L(8); PG8_BAR; PG8_WAIT_L(0); PG8_MMA(0, 0, At, B0); PG8_BAR; PG8_SCHED;
            PG8_LDB(B1, 0, 1); PG8_STAGE(PG8_SB(0, 0), b2, voffB);
            PG8_BAR; PG8_WAIT_L(0); PG8_MMA(0, 1, At, B1); PG8_BAR;
            PG8_LDA(At, 0, 1); PG8_STAGE(PG8_SA(0, 0), a2, voffA);
            PG8_BAR; PG8_WAIT_L(0); PG8_MMA(1, 0, At, B0); PG8_BAR; PG8_SCHED;
            PG8_STAGE(PG8_SB(0, 1), b2 + hstep, voffB);
            PG8_WAIT_V(6); PG8_BAR; PG8_MMA(1, 1, At, B1); PG8_BAR;
            PG8_LDB(B0, 1, 0); PG8_SCHED; PG8_LDA(At, 1, 0); PG8_STAGE(PG8_SA(0, 1), a2 + hstep, voffA);
            PG8_WAIT_L(8); PG8_BAR; PG8_WAIT_L(0); PG8_MMA(0, 0, At, B0); PG8_BAR; PG8_SCHED;
            PG8_LDB(B1, 1, 1); PG8_STAGE(PG8_SB(1, 0), b3, voffB);
            PG8_BAR; PG8_WAIT_L(0); PG8_MMA(0, 1, At, B1); PG8_BAR;
            PG8_LDA(At, 1, 1); PG8_STAGE(PG8_SA(1, 0), a3, voffA);
            PG8_BAR; PG8_WAIT_L(0); PG8_MMA(1, 0, At, B0); PG8_BAR; PG8_SCHED;
            PG8_STAGE(PG8_SB(1, 1), b3 + hstep, voffB);
            PG8_WAIT_V(6); PG8_BAR; PG8_MMA(1, 1, At, B1); PG8_BAR;
            }
        }
        if constexpr (ALIGN_EPI) { if (wr == 0) PG8_BAR; }
        if constexpr (!Epi::AFTER_DRAIN) { E(acc, cur, wr, wc, fr, fq); S.done(cur); }
        if (!has_next) break;
#pragma unroll
        for (int a = 0; a < 2; ++a)
#pragma unroll
            for (int b = 0; b < 2; ++b)
#pragma unroll
                for (int m = 0; m < 4; ++m)
#pragma unroll
                    for (int n = 0; n < 2; ++n) acc[a][b][m][n] = (f32x4){0.f, 0.f, 0.f, 0.f};
        cur = nxt; cA = nA; cB = nB; ++ui;
        if constexpr (ALIGN_EPI) { if (wr == 1) PG8_BAR; }
    }
    PG8_WAIT_V(0);
    if constexpr (!ALIGN_EPI) { if (wr == 0) PG8_BAR; }
    PG8_BAR;
    if constexpr (Epi::AFTER_DRAIN) { E.fused(acc, cur, wr, wc, fr, fq, lds, wid, lane); S.done(cur); }
#undef PG8_SA
#undef PG8_SB
#undef PG8_STAGE
#undef PG8_LDA
#undef PG8_LDB
#undef PG8_MMA
#undef PG8_WAIT_V
#undef PG8_WAIT_L
#undef PG8_BAR
#undef PG8_SCHED
}
}
#include <hip/hip_bf16.h>
#include <cmath>
namespace attn_body {
using bf16=__hip_bfloat16;
using bf16x8=__attribute__((ext_vector_type(8)))short;
using s16x4=__attribute__((ext_vector_type(4)))short;
using f32x16=__attribute__((ext_vector_type(16)))float;
using u32x4=__attribute__((ext_vector_type(4)))unsigned;
constexpr int BATCH=1,NHEAD=16,SEQ=16384,D=64,DM=NHEAD*D,KVP=256,GQA=4;
constexpr int NW=8,QBLK=32,QB=QBLK*NW,KVBLK=64,NQB=SEQ/QB;
constexpr int ATTN_PITCH=DM, ATTN_UNIT_ROWS=QB;
__device__ __forceinline__ int crow(int r,int hi){return (r&3)+8*(r>>2)+4*hi;}
#define SBAR() __builtin_amdgcn_sched_barrier(0)
__device__ __forceinline__ void cmask(f32x16&p0,f32x16&p1,int jb,int qrel,int hi){
  const float NEG=-INFINITY; int kb=64*jb+4*hi;
  #pragma unroll
  for(int r=0;r<16;++r){int kv=kb+(r&3)+8*(r>>2); if(kv>qrel)p0[r]=NEG; if(kv+32>qrel)p1[r]=NEG;}
}

constexpr int NSLOT=3, SLOTB=8192;
constexpr int LDS_K=0, LDS_V=NSLOT*SLOTB, LDS_WS=2*NSLOT*SLOTB, LDS_OST=LDS_WS+NW*64*4, LDS_BYTES=LDS_OST+NW*4096;
constexpr float C2=0.125f*1.4426950408889634f;
__device__ __forceinline__ void glds16(const void*gsrc,unsigned lds_dst){unsigned keep;
  asm volatile("s_mov_b32 %0, m0\n\ts_mov_b32 m0, %2\n\ts_nop 0\n\tglobal_load_lds_dwordx4 %1, off\n\ts_mov_b32 m0, %0":"=&s"(keep):"v"(gsrc),"s"(lds_dst):"memory");}
__device__ __forceinline__ float max3f(float a,float b,float c){float r;asm("v_max3_f32 %0, %1, %2, %3":"=v"(r):"v"(a),"v"(b),"v"(c));return r;}
__device__ __forceinline__ float max2f(float a,float b){float r;asm("v_max_f32_e32 %0, %1, %2":"=v"(r):"v"(a),"v"(b));return r;}
__device__ __forceinline__ float fadd_s(float a,float b){float r;asm("v_add_f32_e32 %0, %1, %2":"=v"(r):"v"(a),"v"(b));return r;}
__device__ __forceinline__ float fsub_s(float a,float b){float r;asm("v_sub_f32_e32 %0, %1, %2":"=v"(r):"v"(a),"v"(b));return r;}
typedef float f32x2_t __attribute__((ext_vector_type(2))); typedef __bf16 bf16x2_t __attribute__((ext_vector_type(2)));
__device__ __forceinline__ unsigned cvtpk_s(float lo,float hi){f32x2_t v={lo,hi};bf16x2_t b=__builtin_convertvector(v,bf16x2_t);return __builtin_bit_cast(unsigned,b);}
#define WAIT_BAR(N) asm volatile("s_waitcnt vmcnt(" #N ") lgkmcnt(0)\n\ts_barrier":::"memory")

__device__ __forceinline__ void qkt(f32x16&p0,f32x16&p1,const char*Kslot,const bf16x8*qr,const f32x16&negm,int r32,int hi){
  const char*kb=Kslot+hi*1024+r32*16;
  #pragma unroll
  for(int d0=0;d0<4;++d0){
    const bf16x8 b0=*reinterpret_cast<const bf16x8*>(kb+d0*2048);
    const bf16x8 b1=*reinterpret_cast<const bf16x8*>(kb+d0*2048+512);
    if(d0==0){p0=__builtin_amdgcn_mfma_f32_32x32x16_bf16(b0,qr[0],negm,0,0,0);p1=__builtin_amdgcn_mfma_f32_32x32x16_bf16(b1,qr[0],negm,0,0,0);}
    else{p0=__builtin_amdgcn_mfma_f32_32x32x16_bf16(b0,qr[d0],p0,0,0,0);p1=__builtin_amdgcn_mfma_f32_32x32x16_bf16(b1,qr[d0],p1,0,0,0);}}
}
typedef __attribute__((address_space(3))) const char* lds_cptr;
typedef short v4i16_t __attribute__((ext_vector_type(4)));
__device__ __forceinline__ void kload8(bf16x8*kf,lds_cptr kp){
  kf[0]=*(const __attribute__((address_space(3))) bf16x8*)(kp);      kf[1]=*(const __attribute__((address_space(3))) bf16x8*)(kp+512);
  kf[2]=*(const __attribute__((address_space(3))) bf16x8*)(kp+2048); kf[3]=*(const __attribute__((address_space(3))) bf16x8*)(kp+2560);
  kf[4]=*(const __attribute__((address_space(3))) bf16x8*)(kp+4096); kf[5]=*(const __attribute__((address_space(3))) bf16x8*)(kp+4608);
  kf[6]=*(const __attribute__((address_space(3))) bf16x8*)(kp+6144); kf[7]=*(const __attribute__((address_space(3))) bf16x8*)(kp+6656);
}
__device__ __forceinline__ void kload2(bf16x8*kf,lds_cptr kp,int j){ kf[2*j]=*(const __attribute__((address_space(3))) bf16x8*)(kp+j*2048); kf[2*j+1]=*(const __attribute__((address_space(3))) bf16x8*)(kp+j*2048+512); }
__device__ __forceinline__ s16x4 vtr(lds_cptr p){ return __builtin_bit_cast(s16x4,__builtin_amdgcn_ds_read_tr16_b64_v4i16((__attribute__((address_space(3))) v4i16_t*)p)); }
__device__ __forceinline__ float rowmax(const f32x16&p0,const f32x16&p1){
  float a=max3f(p0[0],p0[1],p1[0]),b=max3f(p0[2],p0[3],p1[1]);a=max3f(a,p1[2],p1[3]);
  #pragma unroll
  for(int r=4;r<16;r+=4){a=max3f(a,p0[r],p0[r+1]);b=max3f(b,p0[r+2],p0[r+3]);a=max3f(a,p1[r],p1[r+1]);b=max3f(b,p1[r+2],p1[r+3]);}
  const float m=max2f(a,b);
  auto rr=__builtin_amdgcn_permlane32_swap(__float_as_uint(m),__float_as_uint(m),false,false);
  return max2f(__uint_as_float(rr[0]),__uint_as_float(rr[1]));
}
__device__ __forceinline__ void pv(f32x16*o,int vb,bf16x8 pa0,bf16x8 pa1,bf16x8 pa2,bf16x8 pa3){
  #pragma unroll
  for(int d0=0;d0<2;++d0){s16x4 lo[4],hi[4];
    #pragma unroll
    for(int ks=0;ks<4;++ks){
      asm volatile("ds_read_b64_tr_b16 %0,%1 offset:%c2":"=&v"(lo[ks]):"v"(vb),"i"(d0*4096+ks*1024):"memory");
      asm volatile("ds_read_b64_tr_b16 %0,%1 offset:%c2":"=&v"(hi[ks]):"v"(vb),"i"(d0*4096+ks*1024+512):"memory");}
    asm volatile("s_waitcnt lgkmcnt(0)":::"memory");SBAR();
    #define PK(k) (bf16x8){lo[k][0],lo[k][1],lo[k][2],lo[k][3],hi[k][0],hi[k][1],hi[k][2],hi[k][3]}
    o[d0]=__builtin_amdgcn_mfma_f32_32x32x16_bf16(pa0,PK(0),o[d0],0,0,0);
    o[d0]=__builtin_amdgcn_mfma_f32_32x32x16_bf16(pa1,PK(1),o[d0],0,0,0);
    o[d0]=__builtin_amdgcn_mfma_f32_32x32x16_bf16(pa2,PK(2),o[d0],0,0,0);
    o[d0]=__builtin_amdgcn_mfma_f32_32x32x16_bf16(pa3,PK(3),o[d0],0,0,0);
    #undef PK
  }
}

#ifndef ATTN_STORE16
#define ATTN_STORE16(p,v) (*(u32x4*)(p)=(v))
#endif
template<int THRL> __device__ __forceinline__ void attn_unit(int b,int h,int qb,const bf16*Q,const bf16*__restrict__ K,const bf16*__restrict__ V,bf16*O,char*shm){
  const int tid=threadIdx.x,lane=tid&63,r32=lane&31,hi=lane>>5; const int wid=__builtin_amdgcn_readfirstlane(tid>>6);
  const long rowbase=(long)b*SEQ; const int q0=qb*QB;
  const bf16*Qw=Q+(rowbase+q0+wid*QBLK)*DM+h*D;
  const bf16*Kh=K+rowbase*KVP+(h/GQA)*D,*Vh=V+rowbase*KVP+(h/GQA)*D;
  const unsigned lds0=(unsigned)(uintptr_t)shm;
  float*wsf=(float*)(shm+LDS_WS)+wid*64;
  const bf16*ksrc=Kh+(long)lane*KVP+wid*8;
  const bf16*vsrc=Vh+(long)(16*(wid&3)+(lane>>2))*KVP+(wid>>2)*32+(lane&3)*8;
  const unsigned kdst=lds0+LDS_K+wid*1024, vdst=lds0+LDS_V+wid*1024;
  #define DMA_K(t,slot) glds16(ksrc+(long)(t)*KVBLK*KVP,(unsigned)__builtin_amdgcn_readfirstlane(kdst+(slot)))
  #define DMA_V(t,slot) glds16(vsrc+(long)(t)*KVBLK*KVP,(unsigned)__builtin_amdgcn_readfirstlane(vdst+(slot)))
  const int vb0=(int)(lds0+LDS_V)+((lane>>4)&1)*32+(lane&3)*8+(4*hi+((lane&15)>>2))*64;
  const char*Kbase=shm+LDS_K; bf16x8 kf[8];
  const lds_cptr shm3=(lds_cptr)shm; const lds_cptr kp0=shm3+LDS_K+hi*1024+r32*16; const lds_cptr vp0=shm3+LDS_V+((lane>>4)&1)*32+(lane&3)*8+(4*hi+((lane&15)>>2))*64;
  const int NT=SEQ/KVBLK;
  DMA_K(0,0);DMA_V(0,0);DMA_K(1,SLOTB);
  bf16x8 qr[4];
  #pragma unroll
  for(int d0=0;d0<4;++d0)qr[d0]=*reinterpret_cast<const bf16x8*>(&Qw[(long)r32*DM+d0*16+hi*8]);
  float mhat=0.f,l_reg=0.f;f32x16 o[2];o[0]=f32x16{};o[1]=f32x16{};f32x16 negm=f32x16{};asm volatile("":"+v"(negm));
  const int qrel=wid*QBLK+r32;
  #define CMASK(P0,P1,t) do{}while(0)
  bool resc=false;
  #define START(P0,P1) do{ const float rm=rowmax(P0,P1); resc=false; \
    { const float dl=rm; mhat=fadd_s(mhat,dl); \
      _Pragma("unroll") for(int r=0;r<16;++r){P0[r]=fsub_s(P0[r],dl);P1[r]=fsub_s(P1[r],dl);} \
      _Pragma("unroll") for(int r=0;r<16;++r)negm[r]=-mhat; asm volatile("":"+v"(negm)); } \
    _Pragma("unroll") for(int r=0;r<16;++r)P0[r]=__builtin_amdgcn_exp2f(P0[r]); }while(0)
  #define RESC() do{ if(resc){ asm volatile("s_waitcnt lgkmcnt(0)":::"memory"); \
      _Pragma("unroll") for(int d_=0;d_<2;++d_) _Pragma("unroll") for(int r=0;r<16;++r)o[d_][r]*=wsf[crow(r,hi)]; } }while(0)
  f32x16 pA0,pA1,pB0,pB1;
  int sl_prev=0,sl_cur=0,sl_next=SLOTB;
  #define ROT() do{sl_prev=sl_cur;sl_cur=sl_next;sl_next=(sl_next==(NSLOT-1)*SLOTB)?0:sl_next+SLOTB;}while(0)
  DMA_K(2,2*SLOTB);
  WAIT_BAR(3);
  qkt(pA0,pA1,Kbase,qr,negm,r32,hi);asm volatile("s_nop 15\n\ts_nop 7":"+v"(pA0),"+v"(pA1));CMASK(pA0,pA1,0);
  START(pA0,pA1);
  _Pragma("unroll") for(int r=0;r<16;++r)pA1[r]=__builtin_amdgcn_exp2f(pA1[r]);
  WAIT_BAR(0);
  DMA_K(3,0);DMA_V(1,SLOTB);
  ROT();
  kload8(kf,kp0+sl_cur);
  WAIT_BAR(2);
  s16x4 vlo[8],vhi[8]; u32x4 pw0,pw1,pw2,pw3;
  #define PKW(P,B) cvtpk_s(P[B],P[B+1])
  #define PAF(k) __builtin_bit_cast(bf16x8,pw##k)
  #define VFR(i) (bf16x8){vlo[i][0],vlo[i][1],vlo[i][2],vlo[i][3],vhi[i][0],vhi[i][1],vhi[i][2],vhi[i][3]}
  #define PIN(x) asm volatile("":"+v"(x))
  #define MX3(a,b,c) __builtin_fmaxf(__builtin_fmaxf((a),(b)),(c))
  #define GAPA(MF,A0,A1,A2,A3,W0,W1,PW) do{ MF; sacc+=A0; sacc+=A1; sacc+=A2; sacc+=A3; PIN(sacc); W0; W1; PIN(PW); SBAR(); }while(0)
  #define EX(v) __builtin_amdgcn_exp2f(v)
  #define GAPB(MF,X,B) do{ MF; X[B]=EX(X[B]); X[B+1]=EX(X[B+1]); X[B+2]=EX(X[B+2]); X[B+3]=EX(X[B+3]); PIN(X); SBAR(); }while(0)
  #define VRD(i) do{ vlo[i]=vtr(vp_+(((i)>>2)*4096+((i)&3)*1024)); vhi[i]=vtr(vp_+(((i)>>2)*4096+((i)&3)*1024+512)); }while(0)
  #define KRD(G,j) do{ if(G){ kload2(kf,kp0+sl_next,j); SBAR(); } }while(0)
  #define STEP(C0,C1,P0,P1,t,GK,GV,GL) do{ SBAR(); \
    const lds_cptr vp_=vp0+sl_prev; \
    VRD(0); SBAR(); float sacc=(P0[0]+P0[1]); \
    GAPA(C0=__builtin_amdgcn_mfma_f32_32x32x16_bf16(kf[0],qr[0],negm,0,0,0), P0[2],P0[3],P0[4],P0[5],     pw0[0]=PKW(P0,0), pw0[1]=PKW(P0,2), pw0); \
    VRD(4); SBAR(); GAPA(C1=__builtin_amdgcn_mfma_f32_32x32x16_bf16(kf[1],qr[0],negm,0,0,0), P0[6],P0[7],P0[8],P0[9],     pw0[2]=PKW(P0,4), pw0[3]=PKW(P0,6), pw0); \
    VRD(1); SBAR(); GAPA(C0=__builtin_amdgcn_mfma_f32_32x32x16_bf16(kf[2],qr[1],C0,0,0,0),   P0[10],P0[11],P0[12],P0[13], pw1[0]=PKW(P0,8), pw1[1]=PKW(P0,10), pw1); \
    VRD(5); SBAR(); GAPA(C1=__builtin_amdgcn_mfma_f32_32x32x16_bf16(kf[3],qr[1],C1,0,0,0),   P0[14],P0[15],P1[0],P1[1],   pw1[2]=PKW(P0,12),pw1[3]=PKW(P0,14), pw1); \
    VRD(2); SBAR(); GAPA(C0=__builtin_amdgcn_mfma_f32_32x32x16_bf16(kf[4],qr[2],C0,0,0,0),   P1[2],P1[3],P1[4],P1[5],     pw2[0]=PKW(P1,0), pw2[1]=PKW(P1,2), pw2); \
    VRD(6); SBAR(); GAPA(C1=__builtin_amdgcn_mfma_f32_32x32x16_bf16(kf[5],qr[2],C1,0,0,0),   P1[6],P1[7],P1[8],P1[9],     pw2[2]=PKW(P1,4), pw2[3]=PKW(P1,6), pw2); \
    VRD(3); SBAR(); GAPA(C0=__builtin_amdgcn_mfma_f32_32x32x16_bf16(kf[6],qr[3],C0,0,0,0),   P1[10],P1[11],P1[12],P1[13], pw3[0]=PKW(P1,8), pw3[1]=PKW(P1,10), pw3); \
    VRD(7); SBAR(); GAPA(C1=__builtin_amdgcn_mfma_f32_32x32x16_bf16(kf[7],qr[3],C1,0,0,0),   P1[14],P1[15],0.f,0.f,       pw3[2]=PKW(P1,12),pw3[3]=PKW(P1,14), pw3); \
    l_reg+=sacc; \
    if(GK){DMA_K((t)+3,sl_cur);} if(GV){DMA_V((t)+1,sl_next);} \
    CMASK(C0,C1,t); \
    { float a=MX3(C0[0],C0[1],C1[0]),b=MX3(C0[2],C0[3],C1[1]); a=MX3(a,C1[2],C1[3]); \
      _Pragma("unroll") for(int r=4;r<16;r+=4){a=MX3(a,C0[r],C0[r+1]);b=MX3(b,C0[r+2],C0[r+3]);a=MX3(a,C1[r],C1[r+1]);b=MX3(b,C1[r+2],C1[r+3]);} \
      float rm=__builtin_fmaxf(a,b); { auto rr=__builtin_amdgcn_permlane32_swap(__float_as_uint(rm),__float_as_uint(rm),false,false); rm=__builtin_fmaxf(__uint_as_float(rr[0]),__uint_as_float(rr[1])); } \
      resc=false; \
      if(__builtin_expect(__any(rm>(float)THRL),0)){ const float dl=__builtin_fmaxf(rm,0.f); mhat+=dl; \
        _Pragma("unroll") for(int r=0;r<16;++r){C0[r]-=dl;C1[r]-=dl;} \
        _Pragma("unroll") for(int r=0;r<16;++r)negm[r]=-mhat; asm volatile("":"+v"(negm)); \
        const float f=__builtin_amdgcn_exp2f(-dl); l_reg*=f; if(hi==0)wsf[r32]=f; resc=true; } } \
    SBAR(); \
    GAPB(o[0]=__builtin_amdgcn_mfma_f32_32x32x16_bf16(PAF(0),VFR(0),o[0],0,0,0), C0,0); \
    GAPB(o[1]=__builtin_amdgcn_mfma_f32_32x32x16_bf16(PAF(0),VFR(4),o[1],0,0,0), C0,4); \
    KRD(GL,0); GAPB(o[0]=__builtin_amdgcn_mfma_f32_32x32x16_bf16(PAF(1),VFR(1),o[0],0,0,0), C0,8); \
    KRD(GL,1); GAPB(o[1]=__builtin_amdgcn_mfma_f32_32x32x16_bf16(PAF(1),VFR(5),o[1],0,0,0), C0,12); \
    KRD(GL,2); GAPB(o[0]=__builtin_amdgcn_mfma_f32_32x32x16_bf16(PAF(2),VFR(2),o[0],0,0,0), C1,0); \
    KRD(GL,3); GAPB(o[1]=__builtin_amdgcn_mfma_f32_32x32x16_bf16(PAF(2),VFR(6),o[1],0,0,0), C1,4); \
    GAPB(o[0]=__builtin_amdgcn_mfma_f32_32x32x16_bf16(PAF(3),VFR(3),o[0],0,0,0), C1,8); \
    GAPB(o[1]=__builtin_amdgcn_mfma_f32_32x32x16_bf16(PAF(3),VFR(7),o[1],0,0,0), C1,12); \
    }while(0)
  int t=1;
  #undef CMASK
  #define CMASK(P0,P1,t) do{}while(0)
  for(;t+5<NT;t+=2){
    STEP(pB0,pB1,pA0,pA1,t,true,true,true);     WAIT_BAR(2); RESC(); ROT();
    STEP(pA0,pA1,pB0,pB1,t+1,true,true,true);   WAIT_BAR(2); RESC(); ROT();
  }
  #undef CMASK
  #define CMASK(P0,P1,t) do{}while(0)
  #define ENDW(tt) do{ if((tt)+3<NT){WAIT_BAR(2);} else if((tt)+2<NT){WAIT_BAR(1);} else {WAIT_BAR(0);} }while(0)
  for(;t+1<NT;t+=2){
    STEP(pB0,pB1,pA0,pA1,t,(t+3<NT),(t+1<NT),(t+1<NT));       ENDW(t);   RESC(); ROT();
    STEP(pA0,pA1,pB0,pB1,t+1,(t+4<NT),(t+2<NT),(t+2<NT));     ENDW(t+1); RESC(); ROT();
  }
  STEP(pB0,pB1,pA0,pA1,NT-1,false,false,false); RESC();
  { float sacc=pB0[0]+pB0[1]; _Pragma("unroll") for(int r=2;r<16;++r)sacc+=pB0[r]; _Pragma("unroll") for(int r=0;r<16;++r)sacc+=pB1[r]; l_reg+=sacc;
    pw0=(u32x4){PKW(pB0,0),PKW(pB0,2),PKW(pB0,4),PKW(pB0,6)};pw1=(u32x4){PKW(pB0,8),PKW(pB0,10),PKW(pB0,12),PKW(pB0,14)};pw2=(u32x4){PKW(pB1,0),PKW(pB1,2),PKW(pB1,4),PKW(pB1,6)};pw3=(u32x4){PKW(pB1,8),PKW(pB1,10),PKW(pB1,12),PKW(pB1,14)};
    SBAR(); pv(o,vb0+sl_cur,PAF(0),PAF(1),PAF(2),PAF(3)); }
  #undef PKW
  #undef PAF
  #undef VFR
  #undef PIN
  #undef MX3
  #undef GAPA
  #undef GAPB
  #undef EX
  #undef VRD
  #undef KRD
  #undef STEP
  #undef ENDW
  {auto rr=__builtin_amdgcn_permlane32_swap(__float_as_uint(l_reg),__float_as_uint(l_reg),false,false);l_reg=__uint_as_float(rr[0])+__uint_as_float(rr[1]);}
  if(hi==0)wsf[32+r32]=l_reg;asm volatile("s_waitcnt lgkmcnt(0)":::"memory");
  float rli[16];
  #pragma unroll
  for(int r=0;r<16;++r)rli[r]=__builtin_amdgcn_rcpf(wsf[32+crow(r,hi)]);
  bf16*Ow=O+(rowbase+q0+wid*QBLK)*DM+h*D;
  { bf16*stg=(bf16*)(shm+LDS_OST)+wid*2048;
    #pragma unroll
    for(int r=0;r<16;++r){const int orow=crow(r,hi);
      #pragma unroll
      for(int d0=0;d0<2;++d0)stg[orow*64+d0*32+r32]=__float2bfloat16(o[d0][r]*rli[r]);}
    asm volatile("s_waitcnt lgkmcnt(0)":::"memory");
    #pragma unroll
    for(int i=0;i<4;++i){const int row=i*8+(lane>>3),ch=lane&7; const u32x4 v=*(const u32x4*)(stg+row*64+ch*8); ATTN_STORE16(Ow+(long)row*DM+ch*8,v);} }
  asm volatile("s_waitcnt lgkmcnt(0)\n\ts_barrier":::"memory");
  #undef DMA_K
  #undef DMA_V
  #undef CMASK
  #undef START
  #undef RESC
  #undef ROT
}
constexpr int ATTN_LDS_BYTES=LDS_BYTES;
struct AttnTensors { const bf16* Q; const bf16* K; const bf16* V; bf16* O; };
struct AttnUnit { int bh; int qb; };
struct StaticOrder {
  int vcu;
  __device__ __forceinline__ explicit StaticOrder(int grid,int block):vcu((block%8)*(grid/8)+block/8){}
  __device__ __forceinline__ bool next(int i,AttnUnit&u)const{ if(i>=4)return false; const int x=vcu>>5,c=vcu&31,idx=32*i+c; u.bh=2*x+(idx>>6); u.qb=idx&63; return true; }
  __device__ __forceinline__ void a_ready(const AttnUnit&)const{}
  __device__ __forceinline__ void done(const AttnUnit&)const{}
};
template<class Sched,int THRL=8> __device__ __forceinline__ void attn_phase(char*lds,const AttnTensors&T,const Sched&S){
  AttnUnit u;
  for(int i=0;S.next(i,u);++i){ S.a_ready(u); attn_unit<THRL>(u.bh/NHEAD,u.bh%NHEAD,u.qb,T.Q,T.K,T.V,T.O,lds); S.done(u); }
}
#undef SBAR
#undef WAIT_BAR
}
constexpr int NWAVES = 8;
constexpr int M = 16384, D = 1024, FF = 2816, NIN = 4096, MEMLEN = 256, NCH = 512;
constexpr float C2Q = 0.125f * 1.4426950408889634f;
constexpr size_t MiB = 1u << 20, KiB = 1u << 10;
constexpr size_t WS_CTL = 0, CTL_ZERO_BYTES = 1 * MiB;
constexpr size_t WS_SS2 = 256 * KiB, WS_SS3 = 320 * KiB, WS_SS4 = 384 * KiB, WS_SS5 = 448 * KiB;
constexpr size_t WS_SMALL = 1 * MiB;
constexpr size_t WS_RS1 = WS_SMALL, WS_ROPE = WS_SMALL + 64 * KiB, WS_DFT = WS_SMALL + 112 * KiB, WS_TW = WS_SMALL + 128 * KiB, WS_KC = WS_SMALL + 256 * KiB, WS_VC = WS_SMALL + 384 * KiB;
constexpr size_t WS_W1GU = 2 * MiB, WS_W1D = 13 * MiB, WS_W2GU = 18 * MiB + 512 * KiB, WS_W2D = 29 * MiB + 512 * KiB, WS_WIN = 35 * MiB, WS_WFB = 43 * MiB, WS_WAB = 45 * MiB, WS_WOUT = 47 * MiB,
                 WS_WCQ = 49 * MiB, WS_WCO = 49 * MiB + 512 * KiB;
constexpr size_t WS_HB16 = 56 * MiB;
constexpr size_t WS_R1 = 88 * MiB;
constexpr size_t WS_QO = WS_R1, WS_U = WS_R1 + 32 * MiB, WS_KR = WS_R1 + 64 * MiB, WS_VR = WS_R1 + 72 * MiB, WS_F = WS_R1 + 80 * MiB;
constexpr size_t WS_QC = WS_R1, WS_OC = WS_R1 + 8 * MiB;
constexpr size_t WS_GF = 184 * MiB, WS_GA = 216 * MiB, WS_END = 248 * MiB;
static_assert(WS_W1GU + (size_t)2 * FF * D * 2 == WS_W1D && WS_W1D + (size_t)D * FF * 2 == WS_W2GU && WS_W2GU + (size_t)2 * FF * D * 2 == WS_W2D && WS_W2D + (size_t)D * FF * 2 == WS_WIN, "weights map");
static_assert(WS_R1 + (size_t)M * FF * 2 <= WS_GF && WS_F + (size_t)M * NCH * 2 <= WS_GF, "R1 map");
constexpr int CW_BAR = 4096;
constexpr int RING_BYTES = 131072, LDSCTL_OFF = RING_BYTES, MISC_OFF = LDSCTL_OFF + 320, LDS_BYTES = 147456;

#define GAS __attribute__((address_space(1)))
#define LAS __attribute__((address_space(3)))
typedef unsigned short bf16;
typedef unsigned v4u __attribute__((ext_vector_type(4)));
typedef float f32x4 __attribute__((ext_vector_type(4)));
typedef float f32x2 __attribute__((ext_vector_type(2)));
#define LDS_WAIT() asm volatile("s_waitcnt lgkmcnt(0)" ::: "memory")
#define VM_WAIT() asm volatile("s_waitcnt vmcnt(0)" ::: "memory")
__device__ __forceinline__ unsigned f2bf(float f) { unsigned u = __builtin_bit_cast(unsigned, f); return (u + 0x7fffu + ((u >> 16) & 1u)) >> 16; }
__device__ __forceinline__ unsigned pk2(float lo, float hi) { return f2bf(lo) | (f2bf(hi) << 16); }
__device__ __forceinline__ float bf2f(unsigned short b) { return __uint_as_float((unsigned)b << 16); }
__device__ __forceinline__ float bflo_(unsigned u) { return __uint_as_float(u << 16); }
__device__ __forceinline__ float bfhi_(unsigned u) { return __uint_as_float(u & 0xffff0000u); }
constexpr float RMS_EPSF = 1e-6f;
__device__ __forceinline__ float wave_sum(float v) {
#pragma unroll
    for (int o = 1; o < 64; o <<= 1) v += __shfl_xor(v, o);
    return v;
}
__device__ __forceinline__ void sincos_rev(double x, float& s, float& c) {
    x -= __builtin_floor(x);
    const double q = __builtin_rint(x * 4.0);
    const double r = (x - q * 0.25) * 6.283185307179586476925;
    const double r2 = r * r;
    double sp = 1.0 / 6227020800.0; sp = sp * r2 - 1.0 / 39916800.0; sp = sp * r2 + 1.0 / 362880.0; sp = sp * r2 - 1.0 / 5040.0; sp = sp * r2 + 1.0 / 120.0; sp = sp * r2 - 1.0 / 6.0; sp = sp * r2 + 1.0; sp *= r;
    double cp = -1.0 / 87178291200.0; cp = cp * r2 + 1.0 / 479001600.0; cp = cp * r2 - 1.0 / 3628800.0; cp = cp * r2 + 1.0 / 40320.0; cp = cp * r2 - 1.0 / 720.0; cp = cp * r2 + 1.0 / 24.0; cp = cp * r2 - 0.5; cp = cp * r2 + 1.0;
    const int qi = (int)q & 3;
    const double ss = (qi == 0) ? sp : (qi == 1) ? cp : (qi == 2) ? -sp : -cp;
    const double cc = (qi == 0) ? cp : (qi == 1) ? -sp : (qi == 2) ? -cp : sp;
    s = (float)ss; c = (float)cc;
}

struct Frame {
    LAS unsigned char* lds;
    int tid, lane, wave, G, vcu;
    const float* in[24]; float* out; unsigned char* ws;
};
template <class T> __device__ __forceinline__ T* wsp(const Frame& F, size_t off) { return (T*)(F.ws + off); }

__device__ __forceinline__ void p0_transpose_item(const float* W, const float* gain, int K, int N, bf16* WT, int gu, LAS float* scr, int item, int lane) {
    const int nblk = N / 32, kb = item / nblk, nb = item % nblk, k0 = 64 * kb, n0 = 32 * nb;
#pragma unroll 8
    for (int i = 0; i < 32; ++i) { const int kk = 2 * i + (lane >> 5); float v = W[(size_t)(k0 + kk) * N + n0 + (lane & 31)]; if (gain) v *= gain[k0 + kk]; scr[kk * 33 + (lane & 31)] = v; }
    LDS_WAIT(); asm volatile("" ::: "memory");
    const int c = lane & 7;
    const int rb = (gu == 0) ? n0 : (256 * (n0 >> 7) + (n0 & 127) + (gu == 2 ? 128 : 0));
#pragma unroll
    for (int j = 0; j < 4; ++j) { const int n = (lane >> 3) + 8 * j; const LAS float* s = scr + (8 * c) * 33 + n;
        v4u o; o.x = pk2(s[0 * 33], s[1 * 33]); o.y = pk2(s[2 * 33], s[3 * 33]); o.z = pk2(s[4 * 33], s[5 * 33]); o.w = pk2(s[6 * 33], s[7 * 33]);
        *(GAS v4u*)(WT + (size_t)(rb + n) * K + k0 + 8 * c) = o; }
    LDS_WAIT(); asm volatile("" ::: "memory");
}
__device__ __forceinline__ void p0_prologue(Frame& F) {
    const int gw = F.vcu * NWAVES + F.wave, NGW = F.G * NWAVES;
    const int gt = blockIdx.x * (NWAVES * 64) + F.tid, NGT = F.G * NWAVES * 64;
    {
        f32x2* tw = wsp<f32x2>(F, WS_TW); f32x2* dft = wsp<f32x2>(F, WS_DFT); float* rope = wsp<float>(F, WS_ROPE);
        for (int i = gt; i < 16384; i += NGT) { float s, c; sincos_rev((double)i * (1.0 / 16384.0), s, c); tw[i] = (f32x2){c, s}; }
        for (int i = gt; i < 128; i += NGT) { float s, c; sincos_rev((double)i * (1.0 / 128.0), s, c); dft[i] = (f32x2){c, s}; }
        for (int i = gt; i < (256 + 64) * 16; i += NGT) {
            const int j = i & 15, p = i >> 4; const int pos = (p < 256) ? p : p - 256;
            double inv = 1.0; for (int q = 0; q < j; ++q) inv *= 0.5623413251903491;
            const float ang = (float)pos * (float)inv;
            float s, c; sincos_rev((double)ang * 0.15915494309189533577, s, c);
            if (p < 256) { rope[p * 16 + j] = c; rope[4096 + p * 16 + j] = s; } else { rope[8192 + pos * 16 + j] = c; rope[8192 + 1024 + pos * 16 + j] = s; }
        }
    }
    {
        LAS float* scr = (LAS float*)(F.lds + F.wave * 16384);
        constexpr int I_GU = (D / 64) * (FF / 32), I_DN = (FF / 64) * (D / 32), I_IN = (D / 64) * (NIN / 32), I_SQ = (D / 64) * (D / 32), I_CQ = (D / 64) * (256 / 32), I_CO = (256 / 64) * (D / 32);
        constexpr int NITEMS = 4 * I_GU + 2 * I_DN + I_IN + 2 * I_SQ + I_CQ + I_CO;
        for (int it = gw; it < NITEMS; it += NGW) {
            int r = it;
            if (r < I_GU) { p0_transpose_item(F.in[3], F.in[2], D, FF, wsp<bf16>(F, WS_W1GU), 1, scr, r, F.lane); continue; } r -= I_GU;
            if (r < I_GU) { p0_transpose_item(F.in[4], F.in[2], D, FF, wsp<bf16>(F, WS_W1GU), 2, scr, r, F.lane); continue; } r -= I_GU;
            if (r < I_DN) { p0_transpose_item(F.in[5], nullptr, FF, D, wsp<bf16>(F, WS_W1D), 0, scr, r, F.lane); continue; } r -= I_DN;
            if (r < I_GU) { p0_transpose_item(F.in[20], F.in[19], D, FF, wsp<bf16>(F, WS_W2GU), 1, scr, r, F.lane); continue; } r -= I_GU;
            if (r < I_GU) { p0_transpose_item(F.in[21], F.in[19], D, FF, wsp<bf16>(F, WS_W2GU), 2, scr, r, F.lane); continue; } r -= I_GU;
            if (r < I_DN) { p0_transpose_item(F.in[22], nullptr, FF, D, wsp<bf16>(F, WS_W2D), 0, scr, r, F.lane); continue; } r -= I_DN;
            if (r < I_IN) { p0_transpose_item(F.in[7], F.in[6], D, NIN, wsp<bf16>(F, WS_WIN), 0, scr, r, F.lane); continue; } r -= I_IN;
            if (r < I_SQ) { p0_transpose_item(F.in[11], nullptr, D, D, wsp<bf16>(F, WS_WAB), 0, scr, r, F.lane); continue; } r -= I_SQ;
            if (r < I_SQ) { p0_transpose_item(F.in[12], nullptr, D, D, wsp<bf16>(F, WS_WOUT), 0, scr, r, F.lane); continue; } r -= I_SQ;
            if (r < I_CQ) { p0_transpose_item(F.in[15], F.in[13], D, 256, wsp<bf16>(F, WS_WCQ), 0, scr, r, F.lane); continue; } r -= I_CQ;
            p0_transpose_item(F.in[18], nullptr, 256, D, wsp<bf16>(F, WS_WCO), 0, scr, r, F.lane);
        }
    }
    __syncthreads();
    {
        LAS f32x2* tab = (LAS f32x2*)F.lds;
        if (F.tid < 128) { float s, c; sincos_rev((double)F.tid * (1.0 / 128.0), s, c); tab[F.tid] = (f32x2){c * 0.08838834764831845f, s * 0.08838834764831845f}; }
        __syncthreads();
        const float* Wfb = F.in[10]; bf16* WT = wsp<bf16>(F, WS_WFB);
        for (int it = gt; it < 1024 * 128; it += NGT) {
            const int n = it & 1023, kb = it >> 10, kk0 = kb * 8, g = kk0 >> 8, ri = (kk0 >> 7) & 1, c0 = kk0 & 127;
            float a[8];
#pragma unroll
            for (int i = 0; i < 8; ++i) a[i] = 0.f;
            for (int j = 0; j < 128; ++j) {
                const float w = Wfb[(size_t)(g * 128 + j) * 1024 + n];
#pragma unroll
                for (int i = 0; i < 8; ++i) { const f32x2 cs = tab[((c0 + i) * j) & 127]; a[i] += w * (ri ? cs.y : cs.x); }
            }
            v4u o; o.x = pk2(a[0], a[1]); o.y = pk2(a[2], a[3]); o.z = pk2(a[4], a[5]); o.w = pk2(a[6], a[7]);
            *(GAS v4u*)(WT + (size_t)n * 1024 + kk0) = o;
        }
        __syncthreads();
    }
    {
        const float* x = F.in[0]; bf16* xb = wsp<bf16>(F, WS_HB16); float* rs1 = wsp<float>(F, WS_RS1);
        for (int m = gw; m < M; m += NGW) {
            const GAS f32x4* xr = (const GAS f32x4*)(x + (size_t)m * D) + F.lane;
            f32x4 v[4]; float s = 0.f;
#pragma unroll
            for (int j = 0; j < 4; ++j) { v[j] = xr[64 * j]; s += (v[j].x * v[j].x + v[j].y * v[j].y) + (v[j].z * v[j].z + v[j].w * v[j].w); }
            s = wave_sum(s);
            GAS unsigned long long* o8 = (GAS unsigned long long*)(xb + (size_t)m * D) + F.lane;
#pragma unroll
            for (int j = 0; j < 4; ++j) o8[64 * j] = (unsigned long long)pk2(v[j].x, v[j].y) | ((unsigned long long)pk2(v[j].z, v[j].w) << 32);
            if (F.lane == 0) rs1[m] = 1.0f / sqrtf(s * (1.0f / D) + RMS_EPSF);
        }
    }
    {
        LAS float* mn = (LAS float*)(F.lds + 8192); LAS float* red = (LAS float*)(F.lds + 8192 + 4096);
        const float* mem = F.in[1]; const float* gm = F.in[14]; const float* Wk = F.in[16]; const float* Wv = F.in[17];
        bf16* Kc = wsp<bf16>(F, WS_KC); bf16* Vc = wsp<bf16>(F, WS_VC);
        for (int r = blockIdx.x; r < MEMLEN; r += F.G) {
            __syncthreads();
            const float a = mem[(size_t)r * D + F.tid], b = mem[(size_t)r * D + 512 + F.tid];
            float s = wave_sum(a * a + b * b);
            if (F.lane == 0) red[F.wave] = s;
            __syncthreads();
            float tot = 0.f;
#pragma unroll
            for (int w = 0; w < NWAVES; ++w) tot += red[w];
            const float rinv = 1.0f / sqrtf(tot * (1.0f / D) + RMS_EPSF);
            mn[F.tid] = a * rinv * gm[F.tid]; mn[512 + F.tid] = b * rinv * gm[512 + F.tid];
            __syncthreads();
            const int n = F.tid & 255; const float* W = (F.tid < 256) ? Wk : Wv; float acc = 0.f;
            for (int k = 0; k < D; ++k) acc += mn[k] * W[(size_t)k * 256 + n];
            ((F.tid < 256) ? Kc : Vc)[r * 256 + n] = (bf16)f2bf(acc);
        }
        __syncthreads();
    }
}

__device__ __forceinline__ void p_prep_qk(Frame& F) {
    bf16* Q = wsp<bf16>(F, WS_QO); bf16* Kr = wsp<bf16>(F, WS_KR); const float* rope = wsp<float>(F, WS_ROPE);
    const float* qg = F.in[8]; const float* kg = F.in[9];
    const int gt = blockIdx.x * (NWAVES * 64) + F.tid, NGT = F.G * NWAVES * 64;
    for (int it = gt; it < M * 20; it += NGT) {
        const int t = it / 20, hh = it - t * 20;
        bf16* p = (hh < 16) ? (Q + (size_t)t * 1024 + hh * 64) : (Kr + (size_t)t * 256 + (hh - 16) * 64);
        const float* gain = (hh < 16) ? qg : kg; const float post = (hh < 16) ? C2Q : 1.0f;
        float v[64];
#pragma unroll
        for (int i = 0; i < 8; ++i) { const v4u w = *(const GAS v4u*)(p + 8 * i);
            v[8 * i + 0] = __uint_as_float(w.x << 16); v[8 * i + 1] = __uint_as_float(w.x & 0xffff0000u); v[8 * i + 2] = __uint_as_float(w.y << 16); v[8 * i + 3] = __uint_as_float(w.y & 0xffff0000u);
            v[8 * i + 4] = __uint_as_float(w.z << 16); v[8 * i + 5] = __uint_as_float(w.z & 0xffff0000u); v[8 * i + 6] = __uint_as_float(w.w << 16); v[8 * i + 7] = __uint_as_float(w.w & 0xffff0000u); }
        float s = 0.f;
#pragma unroll
        for (int i = 0; i < 64; ++i) s += v[i] * v[i];
        const float rinv = 1.0f / sqrtf(s * (1.0f / 64.0f) + RMS_EPSF);
#pragma unroll
        for (int i = 0; i < 64; ++i) v[i] = v[i] * rinv * gain[i];
        const int row = t >> 6, col = t & 63;
#pragma unroll
        for (int j = 0; j < 16; ++j) {
            const float cr = rope[row * 16 + j], sr = rope[4096 + row * 16 + j], cc = rope[8192 + col * 16 + j], sc = rope[8192 + 1024 + col * 16 + j];
            const float a = v[j], b = v[16 + j]; v[j] = a * cr - b * sr; v[16 + j] = b * cr + a * sr;
            const float e = v[32 + j], f = v[48 + j]; v[32 + j] = e * cc - f * sc; v[48 + j] = f * cc + e * sc;
        }
#pragma unroll
        for (int i = 0; i < 8; ++i) { v4u o; o.x = pk2(v[8 * i] * post, v[8 * i + 1] * post); o.y = pk2(v[8 * i + 2] * post, v[8 * i + 3] * post); o.z = pk2(v[8 * i + 4] * post, v[8 * i + 5] * post); o.w = pk2(v[8 * i + 6] * post, v[8 * i + 7] * post);
            *(GAS v4u*)(p + 8 * i) = o; }
    }
}
__device__ __forceinline__ void p_fftA_simple(Frame& F) {
    const bf16* X = wsp<bf16>(F, WS_F); bf16* A = wsp<bf16>(F, WS_HB16); const f32x2* tw = wsp<f32x2>(F, WS_TW); const f32x2* dft = wsp<f32x2>(F, WS_DFT);
    LAS bf16* Xs = (LAS bf16*)F.lds; LAS f32x2* tab = (LAS f32x2*)(F.lds + 65536);
    if (F.tid < 128) tab[F.tid] = dft[F.tid];
    for (int unit = blockIdx.x; unit < 512; unit += F.G) {
        const int t2 = unit >> 2, g = unit & 3;
        __syncthreads();
#pragma unroll
        for (int i = 0; i < 4; ++i) { const int q = F.tid + 512 * i, row = q >> 4, ch = q & 15;
            *(LAS v4u*)(Xs + row * 128 + ch * 8) = *(const GAS v4u*)(X + (size_t)(128 * row + t2) * NCH + g * 128 + ch * 8); }
        __syncthreads();
        const int c = F.tid & 127, kq = F.tid >> 7;
        for (int k1 = kq * 32; k1 < kq * 32 + 32; ++k1) {
            float ar = 0.f, ai = 0.f; int idx = 0;
#pragma unroll 8
            for (int t1 = 0; t1 < 128; ++t1) { const float x = bf2f(Xs[t1 * 128 + c]); const f32x2 cs = tab[idx]; ar += x * cs.x; ai -= x * cs.y; idx = (idx + k1) & 127; }
            ar *= 0.08838834764831845f; ai *= 0.08838834764831845f;
            const f32x2 w = tw[t2 * k1];
            const float br = ar * w.x + ai * w.y, bi = ai * w.x - ar * w.y;
            bf16* o = A + ((size_t)(k1 * 128 + t2) * 4 + g) * 256 + c;
            o[0] = (bf16)f2bf(br); o[128] = (bf16)f2bf(bi);
        }
    }
    __syncthreads();
}
__device__ __forceinline__ void p_fftB_simple(Frame& F) {
    const bf16* A = wsp<bf16>(F, WS_HB16); bf16* U = wsp<bf16>(F, WS_U); const f32x2* dft = wsp<f32x2>(F, WS_DFT);
    LAS bf16* As = (LAS bf16*)F.lds; LAS f32x2* tab = (LAS f32x2*)(F.lds + 65536);
    if (F.tid < 128) tab[F.tid] = dft[F.tid];
    for (int unit = blockIdx.x; unit < 512; unit += F.G) {
        const int k1 = unit >> 2, g = unit & 3;
        __syncthreads();
#pragma unroll
        for (int i = 0; i < 8; ++i) { const int q = F.tid + 512 * i, row = q >> 5, ch = q & 31;
            *(LAS v4u*)(As + row * 256 + ch * 8) = *(const GAS v4u*)(A + ((size_t)(k1 * 128 + row) * 4 + g) * 256 + ch * 8); }
        __syncthreads();
        const int c = F.tid & 127, kq = F.tid >> 7;
        for (int k2 = kq * 32; k2 < kq * 32 + 32; ++k2) {
            float ur = 0.f, ui = 0.f; int idx = 0;
#pragma unroll 8
            for (int t2 = 0; t2 < 128; ++t2) { const float ar = bf2f(As[t2 * 256 + c]), ai = bf2f(As[t2 * 256 + 128 + c]); const f32x2 cs = tab[idx];
                ur += ar * cs.x + ai * cs.y; ui += ai * cs.x - ar * cs.y; idx = (idx + k2) & 127; }
            bf16* o = U + (size_t)(k1 + 128 * k2) * 1024 + g * 256 + c;
            o[0] = (bf16)f2bf(ur * 0.08838834764831845f); o[128] = (bf16)f2bf(ui * 0.08838834764831845f);
        }
    }
    __syncthreads();
}
__device__ __forceinline__ void p_attn_simple(Frame& F) {
    bf16* Q = wsp<bf16>(F, WS_QO); const bf16* Kr = wsp<bf16>(F, WS_KR); const bf16* Vr = wsp<bf16>(F, WS_VR);
    const int gt = blockIdx.x * (NWAVES * 64) + F.tid, NGT = F.G * NWAVES * 64;
    for (int it = gt; it < M * 16; it += NGT) {
        const int h = it >> 14, t = it & (M - 1), kvh = h >> 2;
        bf16* qp = Q + (size_t)t * 1024 + h * 64;
        float q[64], o[64];
#pragma unroll
        for (int i = 0; i < 8; ++i) { const v4u w = *(const GAS v4u*)(qp + 8 * i);
            q[8 * i + 0] = bflo_(w.x); q[8 * i + 1] = bfhi_(w.x); q[8 * i + 2] = bflo_(w.y); q[8 * i + 3] = bfhi_(w.y); q[8 * i + 4] = bflo_(w.z); q[8 * i + 5] = bfhi_(w.z); q[8 * i + 6] = bflo_(w.w); q[8 * i + 7] = bfhi_(w.w); }
#pragma unroll
        for (int i = 0; i < 64; ++i) o[i] = 0.f;
        float mx = -1e30f, l = 0.f;
        for (int key = 0; key < M; ++key) {
            const bf16* kp = Kr + (size_t)key * 256 + kvh * 64; const bf16* vp = Vr + (size_t)key * 256 + kvh * 64;
            float s = 0.f;
#pragma unroll
            for (int i = 0; i < 8; ++i) { const v4u w = *(const GAS v4u*)(kp + 8 * i);
                s += q[8 * i + 0] * bflo_(w.x) + q[8 * i + 1] * bfhi_(w.x) + q[8 * i + 2] * bflo_(w.y) + q[8 * i + 3] * bfhi_(w.y) + q[8 * i + 4] * bflo_(w.z) + q[8 * i + 5] * bfhi_(w.z) + q[8 * i + 6] * bflo_(w.w) + q[8 * i + 7] * bfhi_(w.w); }
            const float mn = fmaxf(mx, s), al = __builtin_amdgcn_exp2f(mx - mn), p = __builtin_amdgcn_exp2f(s - mn);
            l = l * al + p; mx = mn;
#pragma unroll
            for (int i = 0; i < 8; ++i) { const v4u w = *(const GAS v4u*)(vp + 8 * i);
                o[8 * i + 0] = o[8 * i + 0] * al + p * bflo_(w.x); o[8 * i + 1] = o[8 * i + 1] * al + p * bfhi_(w.x); o[8 * i + 2] = o[8 * i + 2] * al + p * bflo_(w.y); o[8 * i + 3] = o[8 * i + 3] * al + p * bfhi_(w.y);
                o[8 * i + 4] = o[8 * i + 4] * al + p * bflo_(w.z); o[8 * i + 5] = o[8 * i + 5] * al + p * bfhi_(w.z); o[8 * i + 6] = o[8 * i + 6] * al + p * bflo_(w.w); o[8 * i + 7] = o[8 * i + 7] * al + p * bfhi_(w.w); }
        }
        const float li = 1.0f / l;
#pragma unroll
        for (int i = 0; i < 8; ++i) { v4u w; w.x = pk2(o[8 * i] * li, o[8 * i + 1] * li); w.y = pk2(o[8 * i + 2] * li, o[8 * i + 3] * li); w.z = pk2(o[8 * i + 4] * li, o[8 * i + 5] * li); w.w = pk2(o[8 * i + 6] * li, o[8 * i + 7] * li);
            *(GAS v4u*)(qp + 8 * i) = w; }
    }
}
__device__ __forceinline__ void p_cross_simple(Frame& F) {
    const bf16* QC = wsp<bf16>(F, WS_QC); bf16* OC = wsp<bf16>(F, WS_OC); const bf16* Kc = wsp<bf16>(F, WS_KC); const bf16* Vc = wsp<bf16>(F, WS_VC);
    const int gt = blockIdx.x * (NWAVES * 64) + F.tid, NGT = F.G * NWAVES * 64;
    for (int it = gt; it < M * 4; it += NGT) {
        const int h = it >> 14, t = it & (M - 1);
        const bf16* qp = QC + (size_t)t * 256 + h * 64;
        float q[64], o[64];
#pragma unroll
        for (int i = 0; i < 8; ++i) { const v4u w = *(const GAS v4u*)(qp + 8 * i);
            q[8 * i + 0] = bflo_(w.x) * C2Q; q[8 * i + 1] = bfhi_(w.x) * C2Q; q[8 * i + 2] = bflo_(w.y) * C2Q; q[8 * i + 3] = bfhi_(w.y) * C2Q; q[8 * i + 4] = bflo_(w.z) * C2Q; q[8 * i + 5] = bfhi_(w.z) * C2Q; q[8 * i + 6] = bflo_(w.w) * C2Q; q[8 * i + 7] = bfhi_(w.w) * C2Q; }
#pragma unroll
        for (int i = 0; i < 64; ++i) o[i] = 0.f;
        float mx = -1e30f, l = 0.f;
        for (int key = 0; key < MEMLEN; ++key) {
            const bf16* kp = Kc + key * 256 + h * 64; const bf16* vp = Vc + key * 256 + h * 64;
            float s = 0.f;
#pragma unroll
            for (int i = 0; i < 8; ++i) { const v4u w = *(const GAS v4u*)(kp + 8 * i);
                s += q[8 * i + 0] * bflo_(w.x) + q[8 * i + 1] * bfhi_(w.x) + q[8 * i + 2] * bflo_(w.y) + q[8 * i + 3] * bfhi_(w.y) + q[8 * i + 4] * bflo_(w.z) + q[8 * i + 5] * bfhi_(w.z) + q[8 * i + 6] * bflo_(w.w) + q[8 * i + 7] * bfhi_(w.w); }
            const float mn = fmaxf(mx, s), al = __builtin_amdgcn_exp2f(mx - mn), p = __builtin_amdgcn_exp2f(s - mn);
            l = l * al + p; mx = mn;
#pragma unroll
            for (int i = 0; i < 8; ++i) { const v4u w = *(const GAS v4u*)(vp + 8 * i);
                o[8 * i + 0] = o[8 * i + 0] * al + p * bflo_(w.x); o[8 * i + 1] = o[8 * i + 1] * al + p * bfhi_(w.x); o[8 * i + 2] = o[8 * i + 2] * al + p * bflo_(w.y); o[8 * i + 3] = o[8 * i + 3] * al + p * bfhi_(w.y);
                o[8 * i + 4] = o[8 * i + 4] * al + p * bflo_(w.z); o[8 * i + 5] = o[8 * i + 5] * al + p * bfhi_(w.z); o[8 * i + 6] = o[8 * i + 6] * al + p * bflo_(w.w); o[8 * i + 7] = o[8 * i + 7] * al + p * bfhi_(w.w); }
        }
        const float li = 1.0f / l; bf16* op = OC + (size_t)t * 256 + h * 64;
#pragma unroll
        for (int i = 0; i < 8; ++i) { v4u w; w.x = pk2(o[8 * i] * li, o[8 * i + 1] * li); w.y = pk2(o[8 * i + 2] * li, o[8 * i + 3] * li); w.z = pk2(o[8 * i + 4] * li, o[8 * i + 5] * li); w.w = pk2(o[8 * i + 6] * li, o[8 * i + 7] * li);
            *(GAS v4u*)(op + 8 * i) = w; }
    }
}
__device__ __forceinline__ void p_final(Frame& F) {
    const int gw = F.vcu * NWAVES + F.wave, NGW = F.G * NWAVES; const float* gf = F.in[23];
    f32x4 gv[4];
#pragma unroll
    for (int j = 0; j < 4; ++j) gv[j] = ((const GAS f32x4*)gf)[F.lane + 64 * j];
    for (int m = gw; m < M; m += NGW) {
        GAS f32x4* xr = (GAS f32x4*)(F.out + (size_t)m * D) + F.lane;
        f32x4 v[4]; float s = 0.f;
#pragma unroll
        for (int j = 0; j < 4; ++j) { v[j] = xr[64 * j]; s += (v[j].x * v[j].x + v[j].y * v[j].y) + (v[j].z * v[j].z + v[j].w * v[j].w); }
        const float rinv = 1.0f / sqrtf(wave_sum(s) * (1.0f / D) + RMS_EPSF);
#pragma unroll
        for (int j = 0; j < 4; ++j) xr[64 * j] = v[j] * rinv * gv[j];
    }
}
constexpr int N_PHASES = 15;
struct Args { const float* in[24]; float* out; unsigned char* ws; int ph_lo, ph_hi; };
__global__ void __launch_bounds__(NWAVES * 64, 2) mk_fwd(Args args) {
    extern __shared__ __attribute__((aligned(16))) unsigned char lds[];
    Frame F;
    F.lds = (LAS unsigned char*)lds;
    F.tid = threadIdx.x; F.lane = F.tid & 63; F.wave = __builtin_amdgcn_readfirstlane(F.tid >> 6);
    F.G = gridDim.x; { const int bx = blockIdx.x; F.vcu = (F.G % 8 == 0) ? (bx % 8) * (F.G / 8) + bx / 8 : bx; }
#pragma unroll
    for (int i = 0; i < 24; ++i) F.in[i] = args.in[i];
    F.out = args.out; F.ws = args.ws;
    const int lo = args.ph_lo, hi = args.ph_hi;
#define IN(k) (lo <= (k) && (k) < hi)
#define BOTH(k) (IN(k) && IN((k) + 1))
#define GRID_BAR() cooperative_groups::this_grid().sync()
    bf16* const HB16 = wsp<bf16>(F, WS_HB16); bf16* const HH = wsp<bf16>(F, WS_R1);
    bf16* const QO = wsp<bf16>(F, WS_QO); bf16* const UU = wsp<bf16>(F, WS_U); bf16* const KR = wsp<bf16>(F, WS_KR); bf16* const VR = wsp<bf16>(F, WS_VR); bf16* const FB = wsp<bf16>(F, WS_F);
    bf16* const GFB = wsp<bf16>(F, WS_GF); bf16* const GAB = wsp<bf16>(F, WS_GA); bf16* const QC = wsp<bf16>(F, WS_QC); bf16* const OC = wsp<bf16>(F, WS_OC);
    float* const SS2 = wsp<float>(F, WS_SS2); float* const SS3 = wsp<float>(F, WS_SS3); float* const SS4 = wsp<float>(F, WS_SS4);

    if (IN(0)) { p0_prologue(F); if (BOTH(0)) GRID_BAR(); }
    if (IN(1)) {
        pg8::Gemm g{HB16, wsp<bf16>(F, WS_W1GU), M, 2 * FF, D}; pg8::StaticOrder S; S.init(M, 2 * FF, F.G, (int)blockIdx.x);
        pg8::EpiSwiGLU E{HH, FF, wsp<float>(F, WS_RS1), 0};
        pg8::gemm_phase<pg8::EpiSwiGLU, pg8::StaticOrder, true, true>(F.lds, g, S, E);
        if (BOTH(1)) GRID_BAR();
    }
    if (IN(2)) {
        pg8::Gemm g{HH, wsp<bf16>(F, WS_W1D), M, D, FF}; pg8::StaticOrder S; S.init(M, D, F.G, (int)blockIdx.x);
        pg8::EpiResid E{F.in[0], F.out, HB16, SS2, 0.5f, D};
        pg8::gemm_phase<pg8::EpiResid, pg8::StaticOrder, true, true>(F.lds, g, S, E);
        if (BOTH(2)) GRID_BAR();
    }
    if (IN(3)) {
        pg8::Gemm g{HB16, wsp<bf16>(F, WS_WIN), M, NIN, D}; pg8::StaticOrder S; S.init(M, NIN, F.G, (int)blockIdx.x);
        pg8::EpiRoute E{{QO, KR, VR, FB, GFB, GAB}, SS2, 1, 1, 0};
        pg8::gemm_phase<pg8::EpiRoute, pg8::StaticOrder, true, true>(F.lds, g, S, E);
        if (BOTH(3)) GRID_BAR();
    }
    if (IN(4)) { p_prep_qk(F); p_fftA_simple(F); if (BOTH(4)) GRID_BAR(); }
    if (IN(5)) { p_fftB_simple(F); if (BOTH(5)) GRID_BAR(); }
    if (IN(6)) {
#if defined(ATTN_SIMPLE)
        p_attn_simple(F);
#else
        static_assert(attn_body::ATTN_LDS_BYTES <= RING_BYTES, "attention LDS");
        const attn_body::AttnTensors AT{(const attn_body::bf16*)QO, (const attn_body::bf16*)KR, (const attn_body::bf16*)VR, (attn_body::bf16*)QO};
        const attn_body::StaticOrder S((int)F.G, (int)blockIdx.x);
        attn_body::attn_phase<attn_body::StaticOrder>((char*)lds, AT, S);
#endif
        if (BOTH(6)) GRID_BAR();
    }
    if (IN(7)) {
        { pg8::Gemm g{UU, wsp<bf16>(F, WS_WFB), M, D, D}; pg8::StaticOrder S; S.init(M, D, F.G, (int)blockIdx.x);
          pg8::EpiGate E{GFB, nullptr, 1};
          pg8::gemm_phase<pg8::EpiGate, pg8::StaticOrder, true, true>(F.lds, g, S, E); }
        { pg8::Gemm g{QO, wsp<bf16>(F, WS_WAB), M, D, D}; pg8::StaticOrder S; S.init(M, D, F.G, (int)blockIdx.x);
          pg8::EpiGate E{GAB, GFB, 2};
          pg8::gemm_phase<pg8::EpiGate, pg8::StaticOrder, true, true>(F.lds, g, S, E); }
        if (BOTH(7)) GRID_BAR();
    }
    if (IN(8)) {
        pg8::Gemm g{GAB, wsp<bf16>(F, WS_WOUT), M, D, D}; pg8::StaticOrder S; S.init(M, D, F.G, (int)blockIdx.x);
        pg8::EpiResid E{F.out, F.out, HB16, SS3, 1.0f, D};
        pg8::gemm_phase<pg8::EpiResid, pg8::StaticOrder, true, true>(F.lds, g, S, E);
        if (BOTH(8)) GRID_BAR();
    }
    if (IN(9)) {
        pg8::Gemm g{HB16, wsp<bf16>(F, WS_WCQ), M, 256, D}; pg8::StaticOrder S; S.init(M, 256, F.G, (int)blockIdx.x);
        pg8::EpiRoute E{{QC, nullptr, nullptr, nullptr, nullptr, nullptr}, SS3, 1, 0, 256};
        pg8::gemm_phase<pg8::EpiRoute, pg8::StaticOrder, true, true>(F.lds, g, S, E);
        if (BOTH(9)) GRID_BAR();
    }
    if (IN(10)) { p_cross_simple(F); if (BOTH(10)) GRID_BAR(); }
    if (IN(11)) {
        pg8::Gemm g{OC, wsp<bf16>(F, WS_WCO), M, D, 256}; pg8::StaticOrder S; S.init(M, D, F.G, (int)blockIdx.x);
        pg8::EpiResid E{F.out, F.out, HB16, SS4, 1.0f, D};
        pg8::gemm_phase<pg8::EpiResid, pg8::StaticOrder, true, true>(F.lds, g, S, E);
        if (BOTH(11)) GRID_BAR();
    }
    if (IN(12)) {
        pg8::Gemm g{HB16, wsp<bf16>(F, WS_W2GU), M, 2 * FF, D}; pg8::StaticOrder S; S.init(M, 2 * FF, F.G, (int)blockIdx.x);
        pg8::EpiSwiGLU E{HH, FF, SS4, 1};
        pg8::gemm_phase<pg8::EpiSwiGLU, pg8::StaticOrder, true, true>(F.lds, g, S, E);
        if (BOTH(12)) GRID_BAR();
    }
    if (IN(13)) {
        pg8::Gemm g{HH, wsp<bf16>(F, WS_W2D), M, D, FF}; pg8::StaticOrder S; S.init(M, D, F.G, (int)blockIdx.x);
        pg8::EpiResid E{F.out, F.out, nullptr, nullptr, 0.5f, D};
        pg8::gemm_phase<pg8::EpiResid, pg8::StaticOrder, true, true>(F.lds, g, S, E);
        if (BOTH(13)) GRID_BAR();
    }
    if (IN(14)) { p_final(F); }
#undef IN
#undef BOTH
}

extern "C" void kernel_launch(void* const* d_in, const int* in_sizes, int n_in, void* d_out, int out_size, void* d_ws, size_t ws_size, hipStream_t stream) {
    static int grid = 0;
    if (grid == 0) {
        if (n_in != 24 || in_sizes[0] != M * D || out_size != M * D || ws_size < WS_END) {
            fprintf(stderr, "kernel_launch: unexpected shapes: n_in %d in0 %d out %d ws %zu (need %zu)\n", n_in, n_in > 0 ? in_sizes[0] : -1, out_size, ws_size, (size_t)WS_END); grid = -1; return; }
        int dev = 0, cus = 0, per_cu = 0;
        if (hipGetDevice(&dev) != hipSuccess || hipDeviceGetAttribute(&cus, hipDeviceAttributeMultiprocessorCount, dev) != hipSuccess) { grid = -1; return; }
        if (hipFuncSetAttribute((const void*)mk_fwd, hipFuncAttributeMaxDynamicSharedMemorySize, LDS_BYTES) != hipSuccess) { fprintf(stderr, "kernel_launch: hipFuncSetAttribute failed\n"); grid = -1; return; }
        if (hipOccupancyMaxActiveBlocksPerMultiprocessor(&per_cu, (const void*)mk_fwd, NWAVES * 64, LDS_BYTES) != hipSuccess || per_cu < 1) { fprintf(stderr, "kernel_launch: occupancy query says %d\n", per_cu); }
        (void)hipGetLastError();
        grid = cus * (per_cu < 1 ? 1 : 1);
        if (per_cu < 1) { grid = -1; return; }
        if (grid != 256) fprintf(stderr, "kernel_launch: %d CUs (built for 256)\n", grid);
    }
    if (grid < 0) return;
    (void)hipMemsetAsync((char*)d_ws + WS_CTL, 0, CTL_ZERO_BYTES, stream);
    Args a{};
    for (int i = 0; i < 24; ++i) a.in[i] = (const float*)d_in[i];
    a.out = (float*)d_out; a.ws = (unsigned char*)d_ws;
#if defined(MK_MULTI)
    for (int ph = 0; ph < N_PHASES; ++ph) {
        a.ph_lo = ph; a.ph_hi = ph + 1;
        hipLaunchKernelGGL(mk_fwd, dim3(grid), dim3(NWAVES * 64), LDS_BYTES, stream, a);
    }
#else
    a.ph_lo = 0; a.ph_hi = N_PHASES;
    void* kargs[] = {&a};
    const hipError_t e = hipLaunchCooperativeKernel((const void*)mk_fwd, dim3(grid), dim3(NWAVES * 64), kargs, LDS_BYTES, stream);
    if (e != hipSuccess) fprintf(stderr, "kernel_launch: cooperative launch failed: %s (grid %d)\n", hipGetErrorString(e), grid);
#endif
}
```

```cpp
#include <hip/hip_runtime.h>
#include <hip/hip_cooperative_groups.h>
#include <cstdio>
#include <cstdint>
namespace pg8 {
#define PG8_LAS __attribute__((address_space(3)))
typedef unsigned short bf16_t;
typedef short bf16x8 __attribute__((ext_vector_type(8)));
typedef float f32x4 __attribute__((ext_vector_type(4)));
typedef unsigned u32x4 __attribute__((ext_vector_type(4)));
constexpr int BM = 256, BK = 64, HALF = 128, HTB = HALF * BK * 2  , STAGE_BYTES = 8 * HTB, NXCD = 8, WGM = 8;

__host__ __device__ __forceinline__ int lds_byte(int r, int c) { const int st = (r >> 4) * 2 + (c >> 5), rr = r & 15, cc = c & 31, ob = rr * 64 + cc * 2; return st * 1024 + (ob ^ (((ob >> 9) & 1) << 5)); }
__host__ __device__ __forceinline__ void stage_rc(int b, int& R, int& C) { const int st = b / 1024, sb = b % 1024, swz = sb ^ (((sb >> 9) & 1) << 5); R = (st >> 1) * 16 + swz / 64; C = (st & 1) * 32 + (swz % 64) / 2; }
__host__ __device__ __forceinline__ int perm32(int rho) { const int n = rho >> 4, i = rho & 15; return 8 * (i >> 2) + 4 * n + (i & 3); }

struct Unit { int pm, pn; };
struct Gemm { const bf16_t* A; const bf16_t* Bt; int M, N, K; };

struct StaticOrder {
    int nM, nN, nwg, G, c;
    __host__ __device__ void init(int M, int N, int G_, int c_) { nM = M / BM; nN = N / BM; nwg = nM * nN; G = G_; c = c_; }
    __host__ __device__ bool next(int i, Unit& u) const {
        const long L = (long)i * G + c; if (L >= nwg) return false;
        int wgid = (int)L; { const int q = nwg / NXCD, r = nwg % NXCD, xcd = wgid % NXCD, off = wgid / NXCD; wgid = (xcd < r ? xcd * (q + 1) : r * (q + 1) + (xcd - r) * q) + off; }
        const int nig = WGM * nN, gid = wgid / nig, fm = gid * WGM, gsz = (nM - fm) < WGM ? (nM - fm) : WGM;
        u.pm = fm + ((wgid % nig) % gsz); u.pn = (wgid % nig) / gsz; return true;
    }
    __device__ __forceinline__ void a_ready(const Unit&) const {}
    __device__ __forceinline__ void done(const Unit&) const {}
};

__device__ __forceinline__ unsigned cvt_pk_bf16(float lo, float hi) { unsigned r; asm volatile("v_cvt_pk_bf16_f32 %0, %1, %2" : "=v"(r) : "v"(lo), "v"(hi)); return r; }
__device__ __forceinline__ float bflo(unsigned u) { return __uint_as_float(u << 16); }
__device__ __forceinline__ float bfhi(unsigned u) { return __uint_as_float(u & 0xffff0000u); }
__device__ __forceinline__ float sigmoid_f(float x) { return __builtin_amdgcn_rcpf(1.0f + __builtin_amdgcn_exp2f(-1.4426950408889634f * x)); }
__device__ __forceinline__ u32x4 pack8(const f32x4 a, const f32x4 b) { u32x4 w; w.x = cvt_pk_bf16(a[0], a[1]); w.y = cvt_pk_bf16(a[2], a[3]); w.z = cvt_pk_bf16(b[0], b[1]); w.w = cvt_pk_bf16(b[2], b[3]); return w; }
constexpr float RMS_EPS = 1e-6f;
__device__ __forceinline__ float rowscale(const float* p, int row, int mode) { const float v = p[row]; return mode ? __builtin_amdgcn_rsqf(v * (1.0f / 1024.0f) + RMS_EPS) : v; }

struct EpiSwiGLU {
    static constexpr bool PERM = true, AFTER_DRAIN = false;
    bf16_t* H; int ldh; const float* rs; int rs_mode;
    __device__ __forceinline__ void operator()(const f32x4 (&acc)[2][2][4][2], const Unit& u, int wr, int wc, int fr, int fq) const {
        const int row0 = u.pm * BM + wr * 64 + fr, col0 = u.pn * HALF + wc * 32 + 8 * fq;
#pragma unroll
        for (int ai = 0; ai < 2; ++ai)
#pragma unroll
            for (int m = 0; m < 4; ++m) {
                const int row = row0 + ai * HALF + m * 16; const float r = rowscale(rs, row, rs_mode);
                f32x4 o[2];
#pragma unroll
                for (int n = 0; n < 2; ++n) {
                    const f32x4 g = acc[ai][0][m][n] * r, up = acc[ai][1][m][n] * r;
#pragma unroll
                    for (int j = 0; j < 4; ++j) o[n][j] = g[j] * sigmoid_f(g[j]) * up[j];
                }
                *(u32x4*)(H + (size_t)row * ldh + col0) = pack8(o[0], o[1]);
            }
    }
};
struct EpiResid {
    static constexpr bool PERM = true, AFTER_DRAIN = false;
    const float* base; float* out; bf16_t* ob; float* ss; float scale; int ldc;
    __device__ __forceinline__ void operator()(const f32x4 (&acc)[2][2][4][2], const Unit& u, int wr, int wc, int fr, int fq) const {
        const int row0 = u.pm * BM + wr * 64 + fr, col0 = u.pn * BM + wc * 32 + 8 * fq;
#pragma unroll
        for (int ai = 0; ai < 2; ++ai)
#pragma unroll
            for (int m = 0; m < 4; ++m) {
                const int row = row0 + ai * HALF + m * 16; float s = 0.f;
#pragma unroll
                for (int bj = 0; bj < 2; ++bj) {
                    const size_t off = (size_t)row * ldc + col0 + bj * HALF;
                    const f32x4 b0 = *(const f32x4*)(base + off), b1 = *(const f32x4*)(base + off + 4);
                    const f32x4 o0 = b0 + acc[ai][bj][m][0] * scale, o1 = b1 + acc[ai][bj][m][1] * scale;
                    *(f32x4*)(out + off) = o0; *(f32x4*)(out + off + 4) = o1;
                    if (ob) *(u32x4*)(ob + off) = pack8(o0, o1);
                    s += (o0[0] * o0[0] + o0[1] * o0[1]) + (o0[2] * o0[2] + o0[3] * o0[3]) + (o1[0] * o1[0] + o1[1] * o1[1]) + (o1[2] * o1[2] + o1[3] * o1[3]);
                }
                if (ss) { s += __shfl_xor(s, 16); s += __shfl_xor(s, 32); if (fq == 0) atomicAdd(ss + row, s); }
            }
    }
};
struct EpiRoute {
    static constexpr bool PERM = true, AFTER_DRAIN = false;
    bf16_t* dst[6]; const float* rs; int rs_mode; int is_win;
    int ld0;
    __device__ __forceinline__ void operator()(const f32x4 (&acc)[2][2][4][2], const Unit& u, int wr, int wc, int fr, int fq) const {
        const int pn = u.pn; bf16_t* bp; int ldc, colt;
        if (!is_win) { bp = dst[0]; ldc = ld0; colt = pn * BM; }
        else if (pn < 4) { bp = dst[0]; ldc = 1024; colt = pn * BM; }
        else if (pn == 4) { bp = dst[1]; ldc = 256; colt = 0; }
        else if (pn == 5) { bp = dst[2]; ldc = 256; colt = 0; }
        else if (pn < 8) { bp = dst[3]; ldc = 512; colt = (pn - 6) * BM; }
        else if (pn < 12) { bp = dst[4]; ldc = 1024; colt = (pn - 8) * BM; }
        else { bp = dst[5]; ldc = 1024; colt = (pn - 12) * BM; }
        const int row0 = u.pm * BM + wr * 64 + fr, col0 = colt + wc * 32 + 8 * fq;
#pragma unroll
        for (int ai = 0; ai < 2; ++ai)
#pragma unroll
            for (int m = 0; m < 4; ++m) {
                const int row = row0 + ai * HALF + m * 16; const float r = rowscale(rs, row, rs_mode);
#pragma unroll
                for (int bj = 0; bj < 2; ++bj)
                    *(u32x4*)(bp + (size_t)row * ldc + col0 + bj * HALF) = pack8(acc[ai][bj][m][0] * r, acc[ai][bj][m][1] * r);
            }
    }
};
struct EpiGate {
    static constexpr bool PERM = true, AFTER_DRAIN = false;
    bf16_t* G; const bf16_t* T; int mode;
    __device__ __forceinline__ void operator()(const f32x4 (&acc)[2][2][4][2], const Unit& u, int wr, int wc, int fr, int fq) const {
        const int row0 = u.pm * BM + wr * 64 + fr, col0 = u.pn * BM + wc * 32 + 8 * fq;
#pragma unroll
        for (int ai = 0; ai < 2; ++ai)
#pragma unroll
            for (int m = 0; m < 4; ++m) {
                const int row = row0 + ai * HALF + m * 16;
#pragma unroll
                for (int bj = 0; bj < 2; ++bj) {
                    const size_t off = (size_t)row * 1024 + col0 + bj * HALF;
                    const u32x4 gv = *(const u32x4*)(G + off);
                    f32x4 g0 = {bflo(gv.x), bfhi(gv.x), bflo(gv.y), bfhi(gv.y)}, g1 = {bflo(gv.z), bfhi(gv.z), bflo(gv.w), bfhi(gv.w)};
                    f32x4 o0, o1;
#pragma unroll
                    for (int j = 0; j < 4; ++j) { o0[j] = sigmoid_f(g0[j]) * acc[ai][bj][m][0][j]; o1[j] = sigmoid_f(g1[j]) * acc[ai][bj][m][1][j]; }
                    if (mode == 2) { const u32x4 tv = *(const u32x4*)(T + off);
                        o0 += (f32x4){bflo(tv.x), bfhi(tv.x), bflo(tv.y), bfhi(tv.y)}; o1 += (f32x4){bflo(tv.z), bfhi(tv.z), bflo(tv.w), bfhi(tv.w)}; }
                    *(u32x4*)(G + off) = pack8(o0, o1);
                }
            }
    }
};
template <class Epi, class Sched, bool ALIGN_EPI = false, bool SP2 = false>
__device__ __forceinline__ void gemm_phase(PG8_LAS unsigned char* lds, const Gemm g, const Sched& S, const Epi& E) {
    const int tid = threadIdx.x, wid = __builtin_amdgcn_readfirstlane(tid >> 6), lane = tid & 63, wr = wid >> 2, wc = wid & 3, fr = lane & 15, fq = lane >> 4;
    const int K = g.K, nt = K / BK;
    unsigned voffA[2], voffB[2];
#pragma unroll
    for (int i = 0; i < 2; ++i) { int R, C; stage_rc(tid * 16 + i * 8192, R, C); const int Rb = Epi::PERM ? ((R & ~31) + perm32(R & 31)) : R;
        voffA[i] = (unsigned)(R * K + C) * 2u; voffB[i] = (unsigned)(Rb * K + C) * 2u; }
    const size_t kstep = (size_t)(BK * 2);
    const size_t hstep = (size_t)HALF * K * 2;
    const size_t tstep = 2 * hstep;
    const unsigned ldsw = (unsigned)wid * 1024u;
    const int aoff = lds_byte(wr * 64 + fr, fq * 8), boff = lds_byte(wc * 32 + fr, fq * 8);
#define PG8_SA(b, h) (((b) * 2 + (h)) * HTB)
#define PG8_SB(b, h) ((4 + (b) * 2 + (h)) * HTB)
#define PG8_STAGE(bufoff, gbase, voff) do { _Pragma("unroll") for (int _i = 0; _i < 2; ++_i) \
        __builtin_amdgcn_global_load_lds((const unsigned*)((const char*)(gbase) + (voff)[_i]), (PG8_LAS unsigned*)(lds + (bufoff) + ldsw + _i * 8192), 16, 0, 0); } while (0)
#define PG8_LDA(dst, b, h) do { _Pragma("unroll") for (int m = 0; m < 4; ++m) _Pragma("unroll") for (int k = 0; k < 2; ++k) dst[m][k] = *(const PG8_LAS bf16x8*)(lds + PG8_SA(b, h) + aoff + m * 2048 + k * 1024); } while (0)
#define PG8_LDB(dst, b, h) do { _Pragma("unroll") for (int n = 0; n < 2; ++n) _Pragma("unroll") for (int k = 0; k < 2; ++k) dst[n][k] = *(const PG8_LAS bf16x8*)(lds + PG8_SB(b, h) + boff + n * 2048 + k * 1024); } while (0)
#define PG8_MMA(ai, bj, At, Bt) do { __builtin_amdgcn_s_setprio(1); _Pragma("unroll") for (int m = 0; m < 4; ++m) _Pragma("unroll") for (int n = 0; n < 2; ++n) _Pragma("unroll") for (int k = 0; k < 2; ++k) \
        acc[ai][bj][m][n] = __builtin_amdgcn_mfma_f32_16x16x32_bf16(Bt[n][k], At[m][k], acc[ai][bj][m][n], 0, 0, 0); __builtin_amdgcn_s_setprio(0); } while (0)
#define PG8_WAIT_V(n) asm volatile("s_waitcnt vmcnt(" #n ")" ::: "memory")
#define PG8_WAIT_L(n) asm volatile("s_waitcnt lgkmcnt(" #n ")" ::: "memory")
#define PG8_BAR __builtin_amdgcn_s_barrier()
#define PG8_SCHED __builtin_amdgcn_sched_barrier(0)
    Unit cur, nxt; int ui = 0;
    if (!S.next(0, cur)) return;
    f32x4 acc[2][2][4][2];
#pragma unroll
    for (int a = 0; a < 2; ++a)
#pragma unroll
        for (int b = 0; b < 2; ++b)
#pragma unroll
            for (int m = 0; m < 4; ++m)
#pragma unroll
                for (int n = 0; n < 2; ++n) acc[a][b][m][n] = (f32x4){0.f, 0.f, 0.f, 0.f};
    bf16x8 At[4][2], B0[2][2], B1[2][2];
    const char* cA = (const char*)g.A + (size_t)cur.pm * tstep; const char* cB = (const char*)g.Bt + (size_t)cur.pn * tstep;
    S.a_ready(cur);
    if constexpr (SP2) {
        PG8_STAGE(PG8_SB(0, 0), cB, voffB); PG8_STAGE(PG8_SB(0, 1), cB + hstep, voffB); PG8_STAGE(PG8_SA(0, 0), cA, voffA); PG8_STAGE(PG8_SA(0, 1), cA + hstep, voffA);
        if (wr == 1) PG8_BAR;
        PG8_WAIT_V(2); PG8_BAR;
        PG8_STAGE(PG8_SB(1, 0), cB + kstep, voffB); PG8_STAGE(PG8_SA(1, 0), cA + kstep, voffA); PG8_STAGE(PG8_SB(1, 1), cB + hstep + kstep, voffB);
        PG8_WAIT_V(6); PG8_BAR;
    } else {
        PG8_STAGE(PG8_SB(0, 0), cB, voffB); PG8_STAGE(PG8_SA(0, 0), cA, voffA); PG8_STAGE(PG8_SB(0, 1), cB + hstep, voffB); PG8_STAGE(PG8_SA(0, 1), cA + hstep, voffA);
        if (wr == 1) PG8_BAR;
        PG8_WAIT_V(4); PG8_BAR;
        PG8_STAGE(PG8_SB(1, 0), cB + kstep, voffB); PG8_STAGE(PG8_SA(1, 0), cA + kstep, voffA); PG8_STAGE(PG8_SB(1, 1), cB + hstep + kstep, voffB);
        PG8_WAIT_V(6); PG8_BAR;
    }
    for (;;) {
        const bool has_next = S.next(ui + 1, nxt);
        const char* nA = has_next ? (const char*)g.A + (size_t)nxt.pm * tstep : cA; const char* nB = has_next ? (const char*)g.Bt + (size_t)nxt.pn * tstep : cB;
        for (int t = 0; t < nt; t += 2) {
            const bool last = (t == nt - 2);
            const char* a1 = cA + (size_t)(t + 1) * kstep;
            const char* a2 = last ? nA : cA + (size_t)(t + 2) * kstep; const char* b2 = last ? nB : cB + (size_t)(t + 2) * kstep;
            const char* a3 = a2 + kstep; const char* b3 = b2 + kstep;
            if (last && has_next) S.a_ready(nxt);
            if constexpr (SP2) {
            PG8_LDB(B0, 0, 0); PG8_LDB(B1, 0, 1); PG8_SCHED; PG8_LDA(At, 0, 0); PG8_STAGE(PG8_SA(1, 1), a1 + hstep, voffA);
            PG8_WAIT_V(8); PG8_WAIT_L(0); PG8_BAR; PG8_MMA(0, 0, At, B0); PG8_MMA(0, 1, At, B1); PG8_BAR; PG8_SCHED;
            PG8_LDA(At, 0, 1); PG8_STAGE(PG8_SB(0, 0), b2, voffB); PG8_STAGE(PG8_SB(0, 1), b2 + hstep, voffB); PG8_STAGE(PG8_SA(0, 0), a2, voffA);
            PG8_WAIT_V(8); PG8_WAIT_L(0); PG8_BAR; PG8_MMA(1, 0, At, B0); PG8_MMA(1, 1, At, B1); PG8_BAR; PG8_SCHED;
            PG8_LDB(B0, 1, 0); PG8_LDB(B1, 1, 1); PG8_SCHED; PG8_LDA(At, 1, 0); PG8_STAGE(PG8_SA(0, 1), a2 + hstep, voffA);
            PG8_WAIT_V(8); PG8_WAIT_L(0); PG8_BAR; PG8_MMA(0, 0, At, B0); PG8_MMA(0, 1, At, B1); PG8_BAR; PG8_SCHED;
            PG8_LDA(At, 1, 1); PG8_STAGE(PG8_SB(1, 0), b3, voffB); PG8_STAGE(PG8_SB(1, 1), b3 + hstep, voffB); PG8_STAGE(PG8_SA(1, 0), a3, voffA);
            PG8_WAIT_V(8); PG8_WAIT_L(0); PG8_BAR; PG8_MMA(1, 0, At, B0); PG8_MMA(1, 1, At, B1); PG8_BAR; PG8_SCHED;
            } else {
            PG8_LDB(B0, 0, 0); PG8_SCHED; PG8_LDA(At, 0, 0); PG8_STAGE(PG8_SA(1, 1), a1 + hstep, voffA);
            PG8_WAIT_L(8); PG8_BAR; PG8_WAIT_L(0); PG8_MMA(0, 0, At, B0); PG8_BAR; PG8_SCHED;
            PG8_LDB(B1, 0, 1); PG8_STAGE(PG8_SB(0, 0), b2, voffB);
            PG8_BAR; PG8_WAIT_L(0); PG8_MMA(0, 1, At, B1); PG8_BAR;
            PG8_LDA(At, 0, 1); PG8_STAGE(PG8_SA(0, 0), a2, voffA);
            PG8_BAR; PG8_WAIT_L(0); PG8_MMA(1, 0, At, B0); PG8_BAR; PG8_SCHED;
            PG8_STAGE(PG8_SB(0, 1), b2 + hstep, voffB);
            PG8_WAIT_V(6); PG8_BAR; PG8_MMA(1, 1, At, B1); PG8_BAR;
            PG8_LDB(B0, 1, 0); PG8_SCHED; PG8_LDA(At, 1, 0); PG8_STAGE(PG8_SA(0, 1), a2 + hstep, voffA);
            PG8_WAIT_L(8); PG8_BAR; PG8_WAIT_L(0); PG8_MMA(0, 0, At, B0); PG8_BAR; PG8_SCHED;
            PG8_LDB(B1, 1, 1); PG8_STAGE(PG8_SB(1, 0), b3, voffB);
            PG8_BAR; PG8_WAIT_L(0); PG8_MMA(0, 1, At, B1); PG8_BAR;
            PG8_LDA(At, 1, 1); PG8_STAGE(PG8_SA(1, 0), a3, voffA);
            PG8_BAR; PG8_WAIT_L(0); PG8_MMA(1, 0, At, B0); PG8_BAR; PG8_SCHED;
            PG8_STAGE(PG8_SB(1, 1), b3 + hstep, voffB);
            PG8_WAIT_V(6); PG8_BAR; PG8_MMA(1, 1, At, B1); PG8_BAR;
            }
        }
        if constexpr (ALIGN_EPI) { if (wr == 0) PG8_BAR; }
        if constexpr (!Epi::AFTER_DRAIN) { E(acc, cur, wr, wc, fr, fq); S.done(cur); }
        if (!has_next) break;
#pragma unroll
        for (int a = 0; a < 2; ++a)
#pragma unroll
            for (int b = 0; b < 2; ++b)
#pragma unroll
                for (int m = 0; m < 4; ++m)
#pragma unroll
                    for (int n = 0; n < 2; ++n) acc[a][b][m][n] = (f32x4){0.f, 0.f, 0.f, 0.f};
        cur = nxt; cA = nA; cB = nB; ++ui;
        if constexpr (ALIGN_EPI) { if (wr == 1) PG8_BAR; }
    }
    PG8_WAIT_V(0);
    if constexpr (!ALIGN_EPI) { if (wr == 0) PG8_BAR; }
    PG8_BAR;
    if constexpr (Epi::AFTER_DRAIN) { E.fused(acc, cur, wr, wc, fr, fq, lds, wid, lane); S.done(cur); }
#undef PG8_SA
#undef PG8_SB
#undef PG8_STAGE
#undef PG8_LDA
#undef PG8_LDB
#undef PG8_MMA
#undef PG8_WAIT_V
#undef PG8_WAIT_L
#undef PG8_BAR
#undef PG8_SCHED
}
}
#include <hip/hip_bf16.h>
#include <cmath>
namespace attn_body {
using bf16=__hip_bfloat16;
using bf16x8=__attribute__((ext_vector_type(8)))short;
using s16x4=__attribute__((ext_vector_type(4)))short;
using f32x16=__attribute__((ext_vector_type(16)))float;
using u32x4=__attribute__((ext_vector_type(4)))unsigned;
constexpr int BATCH=1,NHEAD=16,SEQ=16384,D=64,DM=NHEAD*D,KVP=256,GQA=4;
constexpr int NW=8,QBLK=32,QB=QBLK*NW,KVBLK=64,NQB=SEQ/QB;
constexpr int ATTN_PITCH=DM, ATTN_UNIT_ROWS=QB;
__device__ __forceinline__ int crow(int r,int hi){return (r&3)+8*(r>>2)+4*hi;}
#define SBAR() __builtin_amdgcn_sched_barrier(0)
__device__ __forceinline__ void cmask(f32x16&p0,f32x16&p1,int jb,int qrel,int hi){
  const float NEG=-INFINITY; int kb=64*jb+4*hi;
  #pragma unroll
  for(int r=0;r<16;++r){int kv=kb+(r&3)+8*(r>>2); if(kv>qrel)p0[r]=NEG; if(kv+32>qrel)p1[r]=NEG;}
}

constexpr int NSLOT=3, SLOTB=8192;
constexpr int LDS_K=0, LDS_V=NSLOT*SLOTB, LDS_WS=2*NSLOT*SLOTB, LDS_OST=LDS_WS+NW*64*4, LDS_BYTES=LDS_OST+NW*4096;
constexpr float C2=0.125f*1.4426950408889634f;
__device__ __forceinline__ void glds16(const void*gsrc,unsigned lds_dst){unsigned keep;
  asm volatile("s_mov_b32 %0, m0\n\ts_mov_b32 m0, %2\n\ts_nop 0\n\tglobal_load_lds_dwordx4 %1, off\n\ts_mov_b32 m0, %0":"=&s"(keep):"v"(gsrc),"s"(lds_dst):"memory");}
__device__ __forceinline__ float max3f(float a,float b,float c){float r;asm("v_max3_f32 %0, %1, %2, %3":"=v"(r):"v"(a),"v"(b),"v"(c));return r;}
__device__ __forceinline__ float max2f(float a,float b){float r;asm("v_max_f32_e32 %0, %1, %2":"=v"(r):"v"(a),"v"(b));return r;}
__device__ __forceinline__ float fadd_s(float a,float b){float r;asm("v_add_f32_e32 %0, %1, %2":"=v"(r):"v"(a),"v"(b));return r;}
__device__ __forceinline__ float fsub_s(float a,float b){float r;asm("v_sub_f32_e32 %0, %1, %2":"=v"(r):"v"(a),"v"(b));return r;}
typedef float f32x2_t __attribute__((ext_vector_type(2))); typedef __bf16 bf16x2_t __attribute__((ext_vector_type(2)));
__device__ __forceinline__ unsigned cvtpk_s(float lo,float hi){f32x2_t v={lo,hi};bf16x2_t b=__builtin_convertvector(v,bf16x2_t);return __builtin_bit_cast(unsigned,b);}
#define WAIT_BAR(N) asm volatile("s_waitcnt vmcnt(" #N ") lgkmcnt(0)\n\ts_barrier":::"memory")

__device__ __forceinline__ void qkt(f32x16&p0,f32x16&p1,const char*Kslot,const bf16x8*qr,const f32x16&negm,int r32,int hi){
  const char*kb=Kslot+hi*1024+r32*16;
  #pragma unroll
  for(int d0=0;d0<4;++d0){
    const bf16x8 b0=*reinterpret_cast<const bf16x8*>(kb+d0*2048);
    const bf16x8 b1=*reinterpret_cast<const bf16x8*>(kb+d0*2048+512);
    if(d0==0){p0=__builtin_amdgcn_mfma_f32_32x32x16_bf16(b0,qr[0],negm,0,0,0);p1=__builtin_amdgcn_mfma_f32_32x32x16_bf16(b1,qr[0],negm,0,0,0);}
    else{p0=__builtin_amdgcn_mfma_f32_32x32x16_bf16(b0,qr[d0],p0,0,0,0);p1=__builtin_amdgcn_mfma_f32_32x32x16_bf16(b1,qr[d0],p1,0,0,0);}}
}
typedef __attribute__((address_space(3))) const char* lds_cptr;
typedef short v4i16_t __attribute__((ext_vector_type(4)));
__device__ __forceinline__ void kload8(bf16x8*kf,lds_cptr kp){
  kf[0]=*(const __attribute__((address_space(3))) bf16x8*)(kp);      kf[1]=*(const __attribute__((address_space(3))) bf16x8*)(kp+512);
  kf[2]=*(const __attribute__((address_space(3))) bf16x8*)(kp+2048); kf[3]=*(const __attribute__((address_space(3))) bf16x8*)(kp+2560);
  kf[4]=*(const __attribute__((address_space(3))) bf16x8*)(kp+4096); kf[5]=*(const __attribute__((address_space(3))) bf16x8*)(kp+4608);
  kf[6]=*(const __attribute__((address_space(3))) bf16x8*)(kp+6144); kf[7]=*(const __attribute__((address_space(3))) bf16x8*)(kp+6656);
}
__device__ __forceinline__ void kload2(bf16x8*kf,lds_cptr kp,int j){ kf[2*j]=*(const __attribute__((address_space(3))) bf16x8*)(kp+j*2048); kf[2*j+1]=*(const __attribute__((address_space(3))) bf16x8*)(kp+j*2048+512); }
__device__ __forceinline__ s16x4 vtr(lds_cptr p){ return __builtin_bit_cast(s16x4,__builtin_amdgcn_ds_read_tr16_b64_v4i16((__attribute__((address_space(3))) v4i16_t*)p)); }
__device__ __forceinline__ float rowmax(const f32x16&p0,const f32x16&p1){
  float a=max3f(p0[0],p0[1],p1[0]),b=max3f(p0[2],p0[3],p1[1]);a=max3f(a,p1[2],p1[3]);
  #pragma unroll
  for(int r=4;r<16;r+=4){a=max3f(a,p0[r],p0[r+1]);b=max3f(b,p0[r+2],p0[r+3]);a=max3f(a,p1[r],p1[r+1]);b=max3f(b,p1[r+2],p1[r+3]);}
  const float m=max2f(a,b);
  auto rr=__builtin_amdgcn_permlane32_swap(__float_as_uint(m),__float_as_uint(m),false,false);
  return max2f(__uint_as_float(rr[0]),__uint_as_float(rr[1]));
}
__device__ __forceinline__ void pv(f32x16*o,int vb,bf16x8 pa0,bf16x8 pa1,bf16x8 pa2,bf16x8 pa3){
  #pragma unroll
  for(int d0=0;d0<2;++d0){s16x4 lo[4],hi[4];
    #pragma unroll
    for(int ks=0;ks<4;++ks){
      asm volatile("ds_read_b64_tr_b16 %0,%1 offset:%c2":"=&v"(lo[ks]):"v"(vb),"i"(d0*4096+ks*1024):"memory");
      asm volatile("ds_read_b64_tr_b16 %0,%1 offset:%c2":"=&v"(hi[ks]):"v"(vb),"i"(d0*4096+ks*1024+512):"memory");}
    asm volatile("s_waitcnt lgkmcnt(0)":::"memory");SBAR();
    #define PK(k) (bf16x8){lo[k][0],lo[k][1],lo[k][2],lo[k][3],hi[k][0],hi[k][1],hi[k][2],hi[k][3]}
    o[d0]=__builtin_amdgcn_mfma_f32_32x32x16_bf16(pa0,PK(0),o[d0],0,0,0);
    o[d0]=__builtin_amdgcn_mfma_f32_32x32x16_bf16(pa1,PK(1),o[d0],0,0,0);
    o[d0]=__builtin_amdgcn_mfma_f32_32x32x16_bf16(pa2,PK(2),o[d0],0,0,0);
    o[d0]=__builtin_amdgcn_mfma_f32_32x32x16_bf16(pa3,PK(3),o[d0],0,0,0);
    #undef PK
  }
}

#ifndef ATTN_STORE16
#define ATTN_STORE16(p,v) (*(u32x4*)(p)=(v))
#endif
template<int THRL> __device__ __forceinline__ void attn_unit(int b,int h,int qb,const bf16*Q,const bf16*__restrict__ K,const bf16*__restrict__ V,bf16*O,char*shm){
  const int tid=threadIdx.x,lane=tid&63,r32=lane&31,hi=lane>>5; const int wid=__builtin_amdgcn_readfirstlane(tid>>6);
  const long rowbase=(long)b*SEQ; const int q0=qb*QB;
  const bf16*Qw=Q+(rowbase+q0+wid*QBLK)*DM+h*D;
  const bf16*Kh=K+rowbase*KVP+(h/GQA)*D,*Vh=V+rowbase*KVP+(h/GQA)*D;
  const unsigned lds0=(unsigned)(uintptr_t)shm;
  float*wsf=(float*)(shm+LDS_WS)+wid*64;
  const bf16*ksrc=Kh+(long)lane*KVP+wid*8;
  const bf16*vsrc=Vh+(long)(16*(wid&3)+(lane>>2))*KVP+(wid>>2)*32+(lane&3)*8;
  const unsigned kdst=lds0+LDS_K+wid*1024, vdst=lds0+LDS_V+wid*1024;
  #define DMA_K(t,slot) glds16(ksrc+(long)(t)*KVBLK*KVP,(unsigned)__builtin_amdgcn_readfirstlane(kdst+(slot)))
  #define DMA_V(t,slot) glds16(vsrc+(long)(t)*KVBLK*KVP,(unsigned)__builtin_amdgcn_readfirstlane(vdst+(slot)))
  const int vb0=(int)(lds0+LDS_V)+((lane>>4)&1)*32+(lane&3)*8+(4*hi+((lane&15)>>2))*64;
  const char*Kbase=shm+LDS_K; bf16x8 kf[8];
  const lds_cptr shm3=(lds_cptr)shm; const lds_cptr kp0=shm3+LDS_K+hi*1024+r32*16; const lds_cptr vp0=shm3+LDS_V+((lane>>4)&1)*32+(lane&3)*8+(4*hi+((lane&15)>>2))*64;
  const int NT=SEQ/KVBLK;
  DMA_K(0,0);DMA_V(0,0);DMA_K(1,SLOTB);
  bf16x8 qr[4];
  #pragma unroll
  for(int d0=0;d0<4;++d0)qr[d0]=*reinterpret_cast<const bf16x8*>(&Qw[(long)r32*DM+d0*16+hi*8]);
  float mhat=0.f,l_reg=0.f;f32x16 o[2];o[0]=f32x16{};o[1]=f32x16{};f32x16 negm=f32x16{};asm volatile("":"+v"(negm));
  const int qrel=wid*QBLK+r32;
  #define CMASK(P0,P1,t) do{}while(0)
  bool resc=false;
  #define START(P0,P1) do{ const float rm=rowmax(P0,P1); resc=false; \
    { const float dl=rm; mhat=fadd_s(mhat,dl); \
      _Pragma("unroll") for(int r=0;r<16;++r){P0[r]=fsub_s(P0[r],dl);P1[r]=fsub_s(P1[r],dl);} \
      _Pragma("unroll") for(int r=0;r<16;++r)negm[r]=-mhat; asm volatile("":"+v"(negm)); } \
    _Pragma("unroll") for(int r=0;r<16;++r)P0[r]=__builtin_amdgcn_exp2f(P0[r]); }while(0)
  #define RESC() do{ if(resc){ asm volatile("s_waitcnt lgkmcnt(0)":::"memory"); \
      _Pragma("unroll") for(int d_=0;d_<2;++d_) _Pragma("unroll") for(int r=0;r<16;++r)o[d_][r]*=wsf[crow(r,hi)]; } }while(0)
  f32x16 pA0,pA1,pB0,pB1;
  int sl_prev=0,sl_cur=0,sl_next=SLOTB;
  #define ROT() do{sl_prev=sl_cur;sl_cur=sl_next;sl_next=(sl_next==(NSLOT-1)*SLOTB)?0:sl_next+SLOTB;}while(0)
  DMA_K(2,2*SLOTB);
  WAIT_BAR(3);
  qkt(pA0,pA1,Kbase,qr,negm,r32,hi);asm volatile("s_nop 15\n\ts_nop 7":"+v"(pA0),"+v"(pA1));CMASK(pA0,pA1,0);
  START(pA0,pA1);
  _Pragma("unroll") for(int r=0;r<16;++r)pA1[r]=__builtin_amdgcn_exp2f(pA1[r]);
  WAIT_BAR(0);
  DMA_K(3,0);DMA_V(1,SLOTB);
  ROT();
  kload8(kf,kp0+sl_cur);
  WAIT_BAR(2);
  s16x4 vlo[8],vhi[8]; u32x4 pw0,pw1,pw2,pw3;
  #define PKW(P,B) cvtpk_s(P[B],P[B+1])
  #define PAF(k) __builtin_bit_cast(bf16x8,pw##k)
  #define VFR(i) (bf16x8){vlo[i][0],vlo[i][1],vlo[i][2],vlo[i][3],vhi[i][0],vhi[i][1],vhi[i][2],vhi[i][3]}
  #define PIN(x) asm volatile("":"+v"(x))
  #define MX3(a,b,c) __builtin_fmaxf(__builtin_fmaxf((a),(b)),(c))
  #define GAPA(MF,A0,A1,A2,A3,W0,W1,PW) do{ MF; sacc+=A0; sacc+=A1; sacc+=A2; sacc+=A3; PIN(sacc); W0; W1; PIN(PW); SBAR(); }while(0)
  #define EX(v) __builtin_amdgcn_exp2f(v)
  #define GAPB(MF,X,B) do{ MF; X[B]=EX(X[B]); X[B+1]=EX(X[B+1]); X[B+2]=EX(X[B+2]); X[B+3]=EX(X[B+3]); PIN(X); SBAR(); }while(0)
  #define VRD(i) do{ vlo[i]=vtr(vp_+(((i)>>2)*4096+((i)&3)*1024)); vhi[i]=vtr(vp_+(((i)>>2)*4096+((i)&3)*1024+512)); }while(0)
  #define KRD(G,j) do{ if(G){ kload2(kf,kp0+sl_next,j); SBAR(); } }while(0)
  #define STEP(C0,C1,P0,P1,t,GK,GV,GL) do{ SBAR(); \
    const lds_cptr vp_=vp0+sl_prev; \
    VRD(0); SBAR(); float sacc=(P0[0]+P0[1]); \
    GAPA(C0=__builtin_amdgcn_mfma_f32_32x32x16_bf16(kf[0],qr[0],negm,0,0,0), P0[2],P0[3],P0[4],P0[5],     pw0[0]=PKW(P0,0), pw0[1]=PKW(P0,2), pw0); \
    VRD(4); SBAR(); GAPA(C1=__builtin_amdgcn_mfma_f32_32x32x16_bf16(kf[1],qr[0],negm,0,0,0), P0[6],P0[7],P0[8],P0[9],     pw0[2]=PKW(P0,4), pw0[3]=PKW(P0,6), pw0); \
    VRD(1); SBAR(); GAPA(C0=__builtin_amdgcn_mfma_f32_32x32x16_bf16(kf[2],qr[1],C0,0,0,0),   P0[10],P0[11],P0[12],P0[13], pw1[0]=PKW(P0,8), pw1[1]=PKW(P0,10), pw1); \
    VRD(5); SBAR(); GAPA(C1=__builtin_amdgcn_mfma_f32_32x32x16_bf16(kf[3],qr[1],C1,0,0,0),   P0[14],P0[15],P1[0],P1[1],   pw1[2]=PKW(P0,12),pw1[3]=PKW(P0,14), pw1); \
    VRD(2); SBAR(); GAPA(C0=__builtin_amdgcn_mfma_f32_32x32x16_bf16(kf[4],qr[2],C0,0,0,0),   P1[2],P1[3],P1[4],P1[5],     pw2[0]=PKW(P1,0), pw2[1]=PKW(P1,2), pw2); \
    VRD(6); SBAR(); GAPA(C1=__builtin_amdgcn_mfma_f32_32x32x16_bf16(kf[5],qr[2],C1,0,0,0),   P1[6],P1[7],P1[8],P1[9],     pw2[2]=PKW(P1,4), pw2[3]=PKW(P1,6), pw2); \
    VRD(3); SBAR(); GAPA(C0=__builtin_amdgcn_mfma_f32_32x32x16_bf16(kf[6],qr[3],C0,0,0,0),   P1[10],P1[11],P1[12],P1[13], pw3[0]=PKW(P1,8), pw3[1]=PKW(P1,10), pw3); \
    VRD(7); SBAR(); GAPA(C1=__builtin_amdgcn_mfma_f32_32x32x16_bf16(kf[7],qr[3],C1,0,0,0),   P1[14],P1[15],0.f,0.f,       pw3[2]=PKW(P1,12),pw3[3]=PKW(P1,14), pw3); \
    l_reg+=sacc; \
    if(GK){DMA_K((t)+3,sl_cur);} if(GV){DMA_V((t)+1,sl_next);} \
    CMASK(C0,C1,t); \
    { float a=MX3(C0[0],C0[1],C1[0]),b=MX3(C0[2],C0[3],C1[1]); a=MX3(a,C1[2],C1[3]); \
      _Pragma("unroll") for(int r=4;r<16;r+=4){a=MX3(a,C0[r],C0[r+1]);b=MX3(b,C0[r+2],C0[r+3]);a=MX3(a,C1[r],C1[r+1]);b=MX3(b,C1[r+2],C1[r+3]);} \
      float rm=__builtin_fmaxf(a,b); { auto rr=__builtin_amdgcn_permlane32_swap(__float_as_uint(rm),__float_as_uint(rm),false,false); rm=__builtin_fmaxf(__uint_as_float(rr[0]),__uint_as_float(rr[1])); } \
      resc=false; \
      if(__builtin_expect(__any(rm>(float)THRL),0)){ const float dl=__builtin_fmaxf(rm,0.f); mhat+=dl; \
        _Pragma("unroll") for(int r=0;r<16;++r){C0[r]-=dl;C1[r]-=dl;} \
        _Pragma("unroll") for(int r=0;r<16;++r)negm[r]=-mhat; asm volatile("":"+v"(negm)); \
        const float f=__builtin_amdgcn_exp2f(-dl); l_reg*=f; if(hi==0)wsf[r32]=f; resc=true; } } \
    SBAR(); \
    GAPB(o[0]=__builtin_amdgcn_mfma_f32_32x32x16_bf16(PAF(0),VFR(0),o[0],0,0,0), C0,0); \
    GAPB(o[1]=__builtin_amdgcn_mfma_f32_32x32x16_bf16(PAF(0),VFR(4),o[1],0,0,0), C0,4); \
    KRD(GL,0); GAPB(o[0]=__builtin_amdgcn_mfma_f32_32x32x16_bf16(PAF(1),VFR(1),o[0],0,0,0), C0,8); \
    KRD(GL,1); GAPB(o[1]=__builtin_amdgcn_mfma_f32_32x32x16_bf16(PAF(1),VFR(5),o[1],0,0,0), C0,12); \
    KRD(GL,2); GAPB(o[0]=__builtin_amdgcn_mfma_f32_32x32x16_bf16(PAF(2),VFR(2),o[0],0,0,0), C1,0); \
    KRD(GL,3); GAPB(o[1]=__builtin_amdgcn_mfma_f32_32x32x16_bf16(PAF(2),VFR(6),o[1],0,0,0), C1,4); \
    GAPB(o[0]=__builtin_amdgcn_mfma_f32_32x32x16_bf16(PAF(3),VFR(3),o[0],0,0,0), C1,8); \
    GAPB(o[1]=__builtin_amdgcn_mfma_f32_32x32x16_bf16(PAF(3),VFR(7),o[1],0,0,0), C1,12); \
    }while(0)
  int t=1;
  #undef CMASK
  #define CMASK(P0,P1,t) do{}while(0)
  for(;t+5<NT;t+=2){
    STEP(pB0,pB1,pA0,pA1,t,true,true,true);     WAIT_BAR(2); RESC(); ROT();
    STEP(pA0,pA1,pB0,pB1,t+1,true,true,true);   WAIT_BAR(2); RESC(); ROT();
  }
  #undef CMASK
  #define CMASK(P0,P1,t) do{}while(0)
  #define ENDW(tt) do{ if((tt)+3<NT){WAIT_BAR(2);} else if((tt)+2<NT){WAIT_BAR(1);} else {WAIT_BAR(0);} }while(0)
  for(;t+1<NT;t+=2){
    STEP(pB0,pB1,pA0,pA1,t,(t+3<NT),(t+1<NT),(t+1<NT));       ENDW(t);   RESC(); ROT();
    STEP(pA0,pA1,pB0,pB1,t+1,(t+4<NT),(t+2<NT),(t+2<NT));     ENDW(t+1); RESC(); ROT();
  }
  STEP(pB0,pB1,pA0,pA1,NT-1,false,false,false); RESC();
  { float sacc=pB0[0]+pB0[1]; _Pragma("unroll") for(int r=2;r<16;++r)sacc+=pB0[r]; _Pragma("unroll") for(int r=0;r<16;++r)sacc+=pB1[r]; l_reg+=sacc;
    pw0=(u32x4){PKW(pB0,0),PKW(pB0,2),PKW(pB0,4),PKW(pB0,6)};pw1=(u32x4){PKW(pB0,8),PKW(pB0,10),PKW(pB0,12),PKW(pB0,14)};pw2=(u32x4){PKW(pB1,0),PKW(pB1,2),PKW(pB1,4),PKW(pB1,6)};pw3=(u32x4){PKW(pB1,8),PKW(pB1,10),PKW(pB1,12),PKW(pB1,14)};
    SBAR(); pv(o,vb0+sl_cur,PAF(0),PAF(1),PAF(2),PAF(3)); }
  #undef PKW
  #undef PAF
  #undef VFR
  #undef PIN
  #undef MX3
  #undef GAPA
  #undef GAPB
  #undef EX
  #undef VRD
  #undef KRD
  #undef STEP
  #undef ENDW
  {auto rr=__builtin_amdgcn_permlane32_swap(__float_as_uint(l_reg),__float_as_uint(l_reg),false,false);l_reg=__uint_as_float(rr[0])+__uint_as_float(rr[1]);}
  if(hi==0)wsf[32+r32]=l_reg;asm volatile("s_waitcnt lgkmcnt(0)":::"memory");
  float rli[16];
  #pragma unroll
  for(int r=0;r<16;++r)rli[r]=__builtin_amdgcn_rcpf(wsf[32+crow(r,hi)]);
  bf16*Ow=O+(rowbase+q0+wid*QBLK)*DM+h*D;
  { bf16*stg=(bf16*)(shm+LDS_OST)+wid*2048;
    #pragma unroll
    for(int r=0;r<16;++r){const int orow=crow(r,hi);
      #pragma unroll
      for(int d0=0;d0<2;++d0)stg[orow*64+d0*32+r32]=__float2bfloat16(o[d0][r]*rli[r]);}
    asm volatile("s_waitcnt lgkmcnt(0)":::"memory");
    #pragma unroll
    for(int i=0;i<4;++i){const int row=i*8+(lane>>3),ch=lane&7; const u32x4 v=*(const u32x4*)(stg+row*64+ch*8); ATTN_STORE16(Ow+(long)row*DM+ch*8,v);} }
  asm volatile("s_waitcnt lgkmcnt(0)\n\ts_barrier":::"memory");
  #undef DMA_K
  #undef DMA_V
  #undef CMASK
  #undef START
  #undef RESC
  #undef ROT
}
constexpr int ATTN_LDS_BYTES=LDS_BYTES;
struct AttnTensors { const bf16* Q; const bf16* K; const bf16* V; bf16* O; };
struct AttnUnit { int bh; int qb; };
struct StaticOrder {
  int vcu;
  __device__ __forceinline__ explicit StaticOrder(int grid,int block):vcu((block%8)*(grid/8)+block/8){}
  __device__ __forceinline__ bool next(int i,AttnUnit&u)const{ if(i>=4)return false; const int x=vcu>>5,c=vcu&31,idx=32*i+c; u.bh=2*x+(idx>>6); u.qb=idx&63; return true; }
  __device__ __forceinline__ void a_ready(const AttnUnit&)const{}
  __device__ __forceinline__ void done(const AttnUnit&)const{}
};
template<class Sched,int THRL=8> __device__ __forceinline__ void attn_phase(char*lds,const AttnTensors&T,const Sched&S){
  AttnUnit u;
  for(int i=0;S.next(i,u);++i){ S.a_ready(u); attn_unit<THRL>(u.bh/NHEAD,u.bh%NHEAD,u.qb,T.Q,T.K,T.V,T.O,lds); S.done(u); }
}
#undef SBAR
#undef WAIT_BAR
}
constexpr int NWAVES = 8;
constexpr int M = 16384, D = 1024, FF = 2816, NIN = 4096, MEMLEN = 256, NCH = 512;
constexpr float C2Q = 0.125f * 1.4426950408889634f;
constexpr size_t MiB = 1u << 20, KiB = 1u << 10;
constexpr size_t WS_CTL = 0, CTL_ZERO_BYTES = 1 * MiB;
constexpr size_t WS_SS2 = 256 * KiB, WS_SS3 = 320 * KiB, WS_SS4 = 384 * KiB, WS_SS5 = 448 * KiB;
constexpr size_t WS_SMALL = 1 * MiB;
constexpr size_t WS_RS1 = WS_SMALL, WS_ROPE = WS_SMALL + 64 * KiB, WS_DFT = WS_SMALL + 112 * KiB, WS_TW = WS_SMALL + 128 * KiB, WS_KC = WS_SMALL + 256 * KiB, WS_VC = WS_SMALL + 384 * KiB;
constexpr size_t WS_W1GU = 2 * MiB, WS_W1D = 13 * MiB, WS_W2GU = 18 * MiB + 512 * KiB, WS_W2D = 29 * MiB + 512 * KiB, WS_WIN = 35 * MiB, WS_WFB = 43 * MiB, WS_WAB = 45 * MiB, WS_WOUT = 47 * MiB,
                 WS_WCQ = 49 * MiB, WS_WCO = 49 * MiB + 512 * KiB;
constexpr size_t WS_HB16 = 56 * MiB;
constexpr size_t WS_R1 = 88 * MiB;
constexpr size_t WS_QO = WS_R1, WS_U = WS_R1 + 32 * MiB, WS_KR = WS_R1 + 64 * MiB, WS_VR = WS_R1 + 72 * MiB, WS_F = WS_R1 + 80 * MiB;
constexpr size_t WS_QC = WS_R1, WS_OC = WS_R1 + 8 * MiB;
constexpr size_t WS_GF = 184 * MiB, WS_GA = 216 * MiB, WS_END = 248 * MiB;
static_assert(WS_W1GU + (size_t)2 * FF * D * 2 == WS_W1D && WS_W1D + (size_t)D * FF * 2 == WS_W2GU && WS_W2GU + (size_t)2 * FF * D * 2 == WS_W2D && WS_W2D + (size_t)D * FF * 2 == WS_WIN, "weights map");
static_assert(WS_R1 + (size_t)M * FF * 2 <= WS_GF && WS_F + (size_t)M * NCH * 2 <= WS_GF, "R1 map");
constexpr int CW_BAR = 4096;
constexpr int RING_BYTES = 131072, LDSCTL_OFF = RING_BYTES, MISC_OFF = LDSCTL_OFF + 320, LDS_BYTES = 147456;

#define GAS __attribute__((address_space(1)))
#define LAS __attribute__((address_space(3)))
typedef unsigned short bf16;
typedef unsigned v4u __attribute__((ext_vector_type(4)));
typedef float f32x4 __attribute__((ext_vector_type(4)));
typedef float f32x2 __attribute__((ext_vector_type(2)));
#define LDS_WAIT() asm volatile("s_waitcnt lgkmcnt(0)" ::: "memory")
#define VM_WAIT() asm volatile("s_waitcnt vmcnt(0)" ::: "memory")
__device__ __forceinline__ unsigned f2bf(float f) { unsigned u = __builtin_bit_cast(unsigned, f); return (u + 0x7fffu + ((u >> 16) & 1u)) >> 16; }
__device__ __forceinline__ unsigned pk2(float lo, float hi) { return f2bf(lo) | (f2bf(hi) << 16); }
__device__ __forceinline__ float bf2f(unsigned short b) { return __uint_as_float((unsigned)b << 16); }
__device__ __forceinline__ float bflo_(unsigned u) { return __uint_as_float(u << 16); }
__device__ __forceinline__ float bfhi_(unsigned u) { return __uint_as_float(u & 0xffff0000u); }
constexpr float RMS_EPSF = 1e-6f;
__device__ __forceinline__ float wave_sum(float v) {
#pragma unroll
    for (int o = 1; o < 64; o <<= 1) v += __shfl_xor(v, o);
    return v;
}
__device__ __forceinline__ void sincos_rev(double x, float& s, float& c) {
    x -= __builtin_floor(x);
    const double q = __builtin_rint(x * 4.0);
    const double r = (x - q * 0.25) * 6.283185307179586476925;
    const double r2 = r * r;
    double sp = 1.0 / 6227020800.0; sp = sp * r2 - 1.0 / 39916800.0; sp = sp * r2 + 1.0 / 362880.0; sp = sp * r2 - 1.0 / 5040.0; sp = sp * r2 + 1.0 / 120.0; sp = sp * r2 - 1.0 / 6.0; sp = sp * r2 + 1.0; sp *= r;
    double cp = -1.0 / 87178291200.0; cp = cp * r2 + 1.0 / 479001600.0; cp = cp * r2 - 1.0 / 3628800.0; cp = cp * r2 + 1.0 / 40320.0; cp = cp * r2 - 1.0 / 720.0; cp = cp * r2 + 1.0 / 24.0; cp = cp * r2 - 0.5; cp = cp * r2 + 1.0;
    const int qi = (int)q & 3;
    const double ss = (qi == 0) ? sp : (qi == 1) ? cp : (qi == 2) ? -sp : -cp;
    const double cc = (qi == 0) ? cp : (qi == 1) ? -sp : (qi == 2) ? -cp : sp;
    s = (float)ss; c = (float)cc;
}

struct Frame {
    LAS unsigned char* lds;
    int tid, lane, wave, G, vcu;
    const float* in[24]; float* out; unsigned char* ws;
};
template <class T> __device__ __forceinline__ T* wsp(const Frame& F, size_t off) { return (T*)(F.ws + off); }

__device__ __forceinline__ void p0_transpose_item(const float* W, const float* gain, int K, int N, bf16* WT, int gu, LAS float* scr, int item, int lane) {
    const int nblk = N / 32, kb = item / nblk, nb = item % nblk, k0 = 64 * kb, n0 = 32 * nb;
#pragma unroll 8
    for (int i = 0; i < 32; ++i) { const int kk = 2 * i + (lane >> 5); float v = W[(size_t)(k0 + kk) * N + n0 + (lane & 31)]; if (gain) v *= gain[k0 + kk]; scr[kk * 33 + (lane & 31)] = v; }
    LDS_WAIT(); asm volatile("" ::: "memory");
    const int c = lane & 7;
    const int rb = (gu == 0) ? n0 : (256 * (n0 >> 7) + (n0 & 127) + (gu == 2 ? 128 : 0));
#pragma unroll
    for (int j = 0; j < 4; ++j) { const int n = (lane >> 3) + 8 * j; const LAS float* s = scr + (8 * c) * 33 + n;
        v4u o; o.x = pk2(s[0 * 33], s[1 * 33]); o.y = pk2(s[2 * 33], s[3 * 33]); o.z = pk2(s[4 * 33], s[5 * 33]); o.w = pk2(s[6 * 33], s[7 * 33]);
        *(GAS v4u*)(WT + (size_t)(rb + n) * K + k0 + 8 * c) = o; }
    LDS_WAIT(); asm volatile("" ::: "memory");
}
__device__ __forceinline__ void p0_prologue(Frame& F) {
    const int gw = F.vcu * NWAVES + F.wave, NGW = F.G * NWAVES;
    const int gt = blockIdx.x * (NWAVES * 64) + F.tid, NGT = F.G * NWAVES * 64;
    {
        f32x2* tw = wsp<f32x2>(F, WS_TW); f32x2* dft = wsp<f32x2>(F, WS_DFT); float* rope = wsp<float>(F, WS_ROPE);
        for (int i = gt; i < 16384; i += NGT) { float s, c; sincos_rev((double)i * (1.0 / 16384.0), s, c); tw[i] = (f32x2){c, s}; }
        for (int i = gt; i < 128; i += NGT) { float s, c; sincos_rev((double)i * (1.0 / 128.0), s, c); dft[i] = (f32x2){c, s}; }
        for (int i = gt; i < (256 + 64) * 16; i += NGT) {
            const int j = i & 15, p = i >> 4; const int pos = (p < 256) ? p : p - 256;
            double inv = 1.0; for (int q = 0; q < j; ++q) inv *= 0.5623413251903491;
            const float ang = (float)pos * (float)inv;
            float s, c; sincos_rev((double)ang * 0.15915494309189533577, s, c);
            if (p < 256) { rope[p * 16 + j] = c; rope[4096 + p * 16 + j] = s; } else { rope[8192 + pos * 16 + j] = c; rope[8192 + 1024 + pos * 16 + j] = s; }
        }
    }
    {
        LAS float* scr = (LAS float*)(F.lds + F.wave * 16384);
        constexpr int I_GU = (D / 64) * (FF / 32), I_DN = (FF / 64) * (D / 32), I_IN = (D / 64) * (NIN / 32), I_SQ = (D / 64) * (D / 32), I_CQ = (D / 64) * (256 / 32), I_CO = (256 / 64) * (D / 32);
        constexpr int NITEMS = 4 * I_GU + 2 * I_DN + I_IN + 2 * I_SQ + I_CQ + I_CO;
        for (int it = gw; it < NITEMS; it += NGW) {
            int r = it;
            if (r < I_GU) { p0_transpose_item(F.in[3], F.in[2], D, FF, wsp<bf16>(F, WS_W1GU), 1, scr, r, F.lane); continue; } r -= I_GU;
            if (r < I_GU) { p0_transpose_item(F.in[4], F.in[2], D, FF, wsp<bf16>(F, WS_W1GU), 2, scr, r, F.lane); continue; } r -= I_GU;
            if (r < I_DN) { p0_transpose_item(F.in[5], nullptr, FF, D, wsp<bf16>(F, WS_W1D), 0, scr, r, F.lane); continue; } r -= I_DN;
            if (r < I_GU) { p0_transpose_item(F.in[20], F.in[19], D, FF, wsp<bf16>(F, WS_W2GU), 1, scr, r, F.lane); continue; } r -= I_GU;
            if (r < I_GU) { p0_transpose_item(F.in[21], F.in[19], D, FF, wsp<bf16>(F, WS_W2GU), 2, scr, r, F.lane); continue; } r -= I_GU;
            if (r < I_DN) { p0_transpose_item(F.in[22], nullptr, FF, D, wsp<bf16>(F, WS_W2D), 0, scr, r, F.lane); continue; } r -= I_DN;
            if (r < I_IN) { p0_transpose_item(F.in[7], F.in[6], D, NIN, wsp<bf16>(F, WS_WIN), 0, scr, r, F.lane); continue; } r -= I_IN;
            if (r < I_SQ) { p0_transpose_item(F.in[11], nullptr, D, D, wsp<bf16>(F, WS_WAB), 0, scr, r, F.lane); continue; } r -= I_SQ;
            if (r < I_SQ) { p0_transpose_item(F.in[12], nullptr, D, D, wsp<bf16>(F, WS_WOUT), 0, scr, r, F.lane); continue; } r -= I_SQ;
            if (r < I_CQ) { p0_transpose_item(F.in[15], F.in[13], D, 256, wsp<bf16>(F, WS_WCQ), 0, scr, r, F.lane); continue; } r -= I_CQ;
            p0_transpose_item(F.in[18], nullptr, 256, D, wsp<bf16>(F, WS_WCO), 0, scr, r, F.lane);
        }
    }
    __syncthreads();
    {
        LAS f32x2* tab = (LAS f32x2*)F.lds;
        if (F.tid < 128) { float s, c; sincos_rev((double)F.tid * (1.0 / 128.0), s, c); tab[F.tid] = (f32x2){c * 0.08838834764831845f, s * 0.08838834764831845f}; }
        __syncthreads();
        const float* Wfb = F.in[10]; bf16* WT = wsp<bf16>(F, WS_WFB);
        for (int it = gt; it < 1024 * 128; it += NGT) {
            const int n = it & 1023, kb = it >> 10, kk0 = kb * 8, g = kk0 >> 8, ri = (kk0 >> 7) & 1, c0 = kk0 & 127;
            float a[8];
#pragma unroll
            for (int i = 0; i < 8; ++i) a[i] = 0.f;
            for (int j = 0; j < 128; ++j) {
                const float w = Wfb[(size_t)(g * 128 + j) * 1024 + n];
#pragma unroll
                for (int i = 0; i < 8; ++i) { const f32x2 cs = tab[((c0 + i) * j) & 127]; a[i] += w * (ri ? cs.y : cs.x); }
            }
            v4u o; o.x = pk2(a[0], a[1]); o.y = pk2(a[2], a[3]); o.z = pk2(a[4], a[5]); o.w = pk2(a[6], a[7]);
            *(GAS v4u*)(WT + (size_t)n * 1024 + kk0) = o;
        }
        __syncthreads();
    }
    {
        const float* x = F.in[0]; bf16* xb = wsp<bf16>(F, WS_HB16); float* rs1 = wsp<float>(F, WS_RS1);
        for (int m = gw; m < M; m += NGW) {
            const GAS f32x4* xr = (const GAS f32x4*)(x + (size_t)m * D) + F.lane;
            f32x4 v[4]; float s = 0.f;
#pragma unroll
            for (int j = 0; j < 4; ++j) { v[j] = xr[64 * j]; s += (v[j].x * v[j].x + v[j].y * v[j].y) + (v[j].z * v[j].z + v[j].w * v[j].w); }
            s = wave_sum(s);
            GAS unsigned long long* o8 = (GAS unsigned long long*)(xb + (size_t)m * D) + F.lane;
#pragma unroll
            for (int j = 0; j < 4; ++j) o8[64 * j] = (unsigned long long)pk2(v[j].x, v[j].y) | ((unsigned long long)pk2(v[j].z, v[j].w) << 32);
            if (F.lane == 0) rs1[m] = 1.0f / sqrtf(s * (1.0f / D) + RMS_EPSF);
        }
    }
    {
        LAS float* mn = (LAS float*)(F.lds + 8192); LAS float* red = (LAS float*)(F.lds + 8192 + 4096);
        const float* mem = F.in[1]; const float* gm = F.in[14]; const float* Wk = F.in[16]; const float* Wv = F.in[17];
        bf16* Kc = wsp<bf16>(F, WS_KC); bf16* Vc = wsp<bf16>(F, WS_VC);
        for (int r = blockIdx.x; r < MEMLEN; r += F.G) {
            __syncthreads();
            const float a = mem[(size_t)r * D + F.tid], b = mem[(size_t)r * D + 512 + F.tid];
            float s = wave_sum(a * a + b * b);
            if (F.lane == 0) red[F.wave] = s;
            __syncthreads();
            float tot = 0.f;
#pragma unroll
            for (int w = 0; w < NWAVES; ++w) tot += red[w];
            const float rinv = 1.0f / sqrtf(tot * (1.0f / D) + RMS_EPSF);
            mn[F.tid] = a * rinv * gm[F.tid]; mn[512 + F.tid] = b * rinv * gm[512 + F.tid];
            __syncthreads();
            const int n = F.tid & 255; const float* W = (F.tid < 256) ? Wk : Wv; float acc = 0.f;
            for (int k = 0; k < D; ++k) acc += mn[k] * W[(size_t)k * 256 + n];
            ((F.tid < 256) ? Kc : Vc)[r * 256 + n] = (bf16)f2bf(acc);
        }
        __syncthreads();
    }
}

__device__ __forceinline__ void p_prep_qk(Frame& F) {
    bf16* Q = wsp<bf16>(F, WS_QO); bf16* Kr = wsp<bf16>(F, WS_KR); const float* rope = wsp<float>(F, WS_ROPE);
    const float* qg = F.in[8]; const float* kg = F.in[9];
    const int gt = blockIdx.x * (NWAVES * 64) + F.tid, NGT = F.G * NWAVES * 64;
    for (int it = gt; it < M * 20; it += NGT) {
        const int t = it / 20, hh = it - t * 20;
        bf16* p = (hh < 16) ? (Q + (size_t)t * 1024 + hh * 64) : (Kr + (size_t)t * 256 + (hh - 16) * 64);
        const float* gain = (hh < 16) ? qg : kg; const float post = (hh < 16) ? C2Q : 1.0f;
        float v[64];
#pragma unroll
        for (int i = 0; i < 8; ++i) { const v4u w = *(const GAS v4u*)(p + 8 * i);
            v[8 * i + 0] = __uint_as_float(w.x << 16); v[8 * i + 1] = __uint_as_float(w.x & 0xffff0000u); v[8 * i + 2] = __uint_as_float(w.y << 16); v[8 * i + 3] = __uint_as_float(w.y & 0xffff0000u);
            v[8 * i + 4] = __uint_as_float(w.z << 16); v[8 * i + 5] = __uint_as_float(w.z & 0xffff0000u); v[8 * i + 6] = __uint_as_float(w.w << 16); v[8 * i + 7] = __uint_as_float(w.w & 0xffff0000u); }
        float s = 0.f;
#pragma unroll
        for (int i = 0; i < 64; ++i) s += v[i] * v[i];
        const float rinv = 1.0f / sqrtf(s * (1.0f / 64.0f) + RMS_EPSF);
#pragma unroll
        for (int i = 0; i < 64; ++i) v[i] = v[i] * rinv * gain[i];
        const int row = t >> 6, col = t & 63;
#pragma unroll
        for (int j = 0; j < 16; ++j) {
            const float cr = rope[row * 16 + j], sr = rope[4096 + row * 16 + j], cc = rope[8192 + col * 16 + j], sc = rope[8192 + 1024 + col * 16 + j];
            const float a = v[j], b = v[16 + j]; v[j] = a * cr - b * sr; v[16 + j] = b * cr + a * sr;
            const float e = v[32 + j], f = v[48 + j]; v[32 + j] = e * cc - f * sc; v[48 + j] = f * cc + e * sc;
        }
#pragma unroll
        for (int i = 0; i < 8; ++i) { v4u o; o.x = pk2(v[8 * i] * post, v[8 * i + 1] * post); o.y = pk2(v[8 * i + 2] * post, v[8 * i + 3] * post); o.z = pk2(v[8 * i + 4] * post, v[8 * i + 5] * post); o.w = pk2(v[8 * i + 6] * post, v[8 * i + 7] * post);
            *(GAS v4u*)(p + 8 * i) = o; }
    }
}
__device__ __forceinline__ void p_fftA_simple(Frame& F) {
    const bf16* X = wsp<bf16>(F, WS_F); bf16* A = wsp<bf16>(F, WS_HB16); const f32x2* tw = wsp<f32x2>(F, WS_TW); const f32x2* dft = wsp<f32x2>(F, WS_DFT);
    LAS bf16* Xs = (LAS bf16*)F.lds; LAS f32x2* tab = (LAS f32x2*)(F.lds + 65536);
    if (F.tid < 128) tab[F.tid] = dft[F.tid];
    for (int unit = blockIdx.x; unit < 512; unit += F.G) {
        const int t2 = unit >> 2, g = unit & 3;
        __syncthreads();
#pragma unroll
        for (int i = 0; i < 4; ++i) { const int q = F.tid + 512 * i, row = q >> 4, ch = q & 15;
            *(LAS v4u*)(Xs + row * 128 + ch * 8) = *(const GAS v4u*)(X + (size_t)(128 * row + t2) * NCH + g * 128 + ch * 8); }
        __syncthreads();
        const int c = F.tid & 127, kq = F.tid >> 7;
        for (int k1 = kq * 32; k1 < kq * 32 + 32; ++k1) {
            float ar = 0.f, ai = 0.f; int idx = 0;
#pragma unroll 8
            for (int t1 = 0; t1 < 128; ++t1) { const float x = bf2f(Xs[t1 * 128 + c]); const f32x2 cs = tab[idx]; ar += x * cs.x; ai -= x * cs.y; idx = (idx + k1) & 127; }
            ar *= 0.08838834764831845f; ai *= 0.08838834764831845f;
            const f32x2 w = tw[t2 * k1];
            const float br = ar * w.x + ai * w.y, bi = ai * w.x - ar * w.y;
            bf16* o = A + ((size_t)(k1 * 128 + t2) * 4 + g) * 256 + c;
            o[0] = (bf16)f2bf(br); o[128] = (bf16)f2bf(bi);
        }
    }
    __syncthreads();
}
__device__ __forceinline__ void p_fftB_simple(Frame& F) {
    const bf16* A = wsp<bf16>(F, WS_HB16); bf16* U = wsp<bf16>(F, WS_U); const f32x2* dft = wsp<f32x2>(F, WS_DFT);
    LAS bf16* As = (LAS bf16*)F.lds; LAS f32x2* tab = (LAS f32x2*)(F.lds + 65536);
    if (F.tid < 128) tab[F.tid] = dft[F.tid];
    for (int unit = blockIdx.x; unit < 512; unit += F.G) {
        const int k1 = unit >> 2, g = unit & 3;
        __syncthreads();
#pragma unroll
        for (int i = 0; i < 8; ++i) { const int q = F.tid + 512 * i, row = q >> 5, ch = q & 31;
            *(LAS v4u*)(As + row * 256 + ch * 8) = *(const GAS v4u*)(A + ((size_t)(k1 * 128 + row) * 4 + g) * 256 + ch * 8); }
        __syncthreads();
        const int c = F.tid & 127, kq = F.tid >> 7;
        for (int k2 = kq * 32; k2 < kq * 32 + 32; ++k2) {
            float ur = 0.f, ui = 0.f; int idx = 0;
#pragma unroll 8
            for (int t2 = 0; t2 < 128; ++t2) { const float ar = bf2f(As[t2 * 256 + c]), ai = bf2f(As[t2 * 256 + 128 + c]); const f32x2 cs = tab[idx];
                ur += ar * cs.x + ai * cs.y; ui += ai * cs.x - ar * cs.y; idx = (idx + k2) & 127; }
            bf16* o = U + (size_t)(k1 + 128 * k2) * 1024 + g * 256 + c;
            o[0] = (bf16)f2bf(ur * 0.08838834764831845f); o[128] = (bf16)f2bf(ui * 0.08838834764831845f);
        }
    }
    __syncthreads();
}
__device__ __forceinline__ void p_attn_simple(Frame& F) {
    bf16* Q = wsp<bf16>(F, WS_QO); const bf16* Kr = wsp<bf16>(F, WS_KR); const bf16* Vr = wsp<bf16>(F, WS_VR);
    const int gt = blockIdx.x * (NWAVES * 64) + F.tid, NGT = F.G * NWAVES * 64;
    for (int it = gt; it < M * 16; it += NGT) {
        const int h = it >> 14, t = it & (M - 1), kvh = h >> 2;
        bf16* qp = Q + (size_t)t * 1024 + h * 64;
        float q[64], o[64];
#pragma unroll
        for (int i = 0; i < 8; ++i) { const v4u w = *(const GAS v4u*)(qp + 8 * i);
            q[8 * i + 0] = bflo_(w.x); q[8 * i + 1] = bfhi_(w.x); q[8 * i + 2] = bflo_(w.y); q[8 * i + 3] = bfhi_(w.y); q[8 * i + 4] = bflo_(w.z); q[8 * i + 5] = bfhi_(w.z); q[8 * i + 6] = bflo_(w.w); q[8 * i + 7] = bfhi_(w.w); }
#pragma unroll
        for (int i = 0; i < 64; ++i) o[i] = 0.f;
        float mx = -1e30f, l = 0.f;
        for (int key = 0; key < M; ++key) {
            const bf16* kp = Kr + (size_t)key * 256 + kvh * 64; const bf16* vp = Vr + (size_t)key * 256 + kvh * 64;
            float s = 0.f;
#pragma unroll
            for (int i = 0; i < 8; ++i) { const v4u w = *(const GAS v4u*)(kp + 8 * i);
                s += q[8 * i + 0] * bflo_(w.x) + q[8 * i + 1] * bfhi_(w.x) + q[8 * i + 2] * bflo_(w.y) + q[8 * i + 3] * bfhi_(w.y) + q[8 * i + 4] * bflo_(w.z) + q[8 * i + 5] * bfhi_(w.z) + q[8 * i + 6] * bflo_(w.w) + q[8 * i + 7] * bfhi_(w.w); }
            const float mn = fmaxf(mx, s), al = __builtin_amdgcn_exp2f(mx - mn), p = __builtin_amdgcn_exp2f(s - mn);
            l = l * al + p; mx = mn;
#pragma unroll
            for (int i = 0; i < 8; ++i) { const v4u w = *(const GAS v4u*)(vp + 8 * i);
                o[8 * i + 0] = o[8 * i + 0] * al + p * bflo_(w.x); o[8 * i + 1] = o[8 * i + 1] * al + p * bfhi_(w.x); o[8 * i + 2] = o[8 * i + 2] * al + p * bflo_(w.y); o[8 * i + 3] = o[8 * i + 3] * al + p * bfhi_(w.y);
                o[8 * i + 4] = o[8 * i + 4] * al + p * bflo_(w.z); o[8 * i + 5] = o[8 * i + 5] * al + p * bfhi_(w.z); o[8 * i + 6] = o[8 * i + 6] * al + p * bflo_(w.w); o[8 * i + 7] = o[8 * i + 7] * al + p * bfhi_(w.w); }
        }
        const float li = 1.0f / l;
#pragma unroll
        for (int i = 0; i < 8; ++i) { v4u w; w.x = pk2(o[8 * i] * li, o[8 * i + 1] * li); w.y = pk2(o[8 * i + 2] * li, o[8 * i + 3] * li); w.z = pk2(o[8 * i + 4] * li, o[8 * i + 5] * li); w.w = pk2(o[8 * i + 6] * li, o[8 * i + 7] * li);
            *(GAS v4u*)(qp + 8 * i) = w; }
    }
}
__device__ __forceinline__ void p_cross_simple(Frame& F) {
    const bf16* QC = wsp<bf16>(F, WS_QC); bf16* OC = wsp<bf16>(F, WS_OC); const bf16* Kc = wsp<bf16>(F, WS_KC); const bf16* Vc = wsp<bf16>(F, WS_VC);
    const int gt = blockIdx.x * (NWAVES * 64) + F.tid, NGT = F.G * NWAVES * 64;
    for (int it = gt; it < M * 4; it += NGT) {
        const int h = it >> 14, t = it & (M - 1);
        const bf16* qp = QC + (size_t)t * 256 + h * 64;
        float q[64], o[64];
#pragma unroll
        for (int i = 0; i < 8; ++i) { const v4u w = *(const GAS v4u*)(qp + 8 * i);
            q[8 * i + 0] = bflo_(w.x) * C2Q; q[8 * i + 1] = bfhi_(w.x) * C2Q; q[8 * i + 2] = bflo_(w.y) * C2Q; q[8 * i + 3] = bfhi_(w.y) * C2Q; q[8 * i + 4] = bflo_(w.z) * C2Q; q[8 * i + 5] = bfhi_(w.z) * C2Q; q[8 * i + 6] = bflo_(w.w) * C2Q; q[8 * i + 7] = bfhi_(w.w) * C2Q; }
#pragma unroll
        for (int i = 0; i < 64; ++i) o[i] = 0.f;
        float mx = -1e30f, l = 0.f;
        for (int key = 0; key < MEMLEN; ++key) {
            const bf16* kp = Kc + key * 256 + h * 64; const bf16* vp = Vc + key * 256 + h * 64;
            float s = 0.f;
#pragma unroll
            for (int i = 0; i < 8; ++i) { const v4u w = *(const GAS v4u*)(kp + 8 * i);
                s += q[8 * i + 0] * bflo_(w.x) + q[8 * i + 1] * bfhi_(w.x) + q[8 * i + 2] * bflo_(w.y) + q[8 * i + 3] * bfhi_(w.y) + q[8 * i + 4] * bflo_(w.z) + q[8 * i + 5] * bfhi_(w.z) + q[8 * i + 6] * bflo_(w.w) + q[8 * i + 7] * bfhi_(w.w); }
            const float mn = fmaxf(mx, s), al = __builtin_amdgcn_exp2f(mx - mn), p = __builtin_amdgcn_exp2f(s - mn);
            l = l * al + p; mx = mn;
#pragma unroll
            for (int i = 0; i < 8; ++i) { const v4u w = *(const GAS v4u*)(vp + 8 * i);
                o[8 * i + 0] = o[8 * i + 0] * al + p * bflo_(w.x); o[8 * i + 1] = o[8 * i + 1] * al + p * bfhi_(w.x); o[8 * i + 2] = o[8 * i + 2] * al + p * bflo_(w.y); o[8 * i + 3] = o[8 * i + 3] * al + p * bfhi_(w.y);
                o[8 * i + 4] = o[8 * i + 4] * al + p * bflo_(w.z); o[8 * i + 5] = o[8 * i + 5] * al + p * bfhi_(w.z); o[8 * i + 6] = o[8 * i + 6] * al + p * bflo_(w.w); o[8 * i + 7] = o[8 * i + 7] * al + p * bfhi_(w.w); }
        }
        const float li = 1.0f / l; bf16* op = OC + (size_t)t * 256 + h * 64;
#pragma unroll
        for (int i = 0; i < 8; ++i) { v4u w; w.x = pk2(o[8 * i] * li, o[8 * i + 1] * li); w.y = pk2(o[8 * i + 2] * li, o[8 * i + 3] * li); w.z = pk2(o[8 * i + 4] * li, o[8 * i + 5] * li); w.w = pk2(o[8 * i + 6] * li, o[8 * i + 7] * li);
            *(GAS v4u*)(op + 8 * i) = w; }
    }
}
__device__ __forceinline__ void p_final(Frame& F) {
    const int gw = F.vcu * NWAVES + F.wave, NGW = F.G * NWAVES; const float* gf = F.in[23];
    f32x4 gv[4];
#pragma unroll
    for (int j = 0; j < 4; ++j) gv[j] = ((const GAS f32x4*)gf)[F.lane + 64 * j];
    for (int m = gw; m < M; m += NGW) {
        GAS f32x4* xr = (GAS f32x4*)(F.out + (size_t)m * D) + F.lane;
        f32x4 v[4]; float s = 0.f;
#pragma unroll
        for (int j = 0; j < 4; ++j) { v[j] = xr[64 * j]; s += (v[j].x * v[j].x + v[j].y * v[j].y) + (v[j].z * v[j].z + v[j].w * v[j].w); }
        const float rinv = 1.0f / sqrtf(wave_sum(s) * (1.0f / D) + RMS_EPSF);
#pragma unroll
        for (int j = 0; j < 4; ++j) xr[64 * j] = v[j] * rinv * gv[j];
    }
}
#define XB_TMO      128
#define XB_XCNT(j)  (256  + 64 * (j))
#define XB_XSUB(j)  (1280 + 64 * (j))
#define XB_XGEN(j)  (2304 + 64 * (j))
#define XB_TOP      3328
#define XB_TOPGEN   3392
#define XCD_BAR_WORDS 3456
#define XB_SPIN_CAP (1u << 18)

__device__ __forceinline__ unsigned xb_ld(unsigned* p)              { return __hip_atomic_load(p, __ATOMIC_RELAXED, __HIP_MEMORY_SCOPE_AGENT); }
__device__ __forceinline__ unsigned xb_add(unsigned* p, unsigned v) { return __hip_atomic_fetch_add(p, v, __ATOMIC_RELAXED, __HIP_MEMORY_SCOPE_AGENT); }
__device__ __forceinline__ unsigned xb_xcc_id() { return (unsigned)__builtin_amdgcn_s_getreg((3 << 11) | 20) & 0xFu; }
#define XB_SPIN(cond, bar) do { unsigned _sp = 0; while (cond) { __builtin_amdgcn_s_sleep(1); \
    if ((++_sp & 255u) == 0u) { if (xb_ld(&(bar)[XB_TMO])) break; if (_sp > XB_SPIN_CAP) { atomicAdd(&(bar)[XB_TMO], 1u); break; } } } } while (0)

struct XcdBarrier {
    unsigned* bar; unsigned x;
    volatile LAS unsigned* st;
};

__device__ __forceinline__ XcdBarrier xcd_barrier_post(unsigned* bar, volatile LAS unsigned* st) {
    XcdBarrier b; b.bar = bar; b.x = xb_xcc_id(); b.st = st;
    if (threadIdx.x == 0) (void)xb_add(&bar[XB_XCNT(b.x)], 1u);
    return b;
}
__device__ __forceinline__ void xcd_barrier_complete(unsigned* bar, unsigned x, unsigned& nloc, unsigned& nx) {
    const unsigned G = gridDim.x * gridDim.y * gridDim.z;
    unsigned sum, cnt, mine, sp = 0u;
    for (;;) {
        sum = 0u; cnt = 0u; mine = 0u;
#pragma unroll
        for (unsigned j = 0; j < 16; ++j) { const unsigned c = xb_ld(&bar[XB_XCNT(j)]); sum += c; cnt += (c > 0u) ? 1u : 0u; mine = (j == x) ? c : mine; }
        if (sum == G) break;
        __builtin_amdgcn_s_sleep(1);
        if ((++sp & 255u) == 0u) { if (xb_ld(&bar[XB_TMO])) break; if (sp > XB_SPIN_CAP) { atomicAdd(&bar[XB_TMO], 1u); break; } }
    }
    nloc = mine > 0u ? mine : 1u; nx = cnt > 0u ? cnt : 1u;
}

__device__ __forceinline__ void xcd_barrier(const XcdBarrier& b) {
    asm volatile("s_waitcnt vmcnt(0)" ::: "memory");
    __syncthreads();
    if (threadIdx.x == 0) {
        unsigned* bar = b.bar;
        __builtin_amdgcn_s_waitcnt(0);
        unsigned nloc = b.st[0], nx = b.st[1];
        if (nloc == 0u) { xcd_barrier_complete(bar, b.x, nloc, nx); b.st[0] = nloc; b.st[1] = nx; }
        const unsigned old = xb_add(&bar[XB_XSUB(b.x)], 1u);
        const unsigned gen = old / nloc;
        if (old + 1u == (gen + 1u) * nloc) {
            __builtin_amdgcn_fence(__ATOMIC_RELEASE, "agent");
            asm volatile("s_waitcnt vmcnt(0)" ::: "memory");
            const unsigned og = xb_add(&bar[XB_TOP], 1u);
            const unsigned tg = og / nx;
            if (og + 1u == (tg + 1u) * nx) xb_add(&bar[XB_TOPGEN], 1u);
            else XB_SPIN(xb_ld(&bar[XB_TOPGEN]) == tg, bar);
            __builtin_amdgcn_fence(__ATOMIC_ACQUIRE, "agent");
            xb_add(&bar[XB_XGEN(b.x)], 1u);
            asm volatile("s_waitcnt vmcnt(0)" ::: "memory");
        } else {
            XB_SPIN(xb_ld(&bar[XB_XGEN(b.x)]) == gen, bar);
            __builtin_amdgcn_fence(__ATOMIC_ACQUIRE, "agent");
            asm volatile("s_waitcnt vmcnt(0)" ::: "memory");
        }
    }
    __syncthreads();
}
constexpr int N_PHASES = 15;
struct Args { const float* in[24]; float* out; unsigned char* ws; int ph_lo, ph_hi; };
__global__ void __launch_bounds__(NWAVES * 64, 2) mk_fwd(Args args) {
    extern __shared__ __attribute__((aligned(16))) unsigned char lds[];
    Frame F;
    F.lds = (LAS unsigned char*)lds;
    F.tid = threadIdx.x; F.lane = F.tid & 63; F.wave = __builtin_amdgcn_readfirstlane(F.tid >> 6);
    F.G = gridDim.x; { const int bx = blockIdx.x; F.vcu = (F.G % 8 == 0) ? (bx % 8) * (F.G / 8) + bx / 8 : bx; }
#pragma unroll
    for (int i = 0; i < 24; ++i) F.in[i] = args.in[i];
    F.out = args.out; F.ws = args.ws;
    const int lo = args.ph_lo, hi = args.ph_hi;
    for (int u = F.tid; u < (LDS_BYTES - LDSCTL_OFF) / 4; u += NWAVES * 64) ((LAS unsigned*)(F.lds + LDSCTL_OFF))[u] = 0u;
    __syncthreads();
    XcdBarrier bar = xcd_barrier_post((unsigned*)(F.ws + WS_CTL) + CW_BAR, (volatile LAS unsigned*)(F.lds + MISC_OFF) + 8);
#define IN(k) (lo <= (k) && (k) < hi)
#define BOTH(k) (IN(k) && IN((k) + 1))
#define GRID_BAR() xcd_barrier(bar)
#define GRID_BAR_CG() do { cooperative_groups::this_grid().sync(); } while (0)
    bf16* const HB16 = wsp<bf16>(F, WS_HB16); bf16* const HH = wsp<bf16>(F, WS_R1);
    bf16* const QO = wsp<bf16>(F, WS_QO); bf16* const UU = wsp<bf16>(F, WS_U); bf16* const KR = wsp<bf16>(F, WS_KR); bf16* const VR = wsp<bf16>(F, WS_VR); bf16* const FB = wsp<bf16>(F, WS_F);
    bf16* const GFB = wsp<bf16>(F, WS_GF); bf16* const GAB = wsp<bf16>(F, WS_GA); bf16* const QC = wsp<bf16>(F, WS_QC); bf16* const OC = wsp<bf16>(F, WS_OC);
    float* const SS2 = wsp<float>(F, WS_SS2); float* const SS3 = wsp<float>(F, WS_SS3); float* const SS4 = wsp<float>(F, WS_SS4);

    if (IN(0)) { p0_prologue(F); if (BOTH(0)) GRID_BAR_CG(); }
    if (IN(1)) {
        pg8::Gemm g{HB16, wsp<bf16>(F, WS_W1GU), M, 2 * FF, D}; pg8::StaticOrder S; S.init(M, 2 * FF, F.G, (int)blockIdx.x);
        pg8::EpiSwiGLU E{HH, FF, wsp<float>(F, WS_RS1), 0};
        pg8::gemm_phase<pg8::EpiSwiGLU, pg8::StaticOrder, true, true>(F.lds, g, S, E);
        if (BOTH(1)) GRID_BAR();
    }
    if (IN(2)) {
        pg8::Gemm g{HH, wsp<bf16>(F, WS_W1D), M, D, FF}; pg8::StaticOrder S; S.init(M, D, F.G, (int)blockIdx.x);
        pg8::EpiResid E{F.in[0], F.out, HB16, SS2, 0.5f, D};
        pg8::gemm_phase<pg8::EpiResid, pg8::StaticOrder, true, true>(F.lds, g, S, E);
        if (BOTH(2)) GRID_BAR();
    }
    if (IN(3)) {
        pg8::Gemm g{HB16, wsp<bf16>(F, WS_WIN), M, NIN, D}; pg8::StaticOrder S; S.init(M, NIN, F.G, (int)blockIdx.x);
        pg8::EpiRoute E{{QO, KR, VR, FB, GFB, GAB}, SS2, 1, 1, 0};
        pg8::gemm_phase<pg8::EpiRoute, pg8::StaticOrder, true, true>(F.lds, g, S, E);
        if (BOTH(3)) GRID_BAR();
    }
    if (IN(4)) { p_prep_qk(F); p_fftA_simple(F); if (BOTH(4)) GRID_BAR(); }
    if (IN(5)) { p_fftB_simple(F); if (BOTH(5)) GRID_BAR(); }
    if (IN(6)) {
#if defined(ATTN_SIMPLE)
        p_attn_simple(F);
#else
        static_assert(attn_body::ATTN_LDS_BYTES <= RING_BYTES, "attention LDS");
        const attn_body::AttnTensors AT{(const attn_body::bf16*)QO, (const attn_body::bf16*)KR, (const attn_body::bf16*)VR, (attn_body::bf16*)QO};
        const attn_body::StaticOrder S((int)F.G, (int)blockIdx.x);
        attn_body::attn_phase<attn_body::StaticOrder>((char*)lds, AT, S);
#endif
        if (BOTH(6)) GRID_BAR();
    }
    if (IN(7)) {
        { pg8::Gemm g{UU, wsp<bf16>(F, WS_WFB), M, D, D}; pg8::StaticOrder S; S.init(M, D, F.G, (int)blockIdx.x);
          pg8::EpiGate E{GFB, nullptr, 1};
          pg8::gemm_phase<pg8::EpiGate, pg8::StaticOrder, true, true>(F.lds, g, S, E); }
        { pg8::Gemm g{QO, wsp<bf16>(F, WS_WAB), M, D, D}; pg8::StaticOrder S; S.init(M, D, F.G, (int)blockIdx.x);
          pg8::EpiGate E{GAB, GFB, 2};
          pg8::gemm_phase<pg8::EpiGate, pg8::StaticOrder, true, true>(F.lds, g, S, E); }
        if (BOTH(7)) GRID_BAR();
    }
    if (IN(8)) {
        pg8::Gemm g{GAB, wsp<bf16>(F, WS_WOUT), M, D, D}; pg8::StaticOrder S; S.init(M, D, F.G, (int)blockIdx.x);
        pg8::EpiResid E{F.out, F.out, HB16, SS3, 1.0f, D};
        pg8::gemm_phase<pg8::EpiResid, pg8::StaticOrder, true, true>(F.lds, g, S, E);
        if (BOTH(8)) GRID_BAR();
    }
    if (IN(9)) {
        pg8::Gemm g{HB16, wsp<bf16>(F, WS_WCQ), M, 256, D}; pg8::StaticOrder S; S.init(M, 256, F.G, (int)blockIdx.x);
        pg8::EpiRoute E{{QC, nullptr, nullptr, nullptr, nullptr, nullptr}, SS3, 1, 0, 256};
        pg8::gemm_phase<pg8::EpiRoute, pg8::StaticOrder, true, true>(F.lds, g, S, E);
        if (BOTH(9)) GRID_BAR();
    }
    if (IN(10)) { p_cross_simple(F); if (BOTH(10)) GRID_BAR(); }
    if (IN(11)) {
        pg8::Gemm g{OC, wsp<bf16>(F, WS_WCO), M, D, 256}; pg8::StaticOrder S; S.init(M, D, F.G, (int)blockIdx.x);
        pg8::EpiResid E{F.out, F.out, HB16, SS4, 1.0f, D};
        pg8::gemm_phase<pg8::EpiResid, pg8::StaticOrder, true, true>(F.lds, g, S, E);
        if (BOTH(11)) GRID_BAR();
    }
    if (IN(12)) {
        pg8::Gemm g{HB16, wsp<bf16>(F, WS_W2GU), M, 2 * FF, D}; pg8::StaticOrder S; S.init(M, 2 * FF, F.G, (int)blockIdx.x);
        pg8::EpiSwiGLU E{HH, FF, SS4, 1};
        pg8::gemm_phase<pg8::EpiSwiGLU, pg8::StaticOrder, true, true>(F.lds, g, S, E);
        if (BOTH(12)) GRID_BAR();
    }
    if (IN(13)) {
        pg8::Gemm g{HH, wsp<bf16>(F, WS_W2D), M, D, FF}; pg8::StaticOrder S; S.init(M, D, F.G, (int)blockIdx.x);
        pg8::EpiResid E{F.out, F.out, nullptr, nullptr, 0.5f, D};
        pg8::gemm_phase<pg8::EpiResid, pg8::StaticOrder, true, true>(F.lds, g, S, E);
        if (BOTH(13)) GRID_BAR();
    }
    if (IN(14)) { p_final(F); }
#undef IN
#undef BOTH
}

extern "C" void kernel_launch(void* const* d_in, const int* in_sizes, int n_in, void* d_out, int out_size, void* d_ws, size_t ws_size, hipStream_t stream) {
    static int grid = 0;
    if (grid == 0) {
        if (n_in != 24 || in_sizes[0] != M * D || out_size != M * D || ws_size < WS_END) {
            fprintf(stderr, "kernel_launch: unexpected shapes: n_in %d in0 %d out %d ws %zu (need %zu)\n", n_in, n_in > 0 ? in_sizes[0] : -1, out_size, ws_size, (size_t)WS_END); grid = -1; return; }
        int dev = 0, cus = 0, per_cu = 0;
        if (hipGetDevice(&dev) != hipSuccess || hipDeviceGetAttribute(&cus, hipDeviceAttributeMultiprocessorCount, dev) != hipSuccess) { grid = -1; return; }
        if (hipFuncSetAttribute((const void*)mk_fwd, hipFuncAttributeMaxDynamicSharedMemorySize, LDS_BYTES) != hipSuccess) { fprintf(stderr, "kernel_launch: hipFuncSetAttribute failed\n"); grid = -1; return; }
        if (hipOccupancyMaxActiveBlocksPerMultiprocessor(&per_cu, (const void*)mk_fwd, NWAVES * 64, LDS_BYTES) != hipSuccess || per_cu < 1) { fprintf(stderr, "kernel_launch: occupancy query says %d\n", per_cu); }
        (void)hipGetLastError();
        grid = cus * (per_cu < 1 ? 1 : 1);
        if (per_cu < 1) { grid = -1; return; }
        if (grid != 256) fprintf(stderr, "kernel_launch: %d CUs (built for 256)\n", grid);
    }
    if (grid < 0) return;
    (void)hipMemsetAsync((char*)d_ws + WS_CTL, 0, CTL_ZERO_BYTES, stream);
    Args a{};
    for (int i = 0; i < 24; ++i) a.in[i] = (const float*)d_in[i];
    a.out = (float*)d_out; a.ws = (unsigned char*)d_ws;
#if defined(MK_MULTI)
    for (int ph = 0; ph < N_PHASES; ++ph) {
        a.ph_lo = ph; a.ph_hi = ph + 1;
        hipLaunchKernelGGL(mk_fwd, dim3(grid), dim3(NWAVES * 64), LDS_BYTES, stream, a);
    }
#else
    a.ph_lo = 0; a.ph_hi = N_PHASES;
    void* kargs[] = {&a};
    const hipError_t e = hipLaunchCooperativeKernel((const void*)mk_fwd, dim3(grid), dim3(NWAVES * 64), kargs, LDS_BYTES, stream);
    if (e != hipSuccess) fprintf(stderr, "kernel_launch: cooperative launch failed: %s (grid %d)\n", hipGetErrorString(e), grid);
#endif
}
```

```cpp
#include <hip/hip_runtime.h>
#include <hip/hip_cooperative_groups.h>
#include <cstdio>
#include <cstdint>
namespace pg8 {
#define PG8_LAS __attribute__((address_space(3)))
typedef unsigned short bf16_t;
typedef short bf16x8 __attribute__((ext_vector_type(8)));
typedef float f32x4 __attribute__((ext_vector_type(4)));
typedef unsigned u32x4 __attribute__((ext_vector_type(4)));
constexpr int BM = 256, BK = 64, HALF = 128, HTB = HALF * BK * 2  , STAGE_BYTES = 8 * HTB, NXCD = 8, WGM = 8;

__host__ __device__ __forceinline__ int lds_byte(int r, int c) { const int st = (r >> 4) * 2 + (c >> 5), rr = r & 15, cc = c & 31, ob = rr * 64 + cc * 2; return st * 1024 + (ob ^ (((ob >> 9) & 1) << 5)); }
__host__ __device__ __forceinline__ void stage_rc(int b, int& R, int& C) { const int st = b / 1024, sb = b % 1024, swz = sb ^ (((sb >> 9) & 1) << 5); R = (st >> 1) * 16 + swz / 64; C = (st & 1) * 32 + (swz % 64) / 2; }
__host__ __device__ __forceinline__ int perm32(int rho) { const int n = rho >> 4, i = rho & 15; return 8 * (i >> 2) + 4 * n + (i & 3); }

struct Unit { int pm, pn; };
struct Gemm { const bf16_t* A; const bf16_t* Bt; int M, N, K; };

struct StaticOrder {
    int nM, nN, nwg, G, c;
    __host__ __device__ void init(int M, int N, int G_, int c_) { nM = M / BM; nN = N / BM; nwg = nM * nN; G = G_; c = c_; }
    __host__ __device__ bool next(int i, Unit& u) const {
        const long L = (long)i * G + c; if (L >= nwg) return false;
        int wgid = (int)L; { const int q = nwg / NXCD, r = nwg % NXCD, xcd = wgid % NXCD, off = wgid / NXCD; wgid = (xcd < r ? xcd * (q + 1) : r * (q + 1) + (xcd - r) * q) + off; }
        const int nig = WGM * nN, gid = wgid / nig, fm = gid * WGM, gsz = (nM - fm) < WGM ? (nM - fm) : WGM;
        u.pm = fm + ((wgid % nig) % gsz); u.pn = (wgid % nig) / gsz; return true;
    }
    __device__ __forceinline__ void a_ready(const Unit&) const {}
    __device__ __forceinline__ void done(const Unit&) const {}
};

typedef float f32x2_cv __attribute__((ext_vector_type(2))); typedef __bf16 bf16x2_cv __attribute__((ext_vector_type(2)));
__device__ __forceinline__ unsigned cvt_pk_bf16(float lo, float hi) { f32x2_cv v = {lo, hi}; bf16x2_cv b = __builtin_convertvector(v, bf16x2_cv); return __builtin_bit_cast(unsigned, b); }
__device__ __forceinline__ float bflo(unsigned u) { return __uint_as_float(u << 16); }
__device__ __forceinline__ float bfhi(unsigned u) { return __uint_as_float(u & 0xffff0000u); }
__device__ __forceinline__ float sigmoid_f(float x) { return __builtin_amdgcn_rcpf(1.0f + __builtin_amdgcn_exp2f(-1.4426950408889634f * x)); }
__device__ __forceinline__ u32x4 pack8(const f32x4 a, const f32x4 b) { u32x4 w; w.x = cvt_pk_bf16(a[0], a[1]); w.y = cvt_pk_bf16(a[2], a[3]); w.z = cvt_pk_bf16(b[0], b[1]); w.w = cvt_pk_bf16(b[2], b[3]); return w; }
constexpr float RMS_EPS = 1e-6f;
__device__ __forceinline__ float rowscale(const float* p, int row, int mode) { const float v = p[row]; return mode ? __builtin_amdgcn_rsqf(v * (1.0f / 1024.0f) + RMS_EPS) : v; }

struct EpiSwiGLU {
    static constexpr bool PERM = true, AFTER_DRAIN = false;
    bf16_t* H; int ldh; const float* rs; int rs_mode;
    __device__ __forceinline__ void operator()(const f32x4 (&acc)[2][2][4][2], const Unit& u, int wr, int wc, int fr, int fq) const {
        const int row0 = u.pm * BM + wr * 64 + fr, col0 = u.pn * HALF + wc * 32 + 8 * fq;
#pragma unroll
        for (int ai = 0; ai < 2; ++ai)
#pragma unroll
            for (int m = 0; m < 4; ++m) {
                const int row = row0 + ai * HALF + m * 16; const float r = rowscale(rs, row, rs_mode);
                f32x4 o[2];
#pragma unroll
                for (int n = 0; n < 2; ++n) {
                    const f32x4 g = acc[ai][0][m][n] * r, up = acc[ai][1][m][n] * r;
#pragma unroll
                    for (int j = 0; j < 4; ++j) o[n][j] = g[j] * sigmoid_f(g[j]) * up[j];
                }
                *(u32x4*)(H + (size_t)row * ldh + col0) = pack8(o[0], o[1]);
            }
    }
};
struct EpiResid {
    static constexpr bool PERM = true, AFTER_DRAIN = false;
    const float* base; float* out; bf16_t* ob; float* ss; float scale; int ldc;
    __device__ __forceinline__ void operator()(const f32x4 (&acc)[2][2][4][2], const Unit& u, int wr, int wc, int fr, int fq) const {
        const int row0 = u.pm * BM + wr * 64 + fr, col0 = u.pn * BM + wc * 32 + 8 * fq;
#pragma unroll
        for (int ai = 0; ai < 2; ++ai)
#pragma unroll
            for (int m = 0; m < 4; ++m) {
                const int row = row0 + ai * HALF + m * 16; float s = 0.f;
#pragma unroll
                for (int bj = 0; bj < 2; ++bj) {
                    const size_t off = (size_t)row * ldc + col0 + bj * HALF;
                    const f32x4 b0 = *(const f32x4*)(base + off), b1 = *(const f32x4*)(base + off + 4);
                    const f32x4 o0 = b0 + acc[ai][bj][m][0] * scale, o1 = b1 + acc[ai][bj][m][1] * scale;
                    *(f32x4*)(out + off) = o0; *(f32x4*)(out + off + 4) = o1;
                    if (ob) *(u32x4*)(ob + off) = pack8(o0, o1);
                    s += (o0[0] * o0[0] + o0[1] * o0[1]) + (o0[2] * o0[2] + o0[3] * o0[3]) + (o1[0] * o1[0] + o1[1] * o1[1]) + (o1[2] * o1[2] + o1[3] * o1[3]);
                }
                if (ss) { s += __shfl_xor(s, 16); s += __shfl_xor(s, 32); if (fq == 0) atomicAdd(ss + row, s); }
            }
    }
};
struct EpiRoute {
    static constexpr bool PERM = true, AFTER_DRAIN = false;
    bf16_t* dst[6]; const float* rs; int rs_mode; int is_win;
    int ld0;
    __device__ __forceinline__ void operator()(const f32x4 (&acc)[2][2][4][2], const Unit& u, int wr, int wc, int fr, int fq) const {
        const int pn = u.pn; bf16_t* bp; int ldc, colt;
        if (!is_win) { bp = dst[0]; ldc = ld0; colt = pn * BM; }
        else if (pn < 4) { bp = dst[0]; ldc = 1024; colt = pn * BM; }
        else if (pn == 4) { bp = dst[1]; ldc = 256; colt = 0; }
        else if (pn == 5) { bp = dst[2]; ldc = 256; colt = 0; }
        else if (pn < 8) { bp = dst[3]; ldc = 512; colt = (pn - 6) * BM; }
        else if (pn < 12) { bp = dst[4]; ldc = 1024; colt = (pn - 8) * BM; }
        else { bp = dst[5]; ldc = 1024; colt = (pn - 12) * BM; }
        const int row0 = u.pm * BM + wr * 64 + fr, col0 = colt + wc * 32 + 8 * fq;
#pragma unroll
        for (int ai = 0; ai < 2; ++ai)
#pragma unroll
            for (int m = 0; m < 4; ++m) {
                const int row = row0 + ai * HALF + m * 16; const float r = rowscale(rs, row, rs_mode);
#pragma unroll
                for (int bj = 0; bj < 2; ++bj)
                    *(u32x4*)(bp + (size_t)row * ldc + col0 + bj * HALF) = pack8(acc[ai][bj][m][0] * r, acc[ai][bj][m][1] * r);
            }
    }
};
struct EpiGate {
    static constexpr bool PERM = true, AFTER_DRAIN = false;
    bf16_t* G; const bf16_t* T; int mode;
    __device__ __forceinline__ void operator()(const f32x4 (&acc)[2][2][4][2], const Unit& u, int wr, int wc, int fr, int fq) const {
        const int row0 = u.pm * BM + wr * 64 + fr, col0 = u.pn * BM + wc * 32 + 8 * fq;
#pragma unroll
        for (int ai = 0; ai < 2; ++ai)
#pragma unroll
            for (int m = 0; m < 4; ++m) {
                const int row = row0 + ai * HALF + m * 16;
#pragma unroll
                for (int bj = 0; bj < 2; ++bj) {
                    const size_t off = (size_t)row * 1024 + col0 + bj * HALF;
                    const u32x4 gv = *(const u32x4*)(G + off);
                    f32x4 g0 = {bflo(gv.x), bfhi(gv.x), bflo(gv.y), bfhi(gv.y)}, g1 = {bflo(gv.z), bfhi(gv.z), bflo(gv.w), bfhi(gv.w)};
                    f32x4 o0, o1;
#pragma unroll
                    for (int j = 0; j < 4; ++j) { o0[j] = sigmoid_f(g0[j]) * acc[ai][bj][m][0][j]; o1[j] = sigmoid_f(g1[j]) * acc[ai][bj][m][1][j]; }
                    if (mode == 2) { const u32x4 tv = *(const u32x4*)(T + off);
                        o0 += (f32x4){bflo(tv.x), bfhi(tv.x), bflo(tv.y), bfhi(tv.y)}; o1 += (f32x4){bflo(tv.z), bfhi(tv.z), bflo(tv.w), bfhi(tv.w)}; }
                    *(u32x4*)(G + off) = pack8(o0, o1);
                }
            }
    }
};
template <class Epi, class Sched, bool ALIGN_EPI = false, bool SP2 = false>
__device__ __forceinline__ void gemm_phase(PG8_LAS unsigned char* lds, const Gemm g, const Sched& S, const Epi& E) {
    const int tid = threadIdx.x, wid = __builtin_amdgcn_readfirstlane(tid >> 6), lane = tid & 63, wr = wid >> 2, wc = wid & 3, fr = lane & 15, fq = lane >> 4;
    const int K = g.K, nt = K / BK;
    unsigned voffA[2], voffB[2];
#pragma unroll
    for (int i = 0; i < 2; ++i) { int R, C; stage_rc(tid * 16 + i * 8192, R, C); const int Rb = Epi::PERM ? ((R & ~31) + perm32(R & 31)) : R;
        voffA[i] = (unsigned)(R * K + C) * 2u; voffB[i] = (unsigned)(Rb * K + C) * 2u; }
    const size_t kstep = (size_t)(BK * 2);
    const size_t hstep = (size_t)HALF * K * 2;
    const size_t tstep = 2 * hstep;
    const unsigned ldsw = (unsigned)wid * 1024u;
    const int aoff = lds_byte(wr * 64 + fr, fq * 8), boff = lds_byte(wc * 32 + fr, fq * 8);
#define PG8_SA(b, h) (((b) * 2 + (h)) * HTB)
#define PG8_SB(b, h) ((4 + (b) * 2 + (h)) * HTB)
#define PG8_STAGE(bufoff, gbase, voff) do { _Pragma("unroll") for (int _i = 0; _i < 2; ++_i) \
        __builtin_amdgcn_global_load_lds((const unsigned*)((const char*)(gbase) + (voff)[_i]), (PG8_LAS unsigned*)(lds + (bufoff) + ldsw + _i * 8192), 16, 0, 0); } while (0)
#define PG8_LDA(dst, b, h) do { _Pragma("unroll") for (int m = 0; m < 4; ++m) _Pragma("unroll") for (int k = 0; k < 2; ++k) dst[m][k] = *(const PG8_LAS bf16x8*)(lds + PG8_SA(b, h) + aoff + m * 2048 + k * 1024); } while (0)
#define PG8_LDB(dst, b, h) do { _Pragma("unroll") for (int n = 0; n < 2; ++n) _Pragma("unroll") for (int k = 0; k < 2; ++k) dst[n][k] = *(const PG8_LAS bf16x8*)(lds + PG8_SB(b, h) + boff + n * 2048 + k * 1024); } while (0)
#define PG8_MMA(ai, bj, At, Bt) do { __builtin_amdgcn_s_setprio(1); _Pragma("unroll") for (int m = 0; m < 4; ++m) _Pragma("unroll") for (int n = 0; n < 2; ++n) _Pragma("unroll") for (int k = 0; k < 2; ++k) \
        acc[ai][bj][m][n] = __builtin_amdgcn_mfma_f32_16x16x32_bf16(Bt[n][k], At[m][k], acc[ai][bj][m][n], 0, 0, 0); __builtin_amdgcn_s_setprio(0); } while (0)
#define PG8_WAIT_V(n) asm volatile("s_waitcnt vmcnt(" #n ")" ::: "memory")
#define PG8_WAIT_L(n) asm volatile("s_waitcnt lgkmcnt(" #n ")" ::: "memory")
#define PG8_BAR __builtin_amdgcn_s_barrier()
#define PG8_SCHED __builtin_amdgcn_sched_barrier(0)
    Unit cur, nxt; int ui = 0;
    if (!S.next(0, cur)) return;
    f32x4 acc[2][2][4][2];
#pragma unroll
    for (int a = 0; a < 2; ++a)
#pragma unroll
        for (int b = 0; b < 2; ++b)
#pragma unroll
            for (int m = 0; m < 4; ++m)
#pragma unroll
                for (int n = 0; n < 2; ++n) acc[a][b][m][n] = (f32x4){0.f, 0.f, 0.f, 0.f};
    bf16x8 At[4][2], B0[2][2], B1[2][2];
    const char* cA = (const char*)g.A + (size_t)cur.pm * tstep; const char* cB = (const char*)g.Bt + (size_t)cur.pn * tstep;
    S.a_ready(cur);
    if constexpr (SP2) {
        PG8_STAGE(PG8_SB(0, 0), cB, voffB); PG8_STAGE(PG8_SB(0, 1), cB + hstep, voffB); PG8_STAGE(PG8_SA(0, 0), cA, voffA); PG8_STAGE(PG8_SA(0, 1), cA + hstep, voffA);
        if (wr == 1) PG8_BAR;
        PG8_WAIT_V(2); PG8_BAR;
        PG8_STAGE(PG8_SB(1, 0), cB + kstep, voffB); PG8_STAGE(PG8_SA(1, 0), cA + kstep, voffA); PG8_STAGE(PG8_SB(1, 1), cB + hstep + kstep, voffB);
        PG8_WAIT_V(6); PG8_BAR;
    } else {
        PG8_STAGE(PG8_SB(0, 0), cB, voffB); PG8_STAGE(PG8_SA(0, 0), cA, voffA); PG8_STAGE(PG8_SB(0, 1), cB + hstep, voffB); PG8_STAGE(PG8_SA(0, 1), cA + hstep, voffA);
        if (wr == 1) PG8_BAR;
        PG8_WAIT_V(4); PG8_BAR;
        PG8_STAGE(PG8_SB(1, 0), cB + kstep, voffB); PG8_STAGE(PG8_SA(1, 0), cA + kstep, voffA); PG8_STAGE(PG8_SB(1, 1), cB + hstep + kstep, voffB);
        PG8_WAIT_V(6); PG8_BAR;
    }
    for (;;) {
        const bool has_next = S.next(ui + 1, nxt);
        const char* nA = has_next ? (const char*)g.A + (size_t)nxt.pm * tstep : cA; const char* nB = has_next ? (const char*)g.Bt + (size_t)nxt.pn * tstep : cB;
        for (int t = 0; t < nt; t += 2) {
            const bool last = (t == nt - 2);
            const char* a1 = cA + (size_t)(t + 1) * kstep;
            const char* a2 = last ? nA : cA + (size_t)(t + 2) * kstep; const char* b2 = last ? nB : cB + (size_t)(t + 2) * kstep;
            const char* a3 = a2 + kstep; const char* b3 = b2 + kstep;
            if (last && has_next) S.a_ready(nxt);
            if constexpr (SP2) {
            PG8_LDB(B0, 0, 0); PG8_LDB(B1, 0, 1); PG8_SCHED; PG8_LDA(At, 0, 0); PG8_STAGE(PG8_SA(1, 1), a1 + hstep, voffA);
            PG8_WAIT_V(8); PG8_WAIT_L(0); PG8_BAR; PG8_MMA(0, 0, At, B0); PG8_MMA(0, 1, At, B1); PG8_BAR; PG8_SCHED;
            PG8_LDA(At, 0, 1); PG8_STAGE(PG8_SB(0, 0), b2, voffB); PG8_STAGE(PG8_SB(0, 1), b2 + hstep, voffB); PG8_STAGE(PG8_SA(0, 0), a2, voffA);
            PG8_WAIT_V(8); PG8_WAIT_L(0); PG8_BAR; PG8_MMA(1, 0, At, B0); PG8_MMA(1, 1, At, B1); PG8_BAR; PG8_SCHED;
            PG8_LDB(B0, 1, 0); PG8_LDB(B1, 1, 1); PG8_SCHED; PG8_LDA(At, 1, 0); PG8_STAGE(PG8_SA(0, 1), a2 + hstep, voffA);
            PG8_WAIT_V(8); PG8_WAIT_L(0); PG8_BAR; PG8_MMA(0, 0, At, B0); PG8_MMA(0, 1, At, B1); PG8_BAR; PG8_SCHED;
            PG8_LDA(At, 1, 1); PG8_STAGE(PG8_SB(1, 0), b3, voffB); PG8_STAGE(PG8_SB(1, 1), b3 + hstep, voffB); PG8_STAGE(PG8_SA(1, 0), a3, voffA);
            PG8_WAIT_V(8); PG8_WAIT_L(0); PG8_BAR; PG8_MMA(1, 0, At, B0); PG8_MMA(1, 1, At, B1); PG8_BAR; PG8_SCHED;
            } else {
            PG8_LDB(B0, 0, 0); PG8_SCHED; PG8_LDA(At, 0, 0); PG8_STAGE(PG8_SA(1, 1), a1 + hstep, voffA);
            PG8_WAIT_L(8); PG8_BAR; PG8_WAIT_L(0); PG8_MMA(0, 0, At, B0); PG8_BAR; PG8_SCHED;
            PG8_LDB(B1, 0, 1); PG8_STAGE(PG8_SB(0, 0), b2, voffB);
            PG8_BAR; PG8_WAIT_L(0); PG8_MMA(0, 1, At, B1); PG8_BAR;
            PG8_LDA(At, 0, 1); PG8_STAGE(PG8_SA(0, 0), a2, voffA);
            PG8_BAR; PG8_WAIT_L(0); PG8_MMA(1, 0, At, B0); PG8_BAR; PG8_SCHED;
            PG8_STAGE(PG8_SB(0, 1), b2 + hstep, voffB);
            PG8_WAIT_V(6); PG8_BAR; PG8_MMA(1, 1, At, B1); PG8_BAR;
            PG8_LDB(B0, 1, 0); PG8_SCHED; PG8_LDA(At, 1, 0); PG8_STAGE(PG8_SA(0, 1), a2 + hstep, voffA);
            PG8_WAIT_L(8); PG8_BAR; PG8_WAIT_L(0); PG8_MMA(0, 0, At, B0); PG8_BAR; PG8_SCHED;
            PG8_LDB(B1, 1, 1); PG8_STAGE(PG8_SB(1, 0), b3, voffB);
            PG8_BAR; PG8_WAIT_L(0); PG8_MMA(0, 1, At, B1); PG8_BAR;
            PG8_LDA(At, 1, 1); PG8_STAGE(PG8_SA(1, 0), a3, voffA);
            PG8_BAR; PG8_WAIT_L(0); PG8_MMA(1, 0, At, B0); PG8_BAR; PG8_SCHED;
            PG8_STAGE(PG8_SB(1, 1), b3 + hstep, voffB);
            PG8_WAIT_V(6); PG8_BAR; PG8_MMA(1, 1, At, B1); PG8_BAR;
            }
        }
        if constexpr (ALIGN_EPI) { if (wr == 0) PG8_BAR; }
        if constexpr (!Epi::AFTER_DRAIN) { E(acc, cur, wr, wc, fr, fq); S.done(cur); }
        if (!has_next) break;
#pragma unroll
        for (int a = 0; a < 2; ++a)
#pragma unroll
            for (int b = 0; b < 2; ++b)
#pragma unroll
                for (int m = 0; m < 4; ++m)
#pragma unroll
                    for (int n = 0; n < 2; ++n) acc[a][b][m][n] = (f32x4){0.f, 0.f, 0.f, 0.f};
        cur = nxt; cA = nA; cB = nB; ++ui;
        if constexpr (ALIGN_EPI) { if (wr == 1) PG8_BAR; }
    }
    PG8_WAIT_V(0);
    if constexpr (!ALIGN_EPI) { if (wr == 0) PG8_BAR; }
    PG8_BAR;
    if constexpr (Epi::AFTER_DRAIN) { E.fused(acc, cur, wr, wc, fr, fq, lds, wid, lane); S.done(cur); }
#undef PG8_SA
#undef PG8_SB
#undef PG8_STAGE
#undef PG8_LDA
#undef PG8_LDB
#undef PG8_MMA
#undef PG8_WAIT_V
#undef PG8_WAIT_L
#undef PG8_BAR
#undef PG8_SCHED
}
}
#include <hip/hip_bf16.h>
#include <cmath>
namespace attn_body {
using bf16=__hip_bfloat16;
using bf16x8=__attribute__((ext_vector_type(8)))short;
using s16x4=__attribute__((ext_vector_type(4)))short;
using f32x16=__attribute__((ext_vector_type(16)))float;
using u32x4=__attribute__((ext_vector_type(4)))unsigned;
constexpr int BATCH=1,NHEAD=16,SEQ=16384,D=64,DM=NHEAD*D,KVP=256,GQA=4;
constexpr int NW=8,QBLK=32,QB=QBLK*NW,KVBLK=64,NQB=SEQ/QB;
constexpr int ATTN_PITCH=DM, ATTN_UNIT_ROWS=QB;
__device__ __forceinline__ int crow(int r,int hi){return (r&3)+8*(r>>2)+4*hi;}
#define SBAR() __builtin_amdgcn_sched_barrier(0)
__device__ __forceinline__ void cmask(f32x16&p0,f32x16&p1,int jb,int qrel,int hi){
  const float NEG=-INFINITY; int kb=64*jb+4*hi;
  #pragma unroll
  for(int r=0;r<16;++r){int kv=kb+(r&3)+8*(r>>2); if(kv>qrel)p0[r]=NEG; if(kv+32>qrel)p1[r]=NEG;}
}

constexpr int NSLOT=3, SLOTB=8192;
constexpr int LDS_K=0, LDS_V=NSLOT*SLOTB, LDS_WS=2*NSLOT*SLOTB, LDS_OST=LDS_WS+NW*64*4, LDS_BYTES=LDS_OST+NW*4096;
constexpr float C2=0.125f*1.4426950408889634f;
__device__ __forceinline__ void glds16(const void*gsrc,unsigned lds_dst){unsigned keep;
  asm volatile("s_mov_b32 %0, m0\n\ts_mov_b32 m0, %2\n\ts_nop 0\n\tglobal_load_lds_dwordx4 %1, off\n\ts_mov_b32 m0, %0":"=&s"(keep):"v"(gsrc),"s"(lds_dst):"memory");}
__device__ __forceinline__ float max3f(float a,float b,float c){float r;asm("v_max3_f32 %0, %1, %2, %3":"=v"(r):"v"(a),"v"(b),"v"(c));return r;}
__device__ __forceinline__ float max2f(float a,float b){float r;asm("v_max_f32_e32 %0, %1, %2":"=v"(r):"v"(a),"v"(b));return r;}
__device__ __forceinline__ float fadd_s(float a,float b){float r;asm("v_add_f32_e32 %0, %1, %2":"=v"(r):"v"(a),"v"(b));return r;}
__device__ __forceinline__ float fsub_s(float a,float b){float r;asm("v_sub_f32_e32 %0, %1, %2":"=v"(r):"v"(a),"v"(b));return r;}
typedef float f32x2_t __attribute__((ext_vector_type(2))); typedef __bf16 bf16x2_t __attribute__((ext_vector_type(2)));
__device__ __forceinline__ unsigned cvtpk_s(float lo,float hi){f32x2_t v={lo,hi};bf16x2_t b=__builtin_convertvector(v,bf16x2_t);return __builtin_bit_cast(unsigned,b);}
#define WAIT_BAR(N) asm volatile("s_waitcnt vmcnt(" #N ") lgkmcnt(0)\n\ts_barrier":::"memory")

__device__ __forceinline__ void qkt(f32x16&p0,f32x16&p1,const char*Kslot,const bf16x8*qr,const f32x16&negm,int r32,int hi){
  const char*kb=Kslot+hi*1024+r32*16;
  #pragma unroll
  for(int d0=0;d0<4;++d0){
    const bf16x8 b0=*reinterpret_cast<const bf16x8*>(kb+d0*2048);
    const bf16x8 b1=*reinterpret_cast<const bf16x8*>(kb+d0*2048+512);
    if(d0==0){p0=__builtin_amdgcn_mfma_f32_32x32x16_bf16(b0,qr[0],negm,0,0,0);p1=__builtin_amdgcn_mfma_f32_32x32x16_bf16(b1,qr[0],negm,0,0,0);}
    else{p0=__builtin_amdgcn_mfma_f32_32x32x16_bf16(b0,qr[d0],p0,0,0,0);p1=__builtin_amdgcn_mfma_f32_32x32x16_bf16(b1,qr[d0],p1,0,0,0);}}
}
typedef __attribute__((address_space(3))) const char* lds_cptr;
typedef short v4i16_t __attribute__((ext_vector_type(4)));
__device__ __forceinline__ void kload8(bf16x8*kf,lds_cptr kp){
  kf[0]=*(const __attribute__((address_space(3))) bf16x8*)(kp);      kf[1]=*(const __attribute__((address_space(3))) bf16x8*)(kp+512);
  kf[2]=*(const __attribute__((address_space(3))) bf16x8*)(kp+2048); kf[3]=*(const __attribute__((address_space(3))) bf16x8*)(kp+2560);
  kf[4]=*(const __attribute__((address_space(3))) bf16x8*)(kp+4096); kf[5]=*(const __attribute__((address_space(3))) bf16x8*)(kp+4608);
  kf[6]=*(const __attribute__((address_space(3))) bf16x8*)(kp+6144); kf[7]=*(const __attribute__((address_space(3))) bf16x8*)(kp+6656);
}
__device__ __forceinline__ void kload2(bf16x8*kf,lds_cptr kp,int j){ kf[2*j]=*(const __attribute__((address_space(3))) bf16x8*)(kp+j*2048); kf[2*j+1]=*(const __attribute__((address_space(3))) bf16x8*)(kp+j*2048+512); }
__device__ __forceinline__ s16x4 vtr(lds_cptr p){ return __builtin_bit_cast(s16x4,__builtin_amdgcn_ds_read_tr16_b64_v4i16((__attribute__((address_space(3))) v4i16_t*)p)); }
__device__ __forceinline__ float rowmax(const f32x16&p0,const f32x16&p1){
  float a=max3f(p0[0],p0[1],p1[0]),b=max3f(p0[2],p0[3],p1[1]);a=max3f(a,p1[2],p1[3]);
  #pragma unroll
  for(int r=4;r<16;r+=4){a=max3f(a,p0[r],p0[r+1]);b=max3f(b,p0[r+2],p0[r+3]);a=max3f(a,p1[r],p1[r+1]);b=max3f(b,p1[r+2],p1[r+3]);}
  const float m=max2f(a,b);
  auto rr=__builtin_amdgcn_permlane32_swap(__float_as_uint(m),__float_as_uint(m),false,false);
  return max2f(__uint_as_float(rr[0]),__uint_as_float(rr[1]));
}
__device__ __forceinline__ void pv(f32x16*o,int vb,bf16x8 pa0,bf16x8 pa1,bf16x8 pa2,bf16x8 pa3){
  #pragma unroll
  for(int d0=0;d0<2;++d0){s16x4 lo[4],hi[4];
    #pragma unroll
    for(int ks=0;ks<4;++ks){
      asm volatile("ds_read_b64_tr_b16 %0,%1 offset:%c2":"=&v"(lo[ks]):"v"(vb),"i"(d0*4096+ks*1024):"memory");
      asm volatile("ds_read_b64_tr_b16 %0,%1 offset:%c2":"=&v"(hi[ks]):"v"(vb),"i"(d0*4096+ks*1024+512):"memory");}
    asm volatile("s_waitcnt lgkmcnt(0)":::"memory");SBAR();
    #define PK(k) (bf16x8){lo[k][0],lo[k][1],lo[k][2],lo[k][3],hi[k][0],hi[k][1],hi[k][2],hi[k][3]}
    o[d0]=__builtin_amdgcn_mfma_f32_32x32x16_bf16(pa0,PK(0),o[d0],0,0,0);
    o[d0]=__builtin_amdgcn_mfma_f32_32x32x16_bf16(pa1,PK(1),o[d0],0,0,0);
    o[d0]=__builtin_amdgcn_mfma_f32_32x32x16_bf16(pa2,PK(2),o[d0],0,0,0);
    o[d0]=__builtin_amdgcn_mfma_f32_32x32x16_bf16(pa3,PK(3),o[d0],0,0,0);
    #undef PK
  }
}

#ifndef ATTN_STORE16
#define ATTN_STORE16(p,v) (*(u32x4*)(p)=(v))
#endif
template<int THRL> __device__ __forceinline__ void attn_unit(int b,int h,int qb,const bf16*Q,const bf16*__restrict__ K,const bf16*__restrict__ V,bf16*O,char*shm){
  const int tid=threadIdx.x,lane=tid&63,r32=lane&31,hi=lane>>5; const int wid=__builtin_amdgcn_readfirstlane(tid>>6);
  const long rowbase=(long)b*SEQ; const int q0=qb*QB;
  const bf16*Qw=Q+(rowbase+q0+wid*QBLK)*DM+h*D;
  const bf16*Kh=K+rowbase*KVP+(h/GQA)*D,*Vh=V+rowbase*KVP+(h/GQA)*D;
  const unsigned lds0=(unsigned)(uintptr_t)shm;
  float*wsf=(float*)(shm+LDS_WS)+wid*64;
  const bf16*ksrc=Kh+(long)lane*KVP+wid*8;
  const bf16*vsrc=Vh+(long)(16*(wid&3)+(lane>>2))*KVP+(wid>>2)*32+(lane&3)*8;
  const unsigned kdst=lds0+LDS_K+wid*1024, vdst=lds0+LDS_V+wid*1024;
  #define DMA_K(t,slot) glds16(ksrc+(long)(t)*KVBLK*KVP,(unsigned)__builtin_amdgcn_readfirstlane(kdst+(slot)))
  #define DMA_V(t,slot) glds16(vsrc+(long)(t)*KVBLK*KVP,(unsigned)__builtin_amdgcn_readfirstlane(vdst+(slot)))
  const int vb0=(int)(lds0+LDS_V)+((lane>>4)&1)*32+(lane&3)*8+(4*hi+((lane&15)>>2))*64;
  const char*Kbase=shm+LDS_K; bf16x8 kf[8];
  const lds_cptr shm3=(lds_cptr)shm; const lds_cptr kp0=shm3+LDS_K+hi*1024+r32*16; const lds_cptr vp0=shm3+LDS_V+((lane>>4)&1)*32+(lane&3)*8+(4*hi+((lane&15)>>2))*64;
  const int NT=SEQ/KVBLK;
  DMA_K(0,0);DMA_V(0,0);DMA_K(1,SLOTB);
  bf16x8 qr[4];
  #pragma unroll
  for(int d0=0;d0<4;++d0)qr[d0]=*reinterpret_cast<const bf16x8*>(&Qw[(long)r32*DM+d0*16+hi*8]);
  float mhat=0.f,l_reg=0.f;f32x16 o[2];o[0]=f32x16{};o[1]=f32x16{};f32x16 negm=f32x16{};asm volatile("":"+v"(negm));
  const int qrel=wid*QBLK+r32;
  #define CMASK(P0,P1,t) do{}while(0)
  bool resc=false;
  #define START(P0,P1) do{ const float rm=rowmax(P0,P1); resc=false; \
    { const float dl=rm; mhat=fadd_s(mhat,dl); \
      _Pragma("unroll") for(int r=0;r<16;++r){P0[r]=fsub_s(P0[r],dl);P1[r]=fsub_s(P1[r],dl);} \
      _Pragma("unroll") for(int r=0;r<16;++r)negm[r]=-mhat; asm volatile("":"+v"(negm)); } \
    _Pragma("unroll") for(int r=0;r<16;++r)P0[r]=__builtin_amdgcn_exp2f(P0[r]); }while(0)
  #define RESC() do{ if(resc){ asm volatile("s_waitcnt lgkmcnt(0)":::"memory"); \
      _Pragma("unroll") for(int d_=0;d_<2;++d_) _Pragma("unroll") for(int r=0;r<16;++r)o[d_][r]*=wsf[crow(r,hi)]; } }while(0)
  f32x16 pA0,pA1,pB0,pB1;
  int sl_prev=0,sl_cur=0,sl_next=SLOTB;
  #define ROT() do{sl_prev=sl_cur;sl_cur=sl_next;sl_next=(sl_next==(NSLOT-1)*SLOTB)?0:sl_next+SLOTB;}while(0)
  DMA_K(2,2*SLOTB);
  WAIT_BAR(3);
  qkt(pA0,pA1,Kbase,qr,negm,r32,hi);asm volatile("s_nop 15\n\ts_nop 7":"+v"(pA0),"+v"(pA1));CMASK(pA0,pA1,0);
  START(pA0,pA1);
  _Pragma("unroll") for(int r=0;r<16;++r)pA1[r]=__builtin_amdgcn_exp2f(pA1[r]);
  WAIT_BAR(0);
  DMA_K(3,0);DMA_V(1,SLOTB);
  ROT();
  kload8(kf,kp0+sl_cur);
  WAIT_BAR(2);
  s16x4 vlo[8],vhi[8]; u32x4 pw0,pw1,pw2,pw3;
  #define PKW(P,B) cvtpk_s(P[B],P[B+1])
  #define PAF(k) __builtin_bit_cast(bf16x8,pw##k)
  #define VFR(i) (bf16x8){vlo[i][0],vlo[i][1],vlo[i][2],vlo[i][3],vhi[i][0],vhi[i][1],vhi[i][2],vhi[i][3]}
  #define PIN(x) asm volatile("":"+v"(x))
  #define MX3(a,b,c) __builtin_fmaxf(__builtin_fmaxf((a),(b)),(c))
  #define GAPA(MF,A0,A1,A2,A3,W0,W1,PW) do{ MF; sacc+=A0; sacc+=A1; sacc+=A2; sacc+=A3; PIN(sacc); W0; W1; PIN(PW); SBAR(); }while(0)
  #define EX(v) __builtin_amdgcn_exp2f(v)
  #define GAPB(MF,X,B) do{ MF; X[B]=EX(X[B]); X[B+1]=EX(X[B+1]); X[B+2]=EX(X[B+2]); X[B+3]=EX(X[B+3]); PIN(X); SBAR(); }while(0)
  #define VRD(i) do{ vlo[i]=vtr(vp_+(((i)>>2)*4096+((i)&3)*1024)); vhi[i]=vtr(vp_+(((i)>>2)*4096+((i)&3)*1024+512)); }while(0)
  #define KRD(G,j) do{ if(G){ kload2(kf,kp0+sl_next,j); SBAR(); } }while(0)
  #define STEP(C0,C1,P0,P1,t,GK,GV,GL) do{ SBAR(); \
    const lds_cptr vp_=vp0+sl_prev; \
    VRD(0); SBAR(); float sacc=(P0[0]+P0[1]); \
    GAPA(C0=__builtin_amdgcn_mfma_f32_32x32x16_bf16(kf[0],qr[0],negm,0,0,0), P0[2],P0[3],P0[4],P0[5],     pw0[0]=PKW(P0,0), pw0[1]=PKW(P0,2), pw0); \
    VRD(4); SBAR(); GAPA(C1=__builtin_amdgcn_mfma_f32_32x32x16_bf16(kf[1],qr[0],negm,0,0,0), P0[6],P0[7],P0[8],P0[9],     pw0[2]=PKW(P0,4), pw0[3]=PKW(P0,6), pw0); \
    VRD(1); SBAR(); GAPA(C0=__builtin_amdgcn_mfma_f32_32x32x16_bf16(kf[2],qr[1],C0,0,0,0),   P0[10],P0[11],P0[12],P0[13], pw1[0]=PKW(P0,8), pw1[1]=PKW(P0,10), pw1); \
    VRD(5); SBAR(); GAPA(C1=__builtin_amdgcn_mfma_f32_32x32x16_bf16(kf[3],qr[1],C1,0,0,0),   P0[14],P0[15],P1[0],P1[1],   pw1[2]=PKW(P0,12),pw1[3]=PKW(P0,14), pw1); \
    VRD(2); SBAR(); GAPA(C0=__builtin_amdgcn_mfma_f32_32x32x16_bf16(kf[4],qr[2],C0,0,0,0),   P1[2],P1[3],P1[4],P1[5],     pw2[0]=PKW(P1,0), pw2[1]=PKW(P1,2), pw2); \
    VRD(6); SBAR(); GAPA(C1=__builtin_amdgcn_mfma_f32_32x32x16_bf16(kf[5],qr[2],C1,0,0,0),   P1[6],P1[7],P1[8],P1[9],     pw2[2]=PKW(P1,4), pw2[3]=PKW(P1,6), pw2); \
    VRD(3); SBAR(); GAPA(C0=__builtin_amdgcn_mfma_f32_32x32x16_bf16(kf[6],qr[3],C0,0,0,0),   P1[10],P1[11],P1[12],P1[13], pw3[0]=PKW(P1,8), pw3[1]=PKW(P1,10), pw3); \
    VRD(7); SBAR(); GAPA(C1=__builtin_amdgcn_mfma_f32_32x32x16_bf16(kf[7],qr[3],C1,0,0,0),   P1[14],P1[15],0.f,0.f,       pw3[2]=PKW(P1,12),pw3[3]=PKW(P1,14), pw3); \
    l_reg+=sacc; \
    if(GK){DMA_K((t)+3,sl_cur);} if(GV){DMA_V((t)+1,sl_next);} \
    CMASK(C0,C1,t); \
    { float a=MX3(C0[0],C0[1],C1[0]),b=MX3(C0[2],C0[3],C1[1]); a=MX3(a,C1[2],C1[3]); \
      _Pragma("unroll") for(int r=4;r<16;r+=4){a=MX3(a,C0[r],C0[r+1]);b=MX3(b,C0[r+2],C0[r+3]);a=MX3(a,C1[r],C1[r+1]);b=MX3(b,C1[r+2],C1[r+3]);} \
      float rm=__builtin_fmaxf(a,b); { auto rr=__builtin_amdgcn_permlane32_swap(__float_as_uint(rm),__float_as_uint(rm),false,false); rm=__builtin_fmaxf(__uint_as_float(rr[0]),__uint_as_float(rr[1])); } \
      resc=false; \
      if(__builtin_expect(__any(rm>(float)THRL),0)){ const float dl=__builtin_fmaxf(rm,0.f); mhat+=dl; \
        _Pragma("unroll") for(int r=0;r<16;++r){C0[r]-=dl;C1[r]-=dl;} \
        _Pragma("unroll") for(int r=0;r<16;++r)negm[r]=-mhat; asm volatile("":"+v"(negm)); \
        const float f=__builtin_amdgcn_exp2f(-dl); l_reg*=f; if(hi==0)wsf[r32]=f; resc=true; } } \
    SBAR(); \
    GAPB(o[0]=__builtin_amdgcn_mfma_f32_32x32x16_bf16(PAF(0),VFR(0),o[0],0,0,0), C0,0); \
    GAPB(o[1]=__builtin_amdgcn_mfma_f32_32x32x16_bf16(PAF(0),VFR(4),o[1],0,0,0), C0,4); \
    KRD(GL,0); GAPB(o[0]=__builtin_amdgcn_mfma_f32_32x32x16_bf16(PAF(1),VFR(1),o[0],0,0,0), C0,8); \
    KRD(GL,1); GAPB(o[1]=__builtin_amdgcn_mfma_f32_32x32x16_bf16(PAF(1),VFR(5),o[1],0,0,0), C0,12); \
    KRD(GL,2); GAPB(o[0]=__builtin_amdgcn_mfma_f32_32x32x16_bf16(PAF(2),VFR(2),o[0],0,0,0), C1,0); \
    KRD(GL,3); GAPB(o[1]=__builtin_amdgcn_mfma_f32_32x32x16_bf16(PAF(2),VFR(6),o[1],0,0,0), C1,4); \
    GAPB(o[0]=__builtin_amdgcn_mfma_f32_32x32x16_bf16(PAF(3),VFR(3),o[0],0,0,0), C1,8); \
    GAPB(o[1]=__builtin_amdgcn_mfma_f32_32x32x16_bf16(PAF(3),VFR(7),o[1],0,0,0), C1,12); \
    }while(0)
  int t=1;
  #undef CMASK
  #define CMASK(P0,P1,t) do{}while(0)
  for(;t+5<NT;t+=2){
    STEP(pB0,pB1,pA0,pA1,t,true,true,true);     WAIT_BAR(2); RESC(); ROT();
    STEP(pA0,pA1,pB0,pB1,t+1,true,true,true);   WAIT_BAR(2); RESC(); ROT();
  }
  #undef CMASK
  #define CMASK(P0,P1,t) do{}while(0)
  #define ENDW(tt) do{ if((tt)+3<NT){WAIT_BAR(2);} else if((tt)+2<NT){WAIT_BAR(1);} else {WAIT_BAR(0);} }while(0)
  for(;t+1<NT;t+=2){
    STEP(pB0,pB1,pA0,pA1,t,(t+3<NT),(t+1<NT),(t+1<NT));       ENDW(t);   RESC(); ROT();
    STEP(pA0,pA1,pB0,pB1,t+1,(t+4<NT),(t+2<NT),(t+2<NT));     ENDW(t+1); RESC(); ROT();
  }
  STEP(pB0,pB1,pA0,pA1,NT-1,false,false,false); RESC();
  { float sacc=pB0[0]+pB0[1]; _Pragma("unroll") for(int r=2;r<16;++r)sacc+=pB0[r]; _Pragma("unroll") for(int r=0;r<16;++r)sacc+=pB1[r]; l_reg+=sacc;
    pw0=(u32x4){PKW(pB0,0),PKW(pB0,2),PKW(pB0,4),PKW(pB0,6)};pw1=(u32x4){PKW(pB0,8),PKW(pB0,10),PKW(pB0,12),PKW(pB0,14)};pw2=(u32x4){PKW(pB1,0),PKW(pB1,2),PKW(pB1,4),PKW(pB1,6)};pw3=(u32x4){PKW(pB1,8),PKW(pB1,10),PKW(pB1,12),PKW(pB1,14)};
    SBAR(); pv(o,vb0+sl_cur,PAF(0),PAF(1),PAF(2),PAF(3)); }
  #undef PKW
  #undef PAF
  #undef VFR
  #undef PIN
  #undef MX3
  #undef GAPA
  #undef GAPB
  #undef EX
  #undef VRD
  #undef KRD
  #undef STEP
  #undef ENDW
  {auto rr=__builtin_amdgcn_permlane32_swap(__float_as_uint(l_reg),__float_as_uint(l_reg),false,false);l_reg=__uint_as_float(rr[0])+__uint_as_float(rr[1]);}
  if(hi==0)wsf[32+r32]=l_reg;asm volatile("s_waitcnt lgkmcnt(0)":::"memory");
  float rli[16];
  #pragma unroll
  for(int r=0;r<16;++r)rli[r]=__builtin_amdgcn_rcpf(wsf[32+crow(r,hi)]);
  bf16*Ow=O+(rowbase+q0+wid*QBLK)*DM+h*D;
  { bf16*stg=(bf16*)(shm+LDS_OST)+wid*2048;
    #pragma unroll
    for(int r=0;r<16;++r){const int orow=crow(r,hi);
      #pragma unroll
      for(int d0=0;d0<2;++d0)stg[orow*64+d0*32+r32]=__float2bfloat16(o[d0][r]*rli[r]);}
    asm volatile("s_waitcnt lgkmcnt(0)":::"memory");
    #pragma unroll
    for(int i=0;i<4;++i){const int row=i*8+(lane>>3),ch=lane&7; const u32x4 v=*(const u32x4*)(stg+row*64+ch*8); ATTN_STORE16(Ow+(long)row*DM+ch*8,v);} }
  asm volatile("s_waitcnt lgkmcnt(0)\n\ts_barrier":::"memory");
  #undef DMA_K
  #undef DMA_V
  #undef CMASK
  #undef START
  #undef RESC
  #undef ROT
}
constexpr int ATTN_LDS_BYTES=LDS_BYTES;
struct AttnTensors { const bf16* Q; const bf16* K; const bf16* V; bf16* O; };
struct AttnUnit { int bh; int qb; };
struct StaticOrder {
  int vcu;
  __device__ __forceinline__ explicit StaticOrder(int grid,int block):vcu((block%8)*(grid/8)+block/8){}
  __device__ __forceinline__ bool next(int i,AttnUnit&u)const{ if(i>=4)return false; const int x=vcu>>5,c=vcu&31,idx=32*i+c; u.bh=2*x+(idx>>6); u.qb=idx&63; return true; }
  __device__ __forceinline__ void a_ready(const AttnUnit&)const{}
  __device__ __forceinline__ void done(const AttnUnit&)const{}
};
template<class Sched,int THRL=8> __device__ __forceinline__ void attn_phase(char*lds,const AttnTensors&T,const Sched&S){
  AttnUnit u;
  for(int i=0;S.next(i,u);++i){ S.a_ready(u); attn_unit<THRL>(u.bh/NHEAD,u.bh%NHEAD,u.qb,T.Q,T.K,T.V,T.O,lds); S.done(u); }
}
#undef SBAR
#undef WAIT_BAR
}
constexpr int NWAVES = 8;
constexpr int M = 16384, D = 1024, FF = 2816, NIN = 4096, MEMLEN = 256, NCH = 512;
constexpr float C2Q = 0.125f * 1.4426950408889634f;
constexpr size_t MiB = 1u << 20, KiB = 1u << 10;
constexpr size_t WS_CTL = 0, CTL_ZERO_BYTES = 1 * MiB;
constexpr size_t WS_SS2 = 256 * KiB, WS_SS3 = 320 * KiB, WS_SS4 = 384 * KiB, WS_SS5 = 448 * KiB;
constexpr size_t WS_SMALL = 1 * MiB;
constexpr size_t WS_RS1 = WS_SMALL, WS_ROPE = WS_SMALL + 64 * KiB, WS_DFT = WS_SMALL + 112 * KiB, WS_TW = WS_SMALL + 128 * KiB, WS_KC = WS_SMALL + 256 * KiB, WS_VC = WS_SMALL + 384 * KiB;
constexpr size_t WS_W1GU = 2 * MiB, WS_W1D = 13 * MiB, WS_W2GU = 18 * MiB + 512 * KiB, WS_W2D = 29 * MiB + 512 * KiB, WS_WIN = 35 * MiB, WS_WFB = 43 * MiB, WS_WAB = 45 * MiB, WS_WOUT = 47 * MiB,
                 WS_WCQ = 49 * MiB, WS_WCO = 49 * MiB + 512 * KiB;
constexpr size_t WS_HB16 = 56 * MiB;
constexpr size_t WS_R1 = 88 * MiB;
constexpr size_t WS_QO = WS_R1, WS_U = WS_R1 + 32 * MiB, WS_KR = WS_R1 + 64 * MiB, WS_VR = WS_R1 + 72 * MiB, WS_F = WS_R1 + 80 * MiB;
constexpr size_t WS_QC = WS_R1, WS_OC = WS_R1 + 8 * MiB;
constexpr size_t WS_GF = 184 * MiB, WS_GA = 216 * MiB, WS_END = 248 * MiB;
static_assert(WS_W1GU + (size_t)2 * FF * D * 2 == WS_W1D && WS_W1D + (size_t)D * FF * 2 == WS_W2GU && WS_W2GU + (size_t)2 * FF * D * 2 == WS_W2D && WS_W2D + (size_t)D * FF * 2 == WS_WIN, "weights map");
static_assert(WS_R1 + (size_t)M * FF * 2 <= WS_GF && WS_F + (size_t)M * NCH * 2 <= WS_GF, "R1 map");
constexpr int CW_BAR = 4096;
constexpr int RING_BYTES = 131072, LDSCTL_OFF = RING_BYTES, MISC_OFF = LDSCTL_OFF + 320, LDS_BYTES = 147456;

#define GAS __attribute__((address_space(1)))
#define LAS __attribute__((address_space(3)))
typedef unsigned short bf16;
typedef unsigned v4u __attribute__((ext_vector_type(4)));
typedef float f32x4 __attribute__((ext_vector_type(4)));
typedef float f32x2 __attribute__((ext_vector_type(2)));
#define LDS_WAIT() asm volatile("s_waitcnt lgkmcnt(0)" ::: "memory")
#define VM_WAIT() asm volatile("s_waitcnt vmcnt(0)" ::: "memory")
__device__ __forceinline__ unsigned f2bf(float f) { unsigned u = __builtin_bit_cast(unsigned, f); return (u + 0x7fffu + ((u >> 16) & 1u)) >> 16; }
__device__ __forceinline__ unsigned pk2(float lo, float hi) { return f2bf(lo) | (f2bf(hi) << 16); }
__device__ __forceinline__ float bf2f(unsigned short b) { return __uint_as_float((unsigned)b << 16); }
__device__ __forceinline__ float bflo_(unsigned u) { return __uint_as_float(u << 16); }
__device__ __forceinline__ float bfhi_(unsigned u) { return __uint_as_float(u & 0xffff0000u); }
constexpr float RMS_EPSF = 1e-6f;
__device__ __forceinline__ float wave_sum(float v) {
#pragma unroll
    for (int o = 1; o < 64; o <<= 1) v += __shfl_xor(v, o);
    return v;
}
__device__ __forceinline__ void sincos_rev(double x, float& s, float& c) {
    x -= __builtin_floor(x);
    const double q = __builtin_rint(x * 4.0);
    const double r = (x - q * 0.25) * 6.283185307179586476925;
    const double r2 = r * r;
    double sp = 1.0 / 6227020800.0; sp = sp * r2 - 1.0 / 39916800.0; sp = sp * r2 + 1.0 / 362880.0; sp = sp * r2 - 1.0 / 5040.0; sp = sp * r2 + 1.0 / 120.0; sp = sp * r2 - 1.0 / 6.0; sp = sp * r2 + 1.0; sp *= r;
    double cp = -1.0 / 87178291200.0; cp = cp * r2 + 1.0 / 479001600.0; cp = cp * r2 - 1.0 / 3628800.0; cp = cp * r2 + 1.0 / 40320.0; cp = cp * r2 - 1.0 / 720.0; cp = cp * r2 + 1.0 / 24.0; cp = cp * r2 - 0.5; cp = cp * r2 + 1.0;
    const int qi = (int)q & 3;
    const double ss = (qi == 0) ? sp : (qi == 1) ? cp : (qi == 2) ? -sp : -cp;
    const double cc = (qi == 0) ? cp : (qi == 1) ? -sp : (qi == 2) ? -cp : sp;
    s = (float)ss; c = (float)cc;
}

struct Frame {
    LAS unsigned char* lds;
    int tid, lane, wave, G, vcu;
    const float* in[24]; float* out; unsigned char* ws;
};
template <class T> __device__ __forceinline__ T* wsp(const Frame& F, size_t off) { return (T*)(F.ws + off); }

__device__ __forceinline__ void p0_transpose_item(const float* W, const float* gain, int K, int N, bf16* WT, int gu, LAS float* scr, int item, int lane) {
    const int nblk = N / 32, kb = item / nblk, nb = item % nblk, k0 = 64 * kb, n0 = 32 * nb;
#pragma unroll 8
    for (int i = 0; i < 32; ++i) { const int kk = 2 * i + (lane >> 5); float v = W[(size_t)(k0 + kk) * N + n0 + (lane & 31)]; if (gain) v *= gain[k0 + kk]; scr[kk * 33 + (lane & 31)] = v; }
    LDS_WAIT(); asm volatile("" ::: "memory");
    const int c = lane & 7;
    const int rb = (gu == 0) ? n0 : (256 * (n0 >> 7) + (n0 & 127) + (gu == 2 ? 128 : 0));
#pragma unroll
    for (int j = 0; j < 4; ++j) { const int n = (lane >> 3) + 8 * j; const LAS float* s = scr + (8 * c) * 33 + n;
        v4u o; o.x = pk2(s[0 * 33], s[1 * 33]); o.y = pk2(s[2 * 33], s[3 * 33]); o.z = pk2(s[4 * 33], s[5 * 33]); o.w = pk2(s[6 * 33], s[7 * 33]);
        *(GAS v4u*)(WT + (size_t)(rb + n) * K + k0 + 8 * c) = o; }
    LDS_WAIT(); asm volatile("" ::: "memory");
}
__device__ __forceinline__ void p0_prologue(Frame& F) {
    const int gw = F.vcu * NWAVES + F.wave, NGW = F.G * NWAVES;
    const int gt = blockIdx.x * (NWAVES * 64) + F.tid, NGT = F.G * NWAVES * 64;
    {
        f32x2* tw = wsp<f32x2>(F, WS_TW); f32x2* dft = wsp<f32x2>(F, WS_DFT); float* rope = wsp<float>(F, WS_ROPE);
        for (int i = gt; i < 16384; i += NGT) { float s, c; sincos_rev((double)i * (1.0 / 16384.0), s, c); tw[i] = (f32x2){c, s}; }
        for (int i = gt; i < 128; i += NGT) { float s, c; sincos_rev((double)i * (1.0 / 128.0), s, c); dft[i] = (f32x2){c, s}; }
        for (int i = gt; i < (256 + 64) * 16; i += NGT) {
            const int j = i & 15, p = i >> 4; const int pos = (p < 256) ? p : p - 256;
            double inv = 1.0; for (int q = 0; q < j; ++q) inv *= 0.5623413251903491;
            const float ang = (float)pos * (float)inv;
            float s, c; sincos_rev((double)ang * 0.15915494309189533577, s, c);
            if (p < 256) { rope[p * 16 + j] = c; rope[4096 + p * 16 + j] = s; } else { rope[8192 + pos * 16 + j] = c; rope[8192 + 1024 + pos * 16 + j] = s; }
        }
    }
    {
        LAS float* scr = (LAS float*)(F.lds + F.wave * 16384);
        constexpr int I_GU = (D / 64) * (FF / 32), I_DN = (FF / 64) * (D / 32), I_IN = (D / 64) * (NIN / 32), I_SQ = (D / 64) * (D / 32), I_CQ = (D / 64) * (256 / 32), I_CO = (256 / 64) * (D / 32);
        constexpr int NITEMS = 4 * I_GU + 2 * I_DN + I_IN + 2 * I_SQ + I_CQ + I_CO;
        for (int it = gw; it < NITEMS; it += NGW) {
            int r = it;
            if (r < I_GU) { p0_transpose_item(F.in[3], F.in[2], D, FF, wsp<bf16>(F, WS_W1GU), 1, scr, r, F.lane); continue; } r -= I_GU;
            if (r < I_GU) { p0_transpose_item(F.in[4], F.in[2], D, FF, wsp<bf16>(F, WS_W1GU), 2, scr, r, F.lane); continue; } r -= I_GU;
            if (r < I_DN) { p0_transpose_item(F.in[5], nullptr, FF, D, wsp<bf16>(F, WS_W1D), 0, scr, r, F.lane); continue; } r -= I_DN;
            if (r < I_GU) { p0_transpose_item(F.in[20], F.in[19], D, FF, wsp<bf16>(F, WS_W2GU), 1, scr, r, F.lane); continue; } r -= I_GU;
            if (r < I_GU) { p0_transpose_item(F.in[21], F.in[19], D, FF, wsp<bf16>(F, WS_W2GU), 2, scr, r, F.lane); continue; } r -= I_GU;
            if (r < I_DN) { p0_transpose_item(F.in[22], nullptr, FF, D, wsp<bf16>(F, WS_W2D), 0, scr, r, F.lane); continue; } r -= I_DN;
            if (r < I_IN) { p0_transpose_item(F.in[7], F.in[6], D, NIN, wsp<bf16>(F, WS_WIN), 0, scr, r, F.lane); continue; } r -= I_IN;
            if (r < I_SQ) { p0_transpose_item(F.in[11], nullptr, D, D, wsp<bf16>(F, WS_WAB), 0, scr, r, F.lane); continue; } r -= I_SQ;
            if (r < I_SQ) { p0_transpose_item(F.in[12], nullptr, D, D, wsp<bf16>(F, WS_WOUT), 0, scr, r, F.lane); continue; } r -= I_SQ;
            if (r < I_CQ) { p0_transpose_item(F.in[15], F.in[13], D, 256, wsp<bf16>(F, WS_WCQ), 0, scr, r, F.lane); continue; } r -= I_CQ;
            p0_transpose_item(F.in[18], nullptr, 256, D, wsp<bf16>(F, WS_WCO), 0, scr, r, F.lane);
        }
    }
    __syncthreads();
    {
        LAS f32x2* tab = (LAS f32x2*)F.lds;
        if (F.tid < 128) { float s, c; sincos_rev((double)F.tid * (1.0 / 128.0), s, c); tab[F.tid] = (f32x2){c * 0.08838834764831845f, s * 0.08838834764831845f}; }
        __syncthreads();
        const float* Wfb = F.in[10]; bf16* WT = wsp<bf16>(F, WS_WFB);
        for (int it = gt; it < 1024 * 128; it += NGT) {
            const int n = it & 1023, kb = it >> 10, kk0 = kb * 8, g = kk0 >> 8, ri = (kk0 >> 7) & 1, c0 = kk0 & 127;
            float a[8];
#pragma unroll
            for (int i = 0; i < 8; ++i) a[i] = 0.f;
            for (int j = 0; j < 128; ++j) {
                const float w = Wfb[(size_t)(g * 128 + j) * 1024 + n];
#pragma unroll
                for (int i = 0; i < 8; ++i) { const f32x2 cs = tab[((c0 + i) * j) & 127]; a[i] += w * (ri ? cs.y : cs.x); }
            }
            v4u o; o.x = pk2(a[0], a[1]); o.y = pk2(a[2], a[3]); o.z = pk2(a[4], a[5]); o.w = pk2(a[6], a[7]);
            *(GAS v4u*)(WT + (size_t)n * 1024 + kk0) = o;
        }
        __syncthreads();
    }
    {
        const float* x = F.in[0]; bf16* xb = wsp<bf16>(F, WS_HB16); float* rs1 = wsp<float>(F, WS_RS1);
        for (int m = gw; m < M; m += NGW) {
            const GAS f32x4* xr = (const GAS f32x4*)(x + (size_t)m * D) + F.lane;
            f32x4 v[4]; float s = 0.f;
#pragma unroll
            for (int j = 0; j < 4; ++j) { v[j] = xr[64 * j]; s += (v[j].x * v[j].x + v[j].y * v[j].y) + (v[j].z * v[j].z + v[j].w * v[j].w); }
            s = wave_sum(s);
            GAS unsigned long long* o8 = (GAS unsigned long long*)(xb + (size_t)m * D) + F.lane;
#pragma unroll
            for (int j = 0; j < 4; ++j) o8[64 * j] = (unsigned long long)pk2(v[j].x, v[j].y) | ((unsigned long long)pk2(v[j].z, v[j].w) << 32);
            if (F.lane == 0) rs1[m] = 1.0f / sqrtf(s * (1.0f / D) + RMS_EPSF);
        }
    }
    {
        LAS float* mn = (LAS float*)(F.lds + 8192); LAS float* red = (LAS float*)(F.lds + 8192 + 4096);
        const float* mem = F.in[1]; const float* gm = F.in[14]; const float* Wk = F.in[16]; const float* Wv = F.in[17];
        bf16* Kc = wsp<bf16>(F, WS_KC); bf16* Vc = wsp<bf16>(F, WS_VC);
        for (int r = blockIdx.x; r < MEMLEN; r += F.G) {
            __syncthreads();
            const float a = mem[(size_t)r * D + F.tid], b = mem[(size_t)r * D + 512 + F.tid];
            float s = wave_sum(a * a + b * b);
            if (F.lane == 0) red[F.wave] = s;
            __syncthreads();
            float tot = 0.f;
#pragma unroll
            for (int w = 0; w < NWAVES; ++w) tot += red[w];
            const float rinv = 1.0f / sqrtf(tot * (1.0f / D) + RMS_EPSF);
            mn[F.tid] = a * rinv * gm[F.tid]; mn[512 + F.tid] = b * rinv * gm[512 + F.tid];
            __syncthreads();
            const int n = F.tid & 255; const float* W = (F.tid < 256) ? Wk : Wv; float acc = 0.f;
            for (int k = 0; k < D; ++k) acc += mn[k] * W[(size_t)k * 256 + n];
            ((F.tid < 256) ? Kc : Vc)[r * 256 + n] = (bf16)f2bf(acc);
        }
        __syncthreads();
    }
}

__device__ __forceinline__ void p_prep_qk(Frame& F) {
    bf16* Q = wsp<bf16>(F, WS_QO); bf16* Kr = wsp<bf16>(F, WS_KR); const float* rope = wsp<float>(F, WS_ROPE);
    const float* qg = F.in[8]; const float* kg = F.in[9];
    const int gt = blockIdx.x * (NWAVES * 64) + F.tid, NGT = F.G * NWAVES * 64;
    for (int it = gt; it < M * 20; it += NGT) {
        const int t = it / 20, hh = it - t * 20;
        bf16* p = (hh < 16) ? (Q + (size_t)t * 1024 + hh * 64) : (Kr + (size_t)t * 256 + (hh - 16) * 64);
        const float* gain = (hh < 16) ? qg : kg; const float post = (hh < 16) ? C2Q : 1.0f;
        float v[64];
#pragma unroll
        for (int i = 0; i < 8; ++i) { const v4u w = *(const GAS v4u*)(p + 8 * i);
            v[8 * i + 0] = __uint_as_float(w.x << 16); v[8 * i + 1] = __uint_as_float(w.x & 0xffff0000u); v[8 * i + 2] = __uint_as_float(w.y << 16); v[8 * i + 3] = __uint_as_float(w.y & 0xffff0000u);
            v[8 * i + 4] = __uint_as_float(w.z << 16); v[8 * i + 5] = __uint_as_float(w.z & 0xffff0000u); v[8 * i + 6] = __uint_as_float(w.w << 16); v[8 * i + 7] = __uint_as_float(w.w & 0xffff0000u); }
        float s = 0.f;
#pragma unroll
        for (int i = 0; i < 64; ++i) s += v[i] * v[i];
        const float rinv = 1.0f / sqrtf(s * (1.0f / 64.0f) + RMS_EPSF);
#pragma unroll
        for (int i = 0; i < 64; ++i) v[i] = v[i] * rinv * gain[i];
        const int row = t >> 6, col = t & 63;
#pragma unroll
        for (int j = 0; j < 16; ++j) {
            const float cr = rope[row * 16 + j], sr = rope[4096 + row * 16 + j], cc = rope[8192 + col * 16 + j], sc = rope[8192 + 1024 + col * 16 + j];
            const float a = v[j], b = v[16 + j]; v[j] = a * cr - b * sr; v[16 + j] = b * cr + a * sr;
            const float e = v[32 + j], f = v[48 + j]; v[32 + j] = e * cc - f * sc; v[48 + j] = f * cc + e * sc;
        }
#pragma unroll
        for (int i = 0; i < 8; ++i) { v4u o; o.x = pk2(v[8 * i] * post, v[8 * i + 1] * post); o.y = pk2(v[8 * i + 2] * post, v[8 * i + 3] * post); o.z = pk2(v[8 * i + 4] * post, v[8 * i + 5] * post); o.w = pk2(v[8 * i + 6] * post, v[8 * i + 7] * post);
            *(GAS v4u*)(p + 8 * i) = o; }
    }
}
__device__ __forceinline__ void p_fftA_simple(Frame& F) {
    const bf16* X = wsp<bf16>(F, WS_F); bf16* A = wsp<bf16>(F, WS_HB16); const f32x2* tw = wsp<f32x2>(F, WS_TW); const f32x2* dft = wsp<f32x2>(F, WS_DFT);
    LAS bf16* Xs = (LAS bf16*)F.lds; LAS f32x2* tab = (LAS f32x2*)(F.lds + 65536);
    if (F.tid < 128) tab[F.tid] = dft[F.tid];
    for (int unit = blockIdx.x; unit < 512; unit += F.G) {
        const int t2 = unit >> 2, g = unit & 3;
        __syncthreads();
#pragma unroll
        for (int i = 0; i < 4; ++i) { const int q = F.tid + 512 * i, row = q >> 4, ch = q & 15;
            *(LAS v4u*)(Xs + row * 128 + ch * 8) = *(const GAS v4u*)(X + (size_t)(128 * row + t2) * NCH + g * 128 + ch * 8); }
        __syncthreads();
        const int c = F.tid & 127, kq = F.tid >> 7;
        for (int k1 = kq * 32; k1 < kq * 32 + 32; ++k1) {
            float ar = 0.f, ai = 0.f; int idx = 0;
#pragma unroll 8
            for (int t1 = 0; t1 < 128; ++t1) { const float x = bf2f(Xs[t1 * 128 + c]); const f32x2 cs = tab[idx]; ar += x * cs.x; ai -= x * cs.y; idx = (idx + k1) & 127; }
            ar *= 0.08838834764831845f; ai *= 0.08838834764831845f;
            const f32x2 w = tw[t2 * k1];
            const float br = ar * w.x + ai * w.y, bi = ai * w.x - ar * w.y;
            bf16* o = A + ((size_t)(k1 * 128 + t2) * 4 + g) * 256 + c;
            o[0] = (bf16)f2bf(br); o[128] = (bf16)f2bf(bi);
        }
    }
    __syncthreads();
}
__device__ __forceinline__ void p_fftB_simple(Frame& F) {
    const bf16* A = wsp<bf16>(F, WS_HB16); bf16* U = wsp<bf16>(F, WS_U); const f32x2* dft = wsp<f32x2>(F, WS_DFT);
    LAS bf16* As = (LAS bf16*)F.lds; LAS f32x2* tab = (LAS f32x2*)(F.lds + 65536);
    if (F.tid < 128) tab[F.tid] = dft[F.tid];
    for (int unit = blockIdx.x; unit < 512; unit += F.G) {
        const int k1 = unit >> 2, g = unit & 3;
        __syncthreads();
#pragma unroll
        for (int i = 0; i < 8; ++i) { const int q = F.tid + 512 * i, row = q >> 5, ch = q & 31;
            *(LAS v4u*)(As + row * 256 + ch * 8) = *(const GAS v4u*)(A + ((size_t)(k1 * 128 + row) * 4 + g) * 256 + ch * 8); }
        __syncthreads();
        const int c = F.tid & 127, kq = F.tid >> 7;
        for (int k2 = kq * 32; k2 < kq * 32 + 32; ++k2) {
            float ur = 0.f, ui = 0.f; int idx = 0;
#pragma unroll 8
            for (int t2 = 0; t2 < 128; ++t2) { const float ar = bf2f(As[t2 * 256 + c]), ai = bf2f(As[t2 * 256 + 128 + c]); const f32x2 cs = tab[idx];
                ur += ar * cs.x + ai * cs.y; ui += ai * cs.x - ar * cs.y; idx = (idx + k2) & 127; }
            bf16* o = U + (size_t)(k1 + 128 * k2) * 1024 + g * 256 + c;
            o[0] = (bf16)f2bf(ur * 0.08838834764831845f); o[128] = (bf16)f2bf(ui * 0.08838834764831845f);
        }
    }
    __syncthreads();
}
__device__ __forceinline__ void p_attn_simple(Frame& F) {
    bf16* Q = wsp<bf16>(F, WS_QO); const bf16* Kr = wsp<bf16>(F, WS_KR); const bf16* Vr = wsp<bf16>(F, WS_VR);
    const int gt = blockIdx.x * (NWAVES * 64) + F.tid, NGT = F.G * NWAVES * 64;
    for (int it = gt; it < M * 16; it += NGT) {
        const int h = it >> 14, t = it & (M - 1), kvh = h >> 2;
        bf16* qp = Q + (size_t)t * 1024 + h * 64;
        float q[64], o[64];
#pragma unroll
        for (int i = 0; i < 8; ++i) { const v4u w = *(const GAS v4u*)(qp + 8 * i);
            q[8 * i + 0] = bflo_(w.x); q[8 * i + 1] = bfhi_(w.x); q[8 * i + 2] = bflo_(w.y); q[8 * i + 3] = bfhi_(w.y); q[8 * i + 4] = bflo_(w.z); q[8 * i + 5] = bfhi_(w.z); q[8 * i + 6] = bflo_(w.w); q[8 * i + 7] = bfhi_(w.w); }
#pragma unroll
        for (int i = 0; i < 64; ++i) o[i] = 0.f;
        float mx = -1e30f, l = 0.f;
        for (int key = 0; key < M; ++key) {
            const bf16* kp = Kr + (size_t)key * 256 + kvh * 64; const bf16* vp = Vr + (size_t)key * 256 + kvh * 64;
            float s = 0.f;
#pragma unroll
            for (int i = 0; i < 8; ++i) { const v4u w = *(const GAS v4u*)(kp + 8 * i);
                s += q[8 * i + 0] * bflo_(w.x) + q[8 * i + 1] * bfhi_(w.x) + q[8 * i + 2] * bflo_(w.y) + q[8 * i + 3] * bfhi_(w.y) + q[8 * i + 4] * bflo_(w.z) + q[8 * i + 5] * bfhi_(w.z) + q[8 * i + 6] * bflo_(w.w) + q[8 * i + 7] * bfhi_(w.w); }
            const float mn = fmaxf(mx, s), al = __builtin_amdgcn_exp2f(mx - mn), p = __builtin_amdgcn_exp2f(s - mn);
            l = l * al + p; mx = mn;
#pragma unroll
            for (int i = 0; i < 8; ++i) { const v4u w = *(const GAS v4u*)(vp + 8 * i);
                o[8 * i + 0] = o[8 * i + 0] * al + p * bflo_(w.x); o[8 * i + 1] = o[8 * i + 1] * al + p * bfhi_(w.x); o[8 * i + 2] = o[8 * i + 2] * al + p * bflo_(w.y); o[8 * i + 3] = o[8 * i + 3] * al + p * bfhi_(w.y);
                o[8 * i + 4] = o[8 * i + 4] * al + p * bflo_(w.z); o[8 * i + 5] = o[8 * i + 5] * al + p * bfhi_(w.z); o[8 * i + 6] = o[8 * i + 6] * al + p * bflo_(w.w); o[8 * i + 7] = o[8 * i + 7] * al + p * bfhi_(w.w); }
        }
        const float li = 1.0f / l;
#pragma unroll
        for (int i = 0; i < 8; ++i) { v4u w; w.x = pk2(o[8 * i] * li, o[8 * i + 1] * li); w.y = pk2(o[8 * i + 2] * li, o[8 * i + 3] * li); w.z = pk2(o[8 * i + 4] * li, o[8 * i + 5] * li); w.w = pk2(o[8 * i + 6] * li, o[8 * i + 7] * li);
            *(GAS v4u*)(qp + 8 * i) = w; }
    }
}
__device__ __forceinline__ void p_cross_simple(Frame& F) {
    const bf16* QC = wsp<bf16>(F, WS_QC); bf16* OC = wsp<bf16>(F, WS_OC); const bf16* Kc = wsp<bf16>(F, WS_KC); const bf16* Vc = wsp<bf16>(F, WS_VC);
    const int gt = blockIdx.x * (NWAVES * 64) + F.tid, NGT = F.G * NWAVES * 64;
    for (int it = gt; it < M * 4; it += NGT) {
        const int h = it >> 14, t = it & (M - 1);
        const bf16* qp = QC + (size_t)t * 256 + h * 64;
        float q[64], o[64];
#pragma unroll
        for (int i = 0; i < 8; ++i) { const v4u w = *(const GAS v4u*)(qp + 8 * i);
            q[8 * i + 0] = bflo_(w.x) * C2Q; q[8 * i + 1] = bfhi_(w.x) * C2Q; q[8 * i + 2] = bflo_(w.y) * C2Q; q[8 * i + 3] = bfhi_(w.y) * C2Q; q[8 * i + 4] = bflo_(w.z) * C2Q; q[8 * i + 5] = bfhi_(w.z) * C2Q; q[8 * i + 6] = bflo_(w.w) * C2Q; q[8 * i + 7] = bfhi_(w.w) * C2Q; }
#pragma unroll
        for (int i = 0; i < 64; ++i) o[i] = 0.f;
        float mx = -1e30f, l = 0.f;
        for (int key = 0; key < MEMLEN; ++key) {
            const bf16* kp = Kc + key * 256 + h * 64; const bf16* vp = Vc + key * 256 + h * 64;
            float s = 0.f;
#pragma unroll
            for (int i = 0; i < 8; ++i) { const v4u w = *(const GAS v4u*)(kp + 8 * i);
                s += q[8 * i + 0] * bflo_(w.x) + q[8 * i + 1] * bfhi_(w.x) + q[8 * i + 2] * bflo_(w.y) + q[8 * i + 3] * bfhi_(w.y) + q[8 * i + 4] * bflo_(w.z) + q[8 * i + 5] * bfhi_(w.z) + q[8 * i + 6] * bflo_(w.w) + q[8 * i + 7] * bfhi_(w.w); }
            const float mn = fmaxf(mx, s), al = __builtin_amdgcn_exp2f(mx - mn), p = __builtin_amdgcn_exp2f(s - mn);
            l = l * al + p; mx = mn;
#pragma unroll
            for (int i = 0; i < 8; ++i) { const v4u w = *(const GAS v4u*)(vp + 8 * i);
                o[8 * i + 0] = o[8 * i + 0] * al + p * bflo_(w.x); o[8 * i + 1] = o[8 * i + 1] * al + p * bfhi_(w.x); o[8 * i + 2] = o[8 * i + 2] * al + p * bflo_(w.y); o[8 * i + 3] = o[8 * i + 3] * al + p * bfhi_(w.y);
                o[8 * i + 4] = o[8 * i + 4] * al + p * bflo_(w.z); o[8 * i + 5] = o[8 * i + 5] * al + p * bfhi_(w.z); o[8 * i + 6] = o[8 * i + 6] * al + p * bflo_(w.w); o[8 * i + 7] = o[8 * i + 7] * al + p * bfhi_(w.w); }
        }
        const float li = 1.0f / l; bf16* op = OC + (size_t)t * 256 + h * 64;
#pragma unroll
        for (int i = 0; i < 8; ++i) { v4u w; w.x = pk2(o[8 * i] * li, o[8 * i + 1] * li); w.y = pk2(o[8 * i + 2] * li, o[8 * i + 3] * li); w.z = pk2(o[8 * i + 4] * li, o[8 * i + 5] * li); w.w = pk2(o[8 * i + 6] * li, o[8 * i + 7] * li);
            *(GAS v4u*)(op + 8 * i) = w; }
    }
}
__device__ __forceinline__ void p_final(Frame& F) {
    const int gw = F.vcu * NWAVES + F.wave, NGW = F.G * NWAVES; const float* gf = F.in[23];
    f32x4 gv[4];
#pragma unroll
    for (int j = 0; j < 4; ++j) gv[j] = ((const GAS f32x4*)gf)[F.lane + 64 * j];
    for (int m = gw; m < M; m += NGW) {
        GAS f32x4* xr = (GAS f32x4*)(F.out + (size_t)m * D) + F.lane;
        f32x4 v[4]; float s = 0.f;
#pragma unroll
        for (int j = 0; j < 4; ++j) { v[j] = xr[64 * j]; s += (v[j].x * v[j].x + v[j].y * v[j].y) + (v[j].z * v[j].z + v[j].w * v[j].w); }
        const float rinv = 1.0f / sqrtf(wave_sum(s) * (1.0f / D) + RMS_EPSF);
#pragma unroll
        for (int j = 0; j < 4; ++j) xr[64 * j] = v[j] * rinv * gv[j];
    }
}
namespace fftm {
typedef short bf16x8 __attribute__((ext_vector_type(8)));
typedef short s16x4 __attribute__((ext_vector_type(4)));
typedef float f32x16 __attribute__((ext_vector_type(16)));
typedef short v4i16_t __attribute__((ext_vector_type(4)));
typedef LAS const unsigned char* lptr;
constexpr int STR_A = 320, STR_B = 576;
constexpr float RSQ128 = 0.08838834764831845f;
#define FFT_MFMA(a, b, c) __builtin_amdgcn_mfma_f32_32x32x16_bf16(a, b, c, 0, 0, 0)
__device__ __forceinline__ s16x4 vtr(lptr p) { return __builtin_bit_cast(s16x4, __builtin_amdgcn_ds_read_tr16_b64_v4i16((LAS v4i16_t*)p)); }
struct DftFrags { bf16x8 c[8], s[8]; };
__device__ __forceinline__ void make_frags(DftFrags& f, const f32x2* dft, int jb, int lane) {
    const int j = 32 * jb + (lane & 31), h = lane >> 5;
#pragma unroll
    for (int s = 0; s < 8; ++s)
#pragma unroll
        for (int e = 0; e < 8; ++e) { const f32x2 cs = dft[(j * (16 * s + 8 * h + e)) & 127]; f.c[s][e] = (short)f2bf(cs.x * RSQ128); f.s[s][e] = (short)f2bf(cs.y * RSQ128); }
}
template <int STRIDE> __device__ __forceinline__ bf16x8 tfrag(lptr p, int s) {
    const s16x4 lo = vtr(p + 16 * s * STRIDE), hi = vtr(p + 16 * s * STRIDE + 4 * STRIDE);
    return (bf16x8){lo[0], lo[1], lo[2], lo[3], hi[0], hi[1], hi[2], hi[3]};
}
template <int STRIDE> __device__ __forceinline__ int tfrag_lane_off(int lane) {
    const int g4 = lane >> 4, c0 = 16 * (g4 & 1), h = g4 >> 1, li = lane & 15, q = li >> 2, p = li & 3;
    return (8 * h + q) * STRIDE + (c0 + 4 * p) * 2;
}
__device__ __forceinline__ unsigned long long pk4(float a, float b, float c, float d) { return (unsigned long long)pg8::cvt_pk_bf16(a, b) | ((unsigned long long)pg8::cvt_pk_bf16(c, d) << 32); }

__device__ __forceinline__ void stageA(Frame& F) {
    const bf16* X = wsp<bf16>(F, WS_F); bf16* A = wsp<bf16>(F, WS_HB16); const f32x2* tw = wsp<f32x2>(F, WS_TW); const f32x2* dft = wsp<f32x2>(F, WS_DFT);
    const int jb = F.wave & 3, chh = F.wave >> 2, lane = F.lane, h = lane >> 5;
    DftFrags fr; make_frags(fr, dft, jb, lane);
    const lptr tp = (lptr)F.lds + tfrag_lane_off<STR_A>(lane) + 128 * chh;
    const int k1 = 32 * jb + (lane & 31);
    v4u pre[4];
    int unit = blockIdx.x;
    if (unit < 512) {
#pragma unroll
        for (int i = 0; i < 4; ++i) { const int q = F.tid + 512 * i, row = q >> 4, ch = q & 15; pre[i] = *(const GAS v4u*)(X + (size_t)(128 * row + (unit >> 2)) * NCH + (unit & 3) * 128 + ch * 8); }
    }
    for (; unit < 512; unit += F.G) {
        const int t2 = unit >> 2, g = unit & 3;
        __syncthreads();
#pragma unroll
        for (int i = 0; i < 4; ++i) { const int q = F.tid + 512 * i, row = q >> 4, ch = q & 15; *(LAS v4u*)(F.lds + row * STR_A + ch * 16) = pre[i]; }
        __syncthreads();
        const int nu = unit + F.G;
        if (nu < 512) {
#pragma unroll
            for (int i = 0; i < 4; ++i) { const int q = F.tid + 512 * i, row = q >> 4, ch = q & 15; pre[i] = *(const GAS v4u*)(X + (size_t)(128 * row + (nu >> 2)) * NCH + (nu & 3) * 128 + ch * 8); }
        }
        f32x16 acc[2][2];
#pragma unroll
        for (int cb = 0; cb < 2; ++cb) { acc[cb][0] = f32x16{}; acc[cb][1] = f32x16{}; }
#pragma unroll
        for (int s = 0; s < 8; ++s)
#pragma unroll
            for (int cb = 0; cb < 2; ++cb) { const bf16x8 a = tfrag<STR_A>(tp + 64 * cb, s); acc[cb][0] = FFT_MFMA(a, fr.c[s], acc[cb][0]); acc[cb][1] = FFT_MFMA(a, fr.s[s], acc[cb][1]); }
        const f32x2 w = tw[t2 * k1];
        bf16* orow = A + ((size_t)(k1 * 128 + t2) * 4 + g) * 256 + 64 * chh + 4 * h;
#pragma unroll
        for (int cb = 0; cb < 2; ++cb)
#pragma unroll
            for (int qd = 0; qd < 4; ++qd) {
                float re[4], im[4];
#pragma unroll
                for (int i = 0; i < 4; ++i) { const float a0 = acc[cb][0][4 * qd + i], a1 = acc[cb][1][4 * qd + i]; re[i] = a0 * w.x - a1 * w.y; im[i] = -a1 * w.x - a0 * w.y; }
                *(GAS unsigned long long*)(orow + 32 * cb + 8 * qd) = pk4(re[0], re[1], re[2], re[3]);
                *(GAS unsigned long long*)(orow + 128 + 32 * cb + 8 * qd) = pk4(im[0], im[1], im[2], im[3]);
            }
    }
    __syncthreads();
}
__device__ __forceinline__ void stageB(Frame& F) {
    const bf16* A = wsp<bf16>(F, WS_HB16); bf16* U = wsp<bf16>(F, WS_U); const f32x2* dft = wsp<f32x2>(F, WS_DFT);
    const int jb = F.wave & 3, chh = F.wave >> 2, lane = F.lane, h = lane >> 5;
    DftFrags fr; make_frags(fr, dft, jb, lane);
    const lptr tp = (lptr)F.lds + tfrag_lane_off<STR_B>(lane) + 128 * chh;
    const int k2 = 32 * jb + (lane & 31);
    v4u pre[8];
    int unit = blockIdx.x;
    if (unit < 512) {
#pragma unroll
        for (int i = 0; i < 8; ++i) { const int q = F.tid + 512 * i, row = q >> 5, ch = q & 31; pre[i] = *(const GAS v4u*)(A + ((size_t)((unit >> 2) * 128 + row) * 4 + (unit & 3)) * 256 + ch * 8); }
    }
    for (; unit < 512; unit += F.G) {
        const int k1 = unit >> 2, g = unit & 3;
        __syncthreads();
#pragma unroll
        for (int i = 0; i < 8; ++i) { const int q = F.tid + 512 * i, row = q >> 5, ch = q & 31; *(LAS v4u*)(F.lds + row * STR_B + ch * 16) = pre[i]; }
        __syncthreads();
        const int nu = unit + F.G;
        if (nu < 512) {
#pragma unroll
            for (int i = 0; i < 8; ++i) { const int q = F.tid + 512 * i, row = q >> 5, ch = q & 31; pre[i] = *(const GAS v4u*)(A + ((size_t)((nu >> 2) * 128 + row) * 4 + (nu & 3)) * 256 + ch * 8); }
        }
        f32x16 accR[2], accI[2];
#pragma unroll
        for (int cb = 0; cb < 2; ++cb) { accR[cb] = f32x16{}; accI[cb] = f32x16{}; }
#pragma unroll
        for (int s = 0; s < 8; ++s) {
            const bf16x8 ns = fr.s[s] ^ (short)0x8000;
#pragma unroll
            for (int cb = 0; cb < 2; ++cb) {
                const bf16x8 ar = tfrag<STR_B>(tp + 64 * cb, s), ai = tfrag<STR_B>(tp + 256 + 64 * cb, s);
                accR[cb] = FFT_MFMA(ar, fr.c[s], accR[cb]); accR[cb] = FFT_MFMA(ai, fr.s[s], accR[cb]);
                accI[cb] = FFT_MFMA(ai, fr.c[s], accI[cb]); accI[cb] = FFT_MFMA(ar, ns, accI[cb]);
            }
        }
        bf16* orow = U + (size_t)(k1 + 128 * k2) * 1024 + g * 256 + 64 * chh + 4 * h;
#pragma unroll
        for (int cb = 0; cb < 2; ++cb)
#pragma unroll
            for (int qd = 0; qd < 4; ++qd) {
                *(GAS unsigned long long*)(orow + 32 * cb + 8 * qd) = pk4(accR[cb][4 * qd], accR[cb][4 * qd + 1], accR[cb][4 * qd + 2], accR[cb][4 * qd + 3]);
                *(GAS unsigned long long*)(orow + 128 + 32 * cb + 8 * qd) = pk4(accI[cb][4 * qd], accI[cb][4 * qd + 1], accI[cb][4 * qd + 2], accI[cb][4 * qd + 3]);
            }
    }
    __syncthreads();
}
#undef FFT_MFMA
}
#define XB_TMO      128
#define XB_XCNT(j)  (256  + 64 * (j))
#define XB_XSUB(j)  (1280 + 64 * (j))
#define XB_XGEN(j)  (2304 + 64 * (j))
#define XB_TOP      3328
#define XB_TOPGEN   3392
#define XCD_BAR_WORDS 3456
#define XB_SPIN_CAP (1u << 18)

__device__ __forceinline__ unsigned xb_ld(unsigned* p)              { return __hip_atomic_load(p, __ATOMIC_RELAXED, __HIP_MEMORY_SCOPE_AGENT); }
__device__ __forceinline__ unsigned xb_add(unsigned* p, unsigned v) { return __hip_atomic_fetch_add(p, v, __ATOMIC_RELAXED, __HIP_MEMORY_SCOPE_AGENT); }
__device__ __forceinline__ unsigned xb_xcc_id() { return (unsigned)__builtin_amdgcn_s_getreg((3 << 11) | 20) & 0xFu; }
#define XB_SPIN(cond, bar) do { unsigned _sp = 0; while (cond) { __builtin_amdgcn_s_sleep(1); \
    if ((++_sp & 255u) == 0u) { if (xb_ld(&(bar)[XB_TMO])) break; if (_sp > XB_SPIN_CAP) { atomicAdd(&(bar)[XB_TMO], 1u); break; } } } } while (0)

struct XcdBarrier {
    unsigned* bar; unsigned x;
    volatile LAS unsigned* st;
};

__device__ __forceinline__ XcdBarrier xcd_barrier_post(unsigned* bar, volatile LAS unsigned* st) {
    XcdBarrier b; b.bar = bar; b.x = xb_xcc_id(); b.st = st;
    if (threadIdx.x == 0) (void)xb_add(&bar[XB_XCNT(b.x)], 1u);
    return b;
}
__device__ __forceinline__ void xcd_barrier_complete(unsigned* bar, unsigned x, unsigned& nloc, unsigned& nx) {
    const unsigned G = gridDim.x * gridDim.y * gridDim.z;
    unsigned sum, cnt, mine, sp = 0u;
    for (;;) {
        sum = 0u; cnt = 0u; mine = 0u;
#pragma unroll
        for (unsigned j = 0; j < 16; ++j) { const unsigned c = xb_ld(&bar[XB_XCNT(j)]); sum += c; cnt += (c > 0u) ? 1u : 0u; mine = (j == x) ? c : mine; }
        if (sum == G) break;
        __builtin_amdgcn_s_sleep(1);
        if ((++sp & 255u) == 0u) { if (xb_ld(&bar[XB_TMO])) break; if (sp > XB_SPIN_CAP) { atomicAdd(&bar[XB_TMO], 1u); break; } }
    }
    nloc = mine > 0u ? mine : 1u; nx = cnt > 0u ? cnt : 1u;
}

__device__ __forceinline__ void xcd_barrier(const XcdBarrier& b) {
    asm volatile("s_waitcnt vmcnt(0)" ::: "memory");
    __syncthreads();
    if (threadIdx.x == 0) {
        unsigned* bar = b.bar;
        __builtin_amdgcn_s_waitcnt(0);
        unsigned nloc = b.st[0], nx = b.st[1];
        if (nloc == 0u) { xcd_barrier_complete(bar, b.x, nloc, nx); b.st[0] = nloc; b.st[1] = nx; }
        const unsigned old = xb_add(&bar[XB_XSUB(b.x)], 1u);
        const unsigned gen = old / nloc;
        if (old + 1u == (gen + 1u) * nloc) {
            __builtin_amdgcn_fence(__ATOMIC_RELEASE, "agent");
            asm volatile("s_waitcnt vmcnt(0)" ::: "memory");
            const unsigned og = xb_add(&bar[XB_TOP], 1u);
            const unsigned tg = og / nx;
            if (og + 1u == (tg + 1u) * nx) xb_add(&bar[XB_TOPGEN], 1u);
            else XB_SPIN(xb_ld(&bar[XB_TOPGEN]) == tg, bar);
            __builtin_amdgcn_fence(__ATOMIC_ACQUIRE, "agent");
            xb_add(&bar[XB_XGEN(b.x)], 1u);
            asm volatile("s_waitcnt vmcnt(0)" ::: "memory");
        } else {
            XB_SPIN(xb_ld(&bar[XB_XGEN(b.x)]) == gen, bar);
            __builtin_amdgcn_fence(__ATOMIC_ACQUIRE, "agent");
            asm volatile("s_waitcnt vmcnt(0)" ::: "memory");
        }
    }
    __syncthreads();
}
constexpr int N_PHASES = 15;
struct Args { const float* in[24]; float* out; unsigned char* ws; int ph_lo, ph_hi; };
__global__ void __launch_bounds__(NWAVES * 64, 2) mk_fwd(Args args) {
    extern __shared__ __attribute__((aligned(16))) unsigned char lds[];
    Frame F;
    F.lds = (LAS unsigned char*)lds;
    F.tid = threadIdx.x; F.lane = F.tid & 63; F.wave = __builtin_amdgcn_readfirstlane(F.tid >> 6);
    F.G = gridDim.x; { const int bx = blockIdx.x; F.vcu = (F.G % 8 == 0) ? (bx % 8) * (F.G / 8) + bx / 8 : bx; }
#pragma unroll
    for (int i = 0; i < 24; ++i) F.in[i] = args.in[i];
    F.out = args.out; F.ws = args.ws;
    const int lo = args.ph_lo, hi = args.ph_hi;
    for (int u = F.tid; u < (LDS_BYTES - LDSCTL_OFF) / 4; u += NWAVES * 64) ((LAS unsigned*)(F.lds + LDSCTL_OFF))[u] = 0u;
    __syncthreads();
    XcdBarrier bar = xcd_barrier_post((unsigned*)(F.ws + WS_CTL) + CW_BAR, (volatile LAS unsigned*)(F.lds + MISC_OFF) + 8);
#define IN(k) (lo <= (k) && (k) < hi)
#define BOTH(k) (IN(k) && IN((k) + 1))
#define GRID_BAR() xcd_barrier(bar)
#define GRID_BAR_CG() do { cooperative_groups::this_grid().sync(); } while (0)
    bf16* const HB16 = wsp<bf16>(F, WS_HB16); bf16* const HH = wsp<bf16>(F, WS_R1);
    bf16* const QO = wsp<bf16>(F, WS_QO); bf16* const UU = wsp<bf16>(F, WS_U); bf16* const KR = wsp<bf16>(F, WS_KR); bf16* const VR = wsp<bf16>(F, WS_VR); bf16* const FB = wsp<bf16>(F, WS_F);
    bf16* const GFB = wsp<bf16>(F, WS_GF); bf16* const GAB = wsp<bf16>(F, WS_GA); bf16* const QC = wsp<bf16>(F, WS_QC); bf16* const OC = wsp<bf16>(F, WS_OC);
    float* const SS2 = wsp<float>(F, WS_SS2); float* const SS3 = wsp<float>(F, WS_SS3); float* const SS4 = wsp<float>(F, WS_SS4);

    if (IN(0)) { p0_prologue(F); if (BOTH(0)) GRID_BAR_CG(); }
    if (IN(1)) {
        pg8::Gemm g{HB16, wsp<bf16>(F, WS_W1GU), M, 2 * FF, D}; pg8::StaticOrder S; S.init(M, 2 * FF, F.G, (int)blockIdx.x);
        pg8::EpiSwiGLU E{HH, FF, wsp<float>(F, WS_RS1), 0};
        pg8::gemm_phase<pg8::EpiSwiGLU, pg8::StaticOrder, true, true>(F.lds, g, S, E);
        if (BOTH(1)) GRID_BAR();
    }
    if (IN(2)) {
        pg8::Gemm g{HH, wsp<bf16>(F, WS_W1D), M, D, FF}; pg8::StaticOrder S; S.init(M, D, F.G, (int)blockIdx.x);
        pg8::EpiResid E{F.in[0], F.out, HB16, SS2, 0.5f, D};
        pg8::gemm_phase<pg8::EpiResid, pg8::StaticOrder, true, true>(F.lds, g, S, E);
        if (BOTH(2)) GRID_BAR();
    }
    if (IN(3)) {
        pg8::Gemm g{HB16, wsp<bf16>(F, WS_WIN), M, NIN, D}; pg8::StaticOrder S; S.init(M, NIN, F.G, (int)blockIdx.x);
        pg8::EpiRoute E{{QO, KR, VR, FB, GFB, GAB}, SS2, 1, 1, 0};
        pg8::gemm_phase<pg8::EpiRoute, pg8::StaticOrder, true, true>(F.lds, g, S, E);
        if (BOTH(3)) GRID_BAR();
    }
    if (IN(4)) { p_prep_qk(F);
#if defined(FFT_SIMPLE) || defined(FFTA_SIMPLE)
        p_fftA_simple(F);
#else
        fftm::stageA(F);
#endif
        if (BOTH(4)) GRID_BAR(); }
    if (IN(5)) {
#if defined(FFT_SIMPLE) || defined(FFTB_SIMPLE)
        p_fftB_simple(F);
#else
        fftm::stageB(F);
#endif
        if (BOTH(5)) GRID_BAR(); }
    if (IN(6)) {
#if defined(ATTN_SIMPLE)
        p_attn_simple(F);
#else
        static_assert(attn_body::ATTN_LDS_BYTES <= RING_BYTES, "attention LDS");
        const attn_body::AttnTensors AT{(const attn_body::bf16*)QO, (const attn_body::bf16*)KR, (const attn_body::bf16*)VR, (attn_body::bf16*)QO};
        const attn_body::StaticOrder S((int)F.G, (int)blockIdx.x);
        attn_body::attn_phase<attn_body::StaticOrder>((char*)lds, AT, S);
#endif
        if (BOTH(6)) GRID_BAR();
    }
    if (IN(7)) {
        { pg8::Gemm g{UU, wsp<bf16>(F, WS_WFB), M, D, D}; pg8::StaticOrder S; S.init(M, D, F.G, (int)blockIdx.x);
          pg8::EpiGate E{GFB, nullptr, 1};
          pg8::gemm_phase<pg8::EpiGate, pg8::StaticOrder, true, true>(F.lds, g, S, E); }
        { pg8::Gemm g{QO, wsp<bf16>(F, WS_WAB), M, D, D}; pg8::StaticOrder S; S.init(M, D, F.G, (int)blockIdx.x);
          pg8::EpiGate E{GAB, GFB, 2};
          pg8::gemm_phase<pg8::EpiGate, pg8::StaticOrder, true, true>(F.lds, g, S, E); }
        if (BOTH(7)) GRID_BAR();
    }
    if (IN(8)) {
        pg8::Gemm g{GAB, wsp<bf16>(F, WS_WOUT), M, D, D}; pg8::StaticOrder S; S.init(M, D, F.G, (int)blockIdx.x);
        pg8::EpiResid E{F.out, F.out, HB16, SS3, 1.0f, D};
        pg8::gemm_phase<pg8::EpiResid, pg8::StaticOrder, true, true>(F.lds, g, S, E);
        if (BOTH(8)) GRID_BAR();
    }
    if (IN(9)) {
        pg8::Gemm g{HB16, wsp<bf16>(F, WS_WCQ), M, 256, D}; pg8::StaticOrder S; S.init(M, 256, F.G, (int)blockIdx.x);
        pg8::EpiRoute E{{QC, nullptr, nullptr, nullptr, nullptr, nullptr}, SS3, 1, 0, 256};
        pg8::gemm_phase<pg8::EpiRoute, pg8::StaticOrder, true, true>(F.lds, g, S, E);
        if (BOTH(9)) GRID_BAR();
    }
    if (IN(10)) { p_cross_simple(F); if (BOTH(10)) GRID_BAR(); }
    if (IN(11)) {
        pg8::Gemm g{OC, wsp<bf16>(F, WS_WCO), M, D, 256}; pg8::StaticOrder S; S.init(M, D, F.G, (int)blockIdx.x);
        pg8::EpiResid E{F.out, F.out, HB16, SS4, 1.0f, D};
        pg8::gemm_phase<pg8::EpiResid, pg8::StaticOrder, true, true>(F.lds, g, S, E);
        if (BOTH(11)) GRID_BAR();
    }
    if (IN(12)) {
        pg8::Gemm g{HB16, wsp<bf16>(F, WS_W2GU), M, 2 * FF, D}; pg8::StaticOrder S; S.init(M, 2 * FF, F.G, (int)blockIdx.x);
        pg8::EpiSwiGLU E{HH, FF, SS4, 1};
        pg8::gemm_phase<pg8::EpiSwiGLU, pg8::StaticOrder, true, true>(F.lds, g, S, E);
        if (BOTH(12)) GRID_BAR();
    }
    if (IN(13)) {
        pg8::Gemm g{HH, wsp<bf16>(F, WS_W2D), M, D, FF}; pg8::StaticOrder S; S.init(M, D, F.G, (int)blockIdx.x);
        pg8::EpiResid E{F.out, F.out, nullptr, nullptr, 0.5f, D};
        pg8::gemm_phase<pg8::EpiResid, pg8::StaticOrder, true, true>(F.lds, g, S, E);
        if (BOTH(13)) GRID_BAR();
    }
    if (IN(14)) { p_final(F); }
#undef IN
#undef BOTH
}

extern "C" void kernel_launch(void* const* d_in, const int* in_sizes, int n_in, void* d_out, int out_size, void* d_ws, size_t ws_size, hipStream_t stream) {
    static int grid = 0;
    if (grid == 0) {
        if (n_in != 24 || in_sizes[0] != M * D || out_size != M * D || ws_size < WS_END) {
            fprintf(stderr, "kernel_launch: unexpected shapes: n_in %d in0 %d out %d ws %zu (need %zu)\n", n_in, n_in > 0 ? in_sizes[0] : -1, out_size, ws_size, (size_t)WS_END); grid = -1; return; }
        int dev = 0, cus = 0, per_cu = 0;
        if (hipGetDevice(&dev) != hipSuccess || hipDeviceGetAttribute(&cus, hipDeviceAttributeMultiprocessorCount, dev) != hipSuccess) { grid = -1; return; }
        if (hipFuncSetAttribute((const void*)mk_fwd, hipFuncAttributeMaxDynamicSharedMemorySize, LDS_BYTES) != hipSuccess) { fprintf(stderr, "kernel_launch: hipFuncSetAttribute failed\n"); grid = -1; return; }
        if (hipOccupancyMaxActiveBlocksPerMultiprocessor(&per_cu, (const void*)mk_fwd, NWAVES * 64, LDS_BYTES) != hipSuccess || per_cu < 1) { fprintf(stderr, "kernel_launch: occupancy query says %d\n", per_cu); }
        (void)hipGetLastError();
        grid = cus * (per_cu < 1 ? 1 : 1);
        if (per_cu < 1) { grid = -1; return; }
        if (grid != 256) fprintf(stderr, "kernel_launch: %d CUs (built for 256)\n", grid);
    }
    if (grid < 0) return;
    (void)hipMemsetAsync((char*)d_ws + WS_CTL, 0, CTL_ZERO_BYTES, stream);
    Args a{};
    for (int i = 0; i < 24; ++i) a.in[i] = (const float*)d_in[i];
    a.out = (float*)d_out; a.ws = (unsigned char*)d_ws;
#if defined(MK_MULTI)
    for (int ph = 0; ph < N_PHASES; ++ph) {
        a.ph_lo = ph; a.ph_hi = ph + 1;
        hipLaunchKernelGGL(mk_fwd, dim3(grid), dim3(NWAVES * 64), LDS_BYTES, stream, a);
    }
#else
    a.ph_lo = 0; a.ph_hi = N_PHASES;
    void* kargs[] = {&a};
    const hipError_t e = hipLaunchCooperativeKernel((const void*)mk_fwd, dim3(grid), dim3(NWAVES * 64), kargs, LDS_BYTES, stream);
    if (e != hipSuccess) fprintf(stderr, "kernel_launch: cooperative launch failed: %s (grid %d)\n", hipGetErrorString(e), grid);
#endif
}
```

```cpp
#include <hip/hip_runtime.h>
#include <hip/hip_cooperative_groups.h>
#include <cstdio>
#include <cstdint>
namespace pg8 {
#define PG8_LAS __attribute__((address_space(3)))
typedef unsigned short bf16_t;
typedef short bf16x8 __attribute__((ext_vector_type(8)));
typedef float f32x4 __attribute__((ext_vector_type(4)));
typedef unsigned u32x4 __attribute__((ext_vector_type(4)));
constexpr int BM = 256, BK = 64, HALF = 128, HTB = HALF * BK * 2  , STAGE_BYTES = 8 * HTB, NXCD = 8, WGM = 8;

__host__ __device__ __forceinline__ int lds_byte(int r, int c) { const int st = (r >> 4) * 2 + (c >> 5), rr = r & 15, cc = c & 31, ob = rr * 64 + cc * 2; return st * 1024 + (ob ^ (((ob >> 9) & 1) << 5)); }
__host__ __device__ __forceinline__ void stage_rc(int b, int& R, int& C) { const int st = b / 1024, sb = b % 1024, swz = sb ^ (((sb >> 9) & 1) << 5); R = (st >> 1) * 16 + swz / 64; C = (st & 1) * 32 + (swz % 64) / 2; }
__host__ __device__ __forceinline__ int perm32(int rho) { const int n = rho >> 4, i = rho & 15; return 8 * (i >> 2) + 4 * n + (i & 3); }

struct Unit { int pm, pn; };
struct Gemm { const bf16_t* A; const bf16_t* Bt; int M, N, K; };

struct StaticOrder {
    int nM, nN, nwg, G, c;
    __host__ __device__ void init(int M, int N, int G_, int c_) { nM = M / BM; nN = N / BM; nwg = nM * nN; G = G_; c = c_; }
    __host__ __device__ bool next(int i, Unit& u) const {
        const long L = (long)i * G + c; if (L >= nwg) return false;
        int wgid = (int)L; { const int q = nwg / NXCD, r = nwg % NXCD, xcd = wgid % NXCD, off = wgid / NXCD; wgid = (xcd < r ? xcd * (q + 1) : r * (q + 1) + (xcd - r) * q) + off; }
        const int nig = WGM * nN, gid = wgid / nig, fm = gid * WGM, gsz = (nM - fm) < WGM ? (nM - fm) : WGM;
        u.pm = fm + ((wgid % nig) % gsz); u.pn = (wgid % nig) / gsz; return true;
    }
    __device__ __forceinline__ void a_ready(const Unit&) const {}
    __device__ __forceinline__ void done(const Unit&) const {}
};

typedef float f32x2_cv __attribute__((ext_vector_type(2))); typedef __bf16 bf16x2_cv __attribute__((ext_vector_type(2)));
__device__ __forceinline__ unsigned cvt_pk_bf16(float lo, float hi) { f32x2_cv v = {lo, hi}; bf16x2_cv b = __builtin_convertvector(v, bf16x2_cv); return __builtin_bit_cast(unsigned, b); }
__device__ __forceinline__ float bflo(unsigned u) { return __uint_as_float(u << 16); }
__device__ __forceinline__ float bfhi(unsigned u) { return __uint_as_float(u & 0xffff0000u); }
__device__ __forceinline__ float sigmoid_f(float x) { return __builtin_amdgcn_rcpf(1.0f + __builtin_amdgcn_exp2f(-1.4426950408889634f * x)); }
__device__ __forceinline__ u32x4 pack8(const f32x4 a, const f32x4 b) { u32x4 w; w.x = cvt_pk_bf16(a[0], a[1]); w.y = cvt_pk_bf16(a[2], a[3]); w.z = cvt_pk_bf16(b[0], b[1]); w.w = cvt_pk_bf16(b[2], b[3]); return w; }
constexpr float RMS_EPS = 1e-6f;
__device__ __forceinline__ float rowscale(const float* p, int row, int mode) { const float v = p[row]; return mode ? __builtin_amdgcn_rsqf(v * (1.0f / 1024.0f) + RMS_EPS) : v; }

struct EpiSwiGLU {
    static constexpr bool PERM = true, AFTER_DRAIN = false;
    bf16_t* H; int ldh; const float* rs; int rs_mode;
    __device__ __forceinline__ void operator()(const f32x4 (&acc)[2][2][4][2], const Unit& u, int wr, int wc, int fr, int fq) const {
        const int row0 = u.pm * BM + wr * 64 + fr, col0 = u.pn * HALF + wc * 32 + 8 * fq;
#pragma unroll
        for (int ai = 0; ai < 2; ++ai)
#pragma unroll
            for (int m = 0; m < 4; ++m) {
                const int row = row0 + ai * HALF + m * 16; const float r = rowscale(rs, row, rs_mode);
                f32x4 o[2];
#pragma unroll
                for (int n = 0; n < 2; ++n) {
                    const f32x4 g = acc[ai][0][m][n] * r, up = acc[ai][1][m][n] * r;
#pragma unroll
                    for (int j = 0; j < 4; ++j) o[n][j] = g[j] * sigmoid_f(g[j]) * up[j];
                }
                *(u32x4*)(H + (size_t)row * ldh + col0) = pack8(o[0], o[1]);
            }
    }
};
struct EpiResid {
    static constexpr bool PERM = true, AFTER_DRAIN = false;
    const float* base; float* out; bf16_t* ob; float* ss; float scale; int ldc;
    __device__ __forceinline__ void operator()(const f32x4 (&acc)[2][2][4][2], const Unit& u, int wr, int wc, int fr, int fq) const {
        const int row0 = u.pm * BM + wr * 64 + fr, col0 = u.pn * BM + wc * 32 + 8 * fq;
#pragma unroll
        for (int ai = 0; ai < 2; ++ai)
#pragma unroll
            for (int m = 0; m < 4; ++m) {
                const int row = row0 + ai * HALF + m * 16; float s = 0.f;
#pragma unroll
                for (int bj = 0; bj < 2; ++bj) {
                    const size_t off = (size_t)row * ldc + col0 + bj * HALF;
                    const f32x4 b0 = *(const f32x4*)(base + off), b1 = *(const f32x4*)(base + off + 4);
                    const f32x4 o0 = b0 + acc[ai][bj][m][0] * scale, o1 = b1 + acc[ai][bj][m][1] * scale;
                    *(f32x4*)(out + off) = o0; *(f32x4*)(out + off + 4) = o1;
                    if (ob) *(u32x4*)(ob + off) = pack8(o0, o1);
                    s += (o0[0] * o0[0] + o0[1] * o0[1]) + (o0[2] * o0[2] + o0[3] * o0[3]) + (o1[0] * o1[0] + o1[1] * o1[1]) + (o1[2] * o1[2] + o1[3] * o1[3]);
                }
                if (ss) { s += __shfl_xor(s, 16); s += __shfl_xor(s, 32); if (fq == 0) atomicAdd(ss + row, s); }
            }
    }
};
struct EpiRoute {
    static constexpr bool PERM = true, AFTER_DRAIN = false;
    bf16_t* dst[6]; const float* rs; int rs_mode; int is_win;
    int ld0; float post;
    __device__ __forceinline__ void operator()(const f32x4 (&acc)[2][2][4][2], const Unit& u, int wr, int wc, int fr, int fq) const {
        const int pn = u.pn; bf16_t* bp; int ldc, colt;
        if (!is_win) { bp = dst[0]; ldc = ld0; colt = pn * BM; }
        else if (pn < 4) { bp = dst[0]; ldc = 1024; colt = pn * BM; }
        else if (pn == 4) { bp = dst[1]; ldc = 256; colt = 0; }
        else if (pn == 5) { bp = dst[2]; ldc = 256; colt = 0; }
        else if (pn < 8) { bp = dst[3]; ldc = 512; colt = (pn - 6) * BM; }
        else if (pn < 12) { bp = dst[4]; ldc = 1024; colt = (pn - 8) * BM; }
        else { bp = dst[5]; ldc = 1024; colt = (pn - 12) * BM; }
        const int row0 = u.pm * BM + wr * 64 + fr, col0 = colt + wc * 32 + 8 * fq;
#pragma unroll
        for (int ai = 0; ai < 2; ++ai)
#pragma unroll
            for (int m = 0; m < 4; ++m) {
                const int row = row0 + ai * HALF + m * 16; const float r = rowscale(rs, row, rs_mode) * post;
#pragma unroll
                for (int bj = 0; bj < 2; ++bj)
                    *(u32x4*)(bp + (size_t)row * ldc + col0 + bj * HALF) = pack8(acc[ai][bj][m][0] * r, acc[ai][bj][m][1] * r);
            }
    }
};
struct EpiGate {
    static constexpr bool PERM = true, AFTER_DRAIN = false;
    bf16_t* G; const bf16_t* T; int mode;
    __device__ __forceinline__ void operator()(const f32x4 (&acc)[2][2][4][2], const Unit& u, int wr, int wc, int fr, int fq) const {
        const int row0 = u.pm * BM + wr * 64 + fr, col0 = u.pn * BM + wc * 32 + 8 * fq;
#pragma unroll
        for (int ai = 0; ai < 2; ++ai)
#pragma unroll
            for (int m = 0; m < 4; ++m) {
                const int row = row0 + ai * HALF + m * 16;
#pragma unroll
                for (int bj = 0; bj < 2; ++bj) {
                    const size_t off = (size_t)row * 1024 + col0 + bj * HALF;
                    const u32x4 gv = *(const u32x4*)(G + off);
                    f32x4 g0 = {bflo(gv.x), bfhi(gv.x), bflo(gv.y), bfhi(gv.y)}, g1 = {bflo(gv.z), bfhi(gv.z), bflo(gv.w), bfhi(gv.w)};
                    f32x4 o0, o1;
#pragma unroll
                    for (int j = 0; j < 4; ++j) { o0[j] = sigmoid_f(g0[j]) * acc[ai][bj][m][0][j]; o1[j] = sigmoid_f(g1[j]) * acc[ai][bj][m][1][j]; }
                    if (mode == 2) { const u32x4 tv = *(const u32x4*)(T + off);
                        o0 += (f32x4){bflo(tv.x), bfhi(tv.x), bflo(tv.y), bfhi(tv.y)}; o1 += (f32x4){bflo(tv.z), bfhi(tv.z), bflo(tv.w), bfhi(tv.w)}; }
                    *(u32x4*)(G + off) = pack8(o0, o1);
                }
            }
    }
};
template <class Epi, class Sched, bool ALIGN_EPI = false, bool SP2 = false>
__device__ __forceinline__ void gemm_phase(PG8_LAS unsigned char* lds, const Gemm g, const Sched& S, const Epi& E) {
    const int tid = threadIdx.x, wid = __builtin_amdgcn_readfirstlane(tid >> 6), lane = tid & 63, wr = wid >> 2, wc = wid & 3, fr = lane & 15, fq = lane >> 4;
    const int K = g.K, nt = K / BK;
    unsigned voffA[2], voffB[2];
#pragma unroll
    for (int i = 0; i < 2; ++i) { int R, C; stage_rc(tid * 16 + i * 8192, R, C); const int Rb = Epi::PERM ? ((R & ~31) + perm32(R & 31)) : R;
        voffA[i] = (unsigned)(R * K + C) * 2u; voffB[i] = (unsigned)(Rb * K + C) * 2u; }
    const size_t kstep = (size_t)(BK * 2);
    const size_t hstep = (size_t)HALF * K * 2;
    const size_t tstep = 2 * hstep;
    const unsigned ldsw = (unsigned)wid * 1024u;
    const int aoff = lds_byte(wr * 64 + fr, fq * 8), boff = lds_byte(wc * 32 + fr, fq * 8);
#define PG8_SA(b, h) (((b) * 2 + (h)) * HTB)
#define PG8_SB(b, h) ((4 + (b) * 2 + (h)) * HTB)
#define PG8_STAGE(bufoff, gbase, voff) do { _Pragma("unroll") for (int _i = 0; _i < 2; ++_i) \
        __builtin_amdgcn_global_load_lds((const unsigned*)((const char*)(gbase) + (voff)[_i]), (PG8_LAS unsigned*)(lds + (bufoff) + ldsw + _i * 8192), 16, 0, 0); } while (0)
#define PG8_LDA(dst, b, h) do { _Pragma("unroll") for (int m = 0; m < 4; ++m) _Pragma("unroll") for (int k = 0; k < 2; ++k) dst[m][k] = *(const PG8_LAS bf16x8*)(lds + PG8_SA(b, h) + aoff + m * 2048 + k * 1024); } while (0)
#define PG8_LDB(dst, b, h) do { _Pragma("unroll") for (int n = 0; n < 2; ++n) _Pragma("unroll") for (int k = 0; k < 2; ++k) dst[n][k] = *(const PG8_LAS bf16x8*)(lds + PG8_SB(b, h) + boff + n * 2048 + k * 1024); } while (0)
#define PG8_MMA(ai, bj, At, Bt) do { __builtin_amdgcn_s_setprio(1); _Pragma("unroll") for (int m = 0; m < 4; ++m) _Pragma("unroll") for (int n = 0; n < 2; ++n) _Pragma("unroll") for (int k = 0; k < 2; ++k) \
        acc[ai][bj][m][n] = __builtin_amdgcn_mfma_f32_16x16x32_bf16(Bt[n][k], At[m][k], acc[ai][bj][m][n], 0, 0, 0); __builtin_amdgcn_s_setprio(0); } while (0)
#define PG8_WAIT_V(n) asm volatile("s_waitcnt vmcnt(" #n ")" ::: "memory")
#define PG8_WAIT_L(n) asm volatile("s_waitcnt lgkmcnt(" #n ")" ::: "memory")
#define PG8_BAR __builtin_amdgcn_s_barrier()
#define PG8_SCHED __builtin_amdgcn_sched_barrier(0)
    Unit cur, nxt; int ui = 0;
    if (!S.next(0, cur)) return;
    f32x4 acc[2][2][4][2];
#pragma unroll
    for (int a = 0; a < 2; ++a)
#pragma unroll
        for (int b = 0; b < 2; ++b)
#pragma unroll
            for (int m = 0; m < 4; ++m)
#pragma unroll
                for (int n = 0; n < 2; ++n) acc[a][b][m][n] = (f32x4){0.f, 0.f, 0.f, 0.f};
    bf16x8 At[4][2], B0[2][2], B1[2][2];
    const char* cA = (const char*)g.A + (size_t)cur.pm * tstep; const char* cB = (const char*)g.Bt + (size_t)cur.pn * tstep;
    S.a_ready(cur);
    if constexpr (SP2) {
        PG8_STAGE(PG8_SB(0, 0), cB, voffB); PG8_STAGE(PG8_SB(0, 1), cB + hstep, voffB); PG8_STAGE(PG8_SA(0, 0), cA, voffA); PG8_STAGE(PG8_SA(0, 1), cA + hstep, voffA);
        if (wr == 1) PG8_BAR;
        PG8_WAIT_V(2); PG8_BAR;
        PG8_STAGE(PG8_SB(1, 0), cB + kstep, voffB); PG8_STAGE(PG8_SA(1, 0), cA + kstep, voffA); PG8_STAGE(PG8_SB(1, 1), cB + hstep + kstep, voffB);
        PG8_WAIT_V(6); PG8_BAR;
    } else {
        PG8_STAGE(PG8_SB(0, 0), cB, voffB); PG8_STAGE(PG8_SA(0, 0), cA, voffA); PG8_STAGE(PG8_SB(0, 1), cB + hstep, voffB); PG8_STAGE(PG8_SA(0, 1), cA + hstep, voffA);
        if (wr == 1) PG8_BAR;
        PG8_WAIT_V(4); PG8_BAR;
        PG8_STAGE(PG8_SB(1, 0), cB + kstep, voffB); PG8_STAGE(PG8_SA(1, 0), cA + kstep, voffA); PG8_STAGE(PG8_SB(1, 1), cB + hstep + kstep, voffB);
        PG8_WAIT_V(6); PG8_BAR;
    }
    for (;;) {
        const bool has_next = S.next(ui + 1, nxt);
        const char* nA = has_next ? (const char*)g.A + (size_t)nxt.pm * tstep : cA; const char* nB = has_next ? (const char*)g.Bt + (size_t)nxt.pn * tstep : cB;
        for (int t = 0; t < nt; t += 2) {
            const bool last = (t == nt - 2);
            const char* a1 = cA + (size_t)(t + 1) * kstep;
            const char* a2 = last ? nA : cA + (size_t)(t + 2) * kstep; const char* b2 = last ? nB : cB + (size_t)(t + 2) * kstep;
            const char* a3 = a2 + kstep; const char* b3 = b2 + kstep;
            if (last && has_next) S.a_ready(nxt);
            if constexpr (SP2) {
            PG8_LDB(B0, 0, 0); PG8_LDB(B1, 0, 1); PG8_SCHED; PG8_LDA(At, 0, 0); PG8_STAGE(PG8_SA(1, 1), a1 + hstep, voffA);
            PG8_WAIT_V(8); PG8_WAIT_L(0); PG8_BAR; PG8_MMA(0, 0, At, B0); PG8_MMA(0, 1, At, B1); PG8_BAR; PG8_SCHED;
            PG8_LDA(At, 0, 1); PG8_STAGE(PG8_SB(0, 0), b2, voffB); PG8_STAGE(PG8_SB(0, 1), b2 + hstep, voffB); PG8_STAGE(PG8_SA(0, 0), a2, voffA);
            PG8_WAIT_V(8); PG8_WAIT_L(0); PG8_BAR; PG8_MMA(1, 0, At, B0); PG8_MMA(1, 1, At, B1); PG8_BAR; PG8_SCHED;
            PG8_LDB(B0, 1, 0); PG8_LDB(B1, 1, 1); PG8_SCHED; PG8_LDA(At, 1, 0); PG8_STAGE(PG8_SA(0, 1), a2 + hstep, voffA);
            PG8_WAIT_V(8); PG8_WAIT_L(0); PG8_BAR; PG8_MMA(0, 0, At, B0); PG8_MMA(0, 1, At, B1); PG8_BAR; PG8_SCHED;
            PG8_LDA(At, 1, 1); PG8_STAGE(PG8_SB(1, 0), b3, voffB); PG8_STAGE(PG8_SB(1, 1), b3 + hstep, voffB); PG8_STAGE(PG8_SA(1, 0), a3, voffA);
            PG8_WAIT_V(8); PG8_WAIT_L(0); PG8_BAR; PG8_MMA(1, 0, At, B0); PG8_MMA(1, 1, At, B1); PG8_BAR; PG8_SCHED;
            } else {
            PG8_LDB(B0, 0, 0); PG8_SCHED; PG8_LDA(At, 0, 0); PG8_STAGE(PG8_SA(1, 1), a1 + hstep, voffA);
            PG8_WAIT_L(8); PG8_BAR; PG8_WAIT_L(0); PG8_MMA(0, 0, At, B0); PG8_BAR; PG8_SCHED;
            PG8_LDB(B1, 0, 1); PG8_STAGE(PG8_SB(0, 0), b2, voffB);
            PG8_BAR; PG8_WAIT_L(0); PG8_MMA(0, 1, At, B1); PG8_BAR;
            PG8_LDA(At, 0, 1); PG8_STAGE(PG8_SA(0, 0), a2, voffA);
            PG8_BAR; PG8_WAIT_L(0); PG8_MMA(1, 0, At, B0); PG8_BAR; PG8_SCHED;
            PG8_STAGE(PG8_SB(0, 1), b2 + hstep, voffB);
            PG8_WAIT_V(6); PG8_BAR; PG8_MMA(1, 1, At, B1); PG8_BAR;
            PG8_LDB(B0, 1, 0); PG8_SCHED; PG8_LDA(At, 1, 0); PG8_STAGE(PG8_SA(0, 1), a2 + hstep, voffA);
            PG8_WAIT_L(8); PG8_BAR; PG8_WAIT_L(0); PG8_MMA(0, 0, At, B0); PG8_BAR; PG8_SCHED;
            PG8_LDB(B1, 1, 1); PG8_STAGE(PG8_SB(1, 0), b3, voffB);
            PG8_BAR; PG8_WAIT_L(0); PG8_MMA(0, 1, At, B1); PG8_BAR;
            PG8_LDA(At, 1, 1); PG8_STAGE(PG8_SA(1, 0), a3, voffA);
            PG8_BAR; PG8_WAIT_L(0); PG8_MMA(1, 0, At, B0); PG8_BAR; PG8_SCHED;
            PG8_STAGE(PG8_SB(1, 1), b3 + hstep, voffB);
            PG8_WAIT_V(6); PG8_BAR; PG8_MMA(1, 1, At, B1); PG8_BAR;
            }
        }
        if constexpr (ALIGN_EPI) { if (wr == 0) PG8_BAR; }
        if constexpr (!Epi::AFTER_DRAIN) { E(acc, cur, wr, wc, fr, fq); S.done(cur); }
        if (!has_next) break;
#pragma unroll
        for (int a = 0; a < 2; ++a)
#pragma unroll
            for (int b = 0; b < 2; ++b)
#pragma unroll
                for (int m = 0; m < 4; ++m)
#pragma unroll
                    for (int n = 0; n < 2; ++n) acc[a][b][m][n] = (f32x4){0.f, 0.f, 0.f, 0.f};
        cur = nxt; cA = nA; cB = nB; ++ui;
        if constexpr (ALIGN_EPI) { if (wr == 1) PG8_BAR; }
    }
    PG8_WAIT_V(0);
    if constexpr (!ALIGN_EPI) { if (wr == 0) PG8_BAR; }
    PG8_BAR;
    if constexpr (Epi::AFTER_DRAIN) { E.fused(acc, cur, wr, wc, fr, fq, lds, wid, lane); S.done(cur); }
#undef PG8_SA
#undef PG8_SB
#undef PG8_STAGE
#undef PG8_LDA
#undef PG8_LDB
#undef PG8_MMA
#undef PG8_WAIT_V
#undef PG8_WAIT_L
#undef PG8_BAR
#undef PG8_SCHED
}
}
#include <hip/hip_bf16.h>
#include <cmath>
namespace attn_body {
using bf16=__hip_bfloat16;
using bf16x8=__attribute__((ext_vector_type(8)))short;
using s16x4=__attribute__((ext_vector_type(4)))short;
using f32x16=__attribute__((ext_vector_type(16)))float;
using u32x4=__attribute__((ext_vector_type(4)))unsigned;
constexpr int BATCH=1,NHEAD=16,SEQ=16384,D=64,DM=NHEAD*D,KVP=256,GQA=4;
constexpr int NW=8,QBLK=32,QB=QBLK*NW,KVBLK=64,NQB=SEQ/QB;
constexpr int ATTN_PITCH=DM, ATTN_UNIT_ROWS=QB;
__device__ __forceinline__ int crow(int r,int hi){return (r&3)+8*(r>>2)+4*hi;}
#define SBAR() __builtin_amdgcn_sched_barrier(0)
__device__ __forceinline__ void cmask(f32x16&p0,f32x16&p1,int jb,int qrel,int hi){
  const float NEG=-INFINITY; int kb=64*jb+4*hi;
  #pragma unroll
  for(int r=0;r<16;++r){int kv=kb+(r&3)+8*(r>>2); if(kv>qrel)p0[r]=NEG; if(kv+32>qrel)p1[r]=NEG;}
}

constexpr int NSLOT=3, SLOTB=8192;
constexpr int LDS_K=0, LDS_V=NSLOT*SLOTB, LDS_WS=2*NSLOT*SLOTB, LDS_OST=LDS_WS+NW*64*4, LDS_BYTES=LDS_OST+NW*4096;
constexpr float C2=0.125f*1.4426950408889634f;
__device__ __forceinline__ void glds16(const void*gsrc,unsigned lds_dst){unsigned keep;
  asm volatile("s_mov_b32 %0, m0\n\ts_mov_b32 m0, %2\n\ts_nop 0\n\tglobal_load_lds_dwordx4 %1, off\n\ts_mov_b32 m0, %0":"=&s"(keep):"v"(gsrc),"s"(lds_dst):"memory");}
__device__ __forceinline__ float max3f(float a,float b,float c){float r;asm("v_max3_f32 %0, %1, %2, %3":"=v"(r):"v"(a),"v"(b),"v"(c));return r;}
__device__ __forceinline__ float max2f(float a,float b){float r;asm("v_max_f32_e32 %0, %1, %2":"=v"(r):"v"(a),"v"(b));return r;}
__device__ __forceinline__ float fadd_s(float a,float b){float r;asm("v_add_f32_e32 %0, %1, %2":"=v"(r):"v"(a),"v"(b));return r;}
__device__ __forceinline__ float fsub_s(float a,float b){float r;asm("v_sub_f32_e32 %0, %1, %2":"=v"(r):"v"(a),"v"(b));return r;}
typedef float f32x2_t __attribute__((ext_vector_type(2))); typedef __bf16 bf16x2_t __attribute__((ext_vector_type(2)));
__device__ __forceinline__ unsigned cvtpk_s(float lo,float hi){f32x2_t v={lo,hi};bf16x2_t b=__builtin_convertvector(v,bf16x2_t);return __builtin_bit_cast(unsigned,b);}
#define WAIT_BAR(N) asm volatile("s_waitcnt vmcnt(" #N ") lgkmcnt(0)\n\ts_barrier":::"memory")

__device__ __forceinline__ void qkt(f32x16&p0,f32x16&p1,const char*Kslot,const bf16x8*qr,const f32x16&negm,int r32,int hi){
  const char*kb=Kslot+hi*1024+r32*16;
  #pragma unroll
  for(int d0=0;d0<4;++d0){
    const bf16x8 b0=*reinterpret_cast<const bf16x8*>(kb+d0*2048);
    const bf16x8 b1=*reinterpret_cast<const bf16x8*>(kb+d0*2048+512);
    if(d0==0){p0=__builtin_amdgcn_mfma_f32_32x32x16_bf16(b0,qr[0],negm,0,0,0);p1=__builtin_amdgcn_mfma_f32_32x32x16_bf16(b1,qr[0],negm,0,0,0);}
    else{p0=__builtin_amdgcn_mfma_f32_32x32x16_bf16(b0,qr[d0],p0,0,0,0);p1=__builtin_amdgcn_mfma_f32_32x32x16_bf16(b1,qr[d0],p1,0,0,0);}}
}
typedef __attribute__((address_space(3))) const char* lds_cptr;
typedef short v4i16_t __attribute__((ext_vector_type(4)));
__device__ __forceinline__ void kload8(bf16x8*kf,lds_cptr kp){
  kf[0]=*(const __attribute__((address_space(3))) bf16x8*)(kp);      kf[1]=*(const __attribute__((address_space(3))) bf16x8*)(kp+512);
  kf[2]=*(const __attribute__((address_space(3))) bf16x8*)(kp+2048); kf[3]=*(const __attribute__((address_space(3))) bf16x8*)(kp+2560);
  kf[4]=*(const __attribute__((address_space(3))) bf16x8*)(kp+4096); kf[5]=*(const __attribute__((address_space(3))) bf16x8*)(kp+4608);
  kf[6]=*(const __attribute__((address_space(3))) bf16x8*)(kp+6144); kf[7]=*(const __attribute__((address_space(3))) bf16x8*)(kp+6656);
}
__device__ __forceinline__ void kload2(bf16x8*kf,lds_cptr kp,int j){ kf[2*j]=*(const __attribute__((address_space(3))) bf16x8*)(kp+j*2048); kf[2*j+1]=*(const __attribute__((address_space(3))) bf16x8*)(kp+j*2048+512); }
__device__ __forceinline__ s16x4 vtr(lds_cptr p){ return __builtin_bit_cast(s16x4,__builtin_amdgcn_ds_read_tr16_b64_v4i16((__attribute__((address_space(3))) v4i16_t*)p)); }
__device__ __forceinline__ float rowmax(const f32x16&p0,const f32x16&p1){
  float a=max3f(p0[0],p0[1],p1[0]),b=max3f(p0[2],p0[3],p1[1]);a=max3f(a,p1[2],p1[3]);
  #pragma unroll
  for(int r=4;r<16;r+=4){a=max3f(a,p0[r],p0[r+1]);b=max3f(b,p0[r+2],p0[r+3]);a=max3f(a,p1[r],p1[r+1]);b=max3f(b,p1[r+2],p1[r+3]);}
  const float m=max2f(a,b);
  auto rr=__builtin_amdgcn_permlane32_swap(__float_as_uint(m),__float_as_uint(m),false,false);
  return max2f(__uint_as_float(rr[0]),__uint_as_float(rr[1]));
}
__device__ __forceinline__ void pv(f32x16*o,int vb,bf16x8 pa0,bf16x8 pa1,bf16x8 pa2,bf16x8 pa3){
  #pragma unroll
  for(int d0=0;d0<2;++d0){s16x4 lo[4],hi[4];
    #pragma unroll
    for(int ks=0;ks<4;++ks){
      asm volatile("ds_read_b64_tr_b16 %0,%1 offset:%c2":"=&v"(lo[ks]):"v"(vb),"i"(d0*4096+ks*1024):"memory");
      asm volatile("ds_read_b64_tr_b16 %0,%1 offset:%c2":"=&v"(hi[ks]):"v"(vb),"i"(d0*4096+ks*1024+512):"memory");}
    asm volatile("s_waitcnt lgkmcnt(0)":::"memory");SBAR();
    #define PK(k) (bf16x8){lo[k][0],lo[k][1],lo[k][2],lo[k][3],hi[k][0],hi[k][1],hi[k][2],hi[k][3]}
    o[d0]=__builtin_amdgcn_mfma_f32_32x32x16_bf16(pa0,PK(0),o[d0],0,0,0);
    o[d0]=__builtin_amdgcn_mfma_f32_32x32x16_bf16(pa1,PK(1),o[d0],0,0,0);
    o[d0]=__builtin_amdgcn_mfma_f32_32x32x16_bf16(pa2,PK(2),o[d0],0,0,0);
    o[d0]=__builtin_amdgcn_mfma_f32_32x32x16_bf16(pa3,PK(3),o[d0],0,0,0);
    #undef PK
  }
}

#ifndef ATTN_STORE16
#define ATTN_STORE16(p,v) (*(u32x4*)(p)=(v))
#endif
template<int THRL,int QP_,int KVP_,int SKV_,int GQ_> __device__ __forceinline__ void attn_unit(int b,int h,int qb,const bf16*Q,const bf16*__restrict__ K,const bf16*__restrict__ V,bf16*O,char*shm){
  const int tid=threadIdx.x,lane=tid&63,r32=lane&31,hi=lane>>5; const int wid=__builtin_amdgcn_readfirstlane(tid>>6);
  const long rowbase=0; (void)b; const int q0=qb*QB;
  const bf16*Qw=Q+(rowbase+q0+wid*QBLK)*QP_+h*D;
  const bf16*Kh=K+rowbase*KVP_+(h/GQ_)*D,*Vh=V+rowbase*KVP_+(h/GQ_)*D;
  const unsigned lds0=(unsigned)(uintptr_t)shm;
  float*wsf=(float*)(shm+LDS_WS)+wid*64;
  const bf16*ksrc=Kh+(long)lane*KVP_+wid*8;
  const bf16*vsrc=Vh+(long)(16*(wid&3)+(lane>>2))*KVP_+(wid>>2)*32+(lane&3)*8;
  const unsigned kdst=lds0+LDS_K+wid*1024, vdst=lds0+LDS_V+wid*1024;
  #define DMA_K(t,slot) glds16(ksrc+(long)(t)*KVBLK*KVP_,(unsigned)__builtin_amdgcn_readfirstlane(kdst+(slot)))
  #define DMA_V(t,slot) glds16(vsrc+(long)(t)*KVBLK*KVP_,(unsigned)__builtin_amdgcn_readfirstlane(vdst+(slot)))
  const int vb0=(int)(lds0+LDS_V)+((lane>>4)&1)*32+(lane&3)*8+(4*hi+((lane&15)>>2))*64;
  const char*Kbase=shm+LDS_K; bf16x8 kf[8];
  const lds_cptr shm3=(lds_cptr)shm; const lds_cptr kp0=shm3+LDS_K+hi*1024+r32*16; const lds_cptr vp0=shm3+LDS_V+((lane>>4)&1)*32+(lane&3)*8+(4*hi+((lane&15)>>2))*64;
  const int NT=SKV_/KVBLK;
  DMA_K(0,0);DMA_V(0,0);DMA_K(1,SLOTB);
  bf16x8 qr[4];
  #pragma unroll
  for(int d0=0;d0<4;++d0)qr[d0]=*reinterpret_cast<const bf16x8*>(&Qw[(long)r32*QP_+d0*16+hi*8]);
  float mhat=0.f,l_reg=0.f;f32x16 o[2];o[0]=f32x16{};o[1]=f32x16{};f32x16 negm=f32x16{};asm volatile("":"+v"(negm));
  const int qrel=wid*QBLK+r32;
  #define CMASK(P0,P1,t) do{}while(0)
  bool resc=false;
  #define START(P0,P1) do{ const float rm=rowmax(P0,P1); resc=false; \
    { const float dl=rm; mhat=fadd_s(mhat,dl); \
      _Pragma("unroll") for(int r=0;r<16;++r){P0[r]=fsub_s(P0[r],dl);P1[r]=fsub_s(P1[r],dl);} \
      _Pragma("unroll") for(int r=0;r<16;++r)negm[r]=-mhat; asm volatile("":"+v"(negm)); } \
    _Pragma("unroll") for(int r=0;r<16;++r)P0[r]=__builtin_amdgcn_exp2f(P0[r]); }while(0)
  #define RESC() do{ if(resc){ asm volatile("s_waitcnt lgkmcnt(0)":::"memory"); \
      _Pragma("unroll") for(int d_=0;d_<2;++d_) _Pragma("unroll") for(int r=0;r<16;++r)o[d_][r]*=wsf[crow(r,hi)]; } }while(0)
  f32x16 pA0,pA1,pB0,pB1;
  int sl_prev=0,sl_cur=0,sl_next=SLOTB;
  #define ROT() do{sl_prev=sl_cur;sl_cur=sl_next;sl_next=(sl_next==(NSLOT-1)*SLOTB)?0:sl_next+SLOTB;}while(0)
  DMA_K(2,2*SLOTB);
  WAIT_BAR(3);
  qkt(pA0,pA1,Kbase,qr,negm,r32,hi);asm volatile("s_nop 15\n\ts_nop 7":"+v"(pA0),"+v"(pA1));CMASK(pA0,pA1,0);
  START(pA0,pA1);
  _Pragma("unroll") for(int r=0;r<16;++r)pA1[r]=__builtin_amdgcn_exp2f(pA1[r]);
  WAIT_BAR(0);
  DMA_K(3,0);DMA_V(1,SLOTB);
  ROT();
  kload8(kf,kp0+sl_cur);
  WAIT_BAR(2);
  s16x4 vlo[8],vhi[8]; u32x4 pw0,pw1,pw2,pw3;
  #define PKW(P,B) cvtpk_s(P[B],P[B+1])
  #define PAF(k) __builtin_bit_cast(bf16x8,pw##k)
  #define VFR(i) (bf16x8){vlo[i][0],vlo[i][1],vlo[i][2],vlo[i][3],vhi[i][0],vhi[i][1],vhi[i][2],vhi[i][3]}
  #define PIN(x) asm volatile("":"+v"(x))
  #define MX3(a,b,c) __builtin_fmaxf(__builtin_fmaxf((a),(b)),(c))
  #define GAPA(MF,A0,A1,A2,A3,W0,W1,PW) do{ MF; sacc+=A0; sacc+=A1; sacc+=A2; sacc+=A3; PIN(sacc); W0; W1; PIN(PW); SBAR(); }while(0)
  #define EX(v) __builtin_amdgcn_exp2f(v)
  #define GAPB(MF,X,B) do{ MF; X[B]=EX(X[B]); X[B+1]=EX(X[B+1]); X[B+2]=EX(X[B+2]); X[B+3]=EX(X[B+3]); PIN(X); SBAR(); }while(0)
  #define VRD(i) do{ vlo[i]=vtr(vp_+(((i)>>2)*4096+((i)&3)*1024)); vhi[i]=vtr(vp_+(((i)>>2)*4096+((i)&3)*1024+512)); }while(0)
  #define KRD(G,j) do{ if(G){ kload2(kf,kp0+sl_next,j); SBAR(); } }while(0)
  #define STEP(C0,C1,P0,P1,t,GK,GV,GL) do{ SBAR(); \
    const lds_cptr vp_=vp0+sl_prev; \
    VRD(0); SBAR(); float sacc=(P0[0]+P0[1]); \
    GAPA(C0=__builtin_amdgcn_mfma_f32_32x32x16_bf16(kf[0],qr[0],negm,0,0,0), P0[2],P0[3],P0[4],P0[5],     pw0[0]=PKW(P0,0), pw0[1]=PKW(P0,2), pw0); \
    VRD(4); SBAR(); GAPA(C1=__builtin_amdgcn_mfma_f32_32x32x16_bf16(kf[1],qr[0],negm,0,0,0), P0[6],P0[7],P0[8],P0[9],     pw0[2]=PKW(P0,4), pw0[3]=PKW(P0,6), pw0); \
    VRD(1); SBAR(); GAPA(C0=__builtin_amdgcn_mfma_f32_32x32x16_bf16(kf[2],qr[1],C0,0,0,0),   P0[10],P0[11],P0[12],P0[13], pw1[0]=PKW(P0,8), pw1[1]=PKW(P0,10), pw1); \
    VRD(5); SBAR(); GAPA(C1=__builtin_amdgcn_mfma_f32_32x32x16_bf16(kf[3],qr[1],C1,0,0,0),   P0[14],P0[15],P1[0],P1[1],   pw1[2]=PKW(P0,12),pw1[3]=PKW(P0,14), pw1); \
    VRD(2); SBAR(); GAPA(C0=__builtin_amdgcn_mfma_f32_32x32x16_bf16(kf[4],qr[2],C0,0,0,0),   P1[2],P1[3],P1[4],P1[5],     pw2[0]=PKW(P1,0), pw2[1]=PKW(P1,2), pw2); \
    VRD(6); SBAR(); GAPA(C1=__builtin_amdgcn_mfma_f32_32x32x16_bf16(kf[5],qr[2],C1,0,0,0),   P1[6],P1[7],P1[8],P1[9],     pw2[2]=PKW(P1,4), pw2[3]=PKW(P1,6), pw2); \
    VRD(3); SBAR(); GAPA(C0=__builtin_amdgcn_mfma_f32_32x32x16_bf16(kf[6],qr[3],C0,0,0,0),   P1[10],P1[11],P1[12],P1[13], pw3[0]=PKW(P1,8), pw3[1]=PKW(P1,10), pw3); \
    VRD(7); SBAR(); GAPA(C1=__builtin_amdgcn_mfma_f32_32x32x16_bf16(kf[7],qr[3],C1,0,0,0),   P1[14],P1[15],0.f,0.f,       pw3[2]=PKW(P1,12),pw3[3]=PKW(P1,14), pw3); \
    l_reg+=sacc; \
    if(GK){DMA_K((t)+3,sl_cur);} if(GV){DMA_V((t)+1,sl_next);} \
    CMASK(C0,C1,t); \
    { float a=MX3(C0[0],C0[1],C1[0]),b=MX3(C0[2],C0[3],C1[1]); a=MX3(a,C1[2],C1[3]); \
      _Pragma("unroll") for(int r=4;r<16;r+=4){a=MX3(a,C0[r],C0[r+1]);b=MX3(b,C0[r+2],C0[r+3]);a=MX3(a,C1[r],C1[r+1]);b=MX3(b,C1[r+2],C1[r+3]);} \
      float rm=__builtin_fmaxf(a,b); { auto rr=__builtin_amdgcn_permlane32_swap(__float_as_uint(rm),__float_as_uint(rm),false,false); rm=__builtin_fmaxf(__uint_as_float(rr[0]),__uint_as_float(rr[1])); } \
      resc=false; \
      if(__builtin_expect(__any(rm>(float)THRL),0)){ const float dl=__builtin_fmaxf(rm,0.f); mhat+=dl; \
        _Pragma("unroll") for(int r=0;r<16;++r){C0[r]-=dl;C1[r]-=dl;} \
        _Pragma("unroll") for(int r=0;r<16;++r)negm[r]=-mhat; asm volatile("":"+v"(negm)); \
        const float f=__builtin_amdgcn_exp2f(-dl); l_reg*=f; if(hi==0)wsf[r32]=f; resc=true; } } \
    SBAR(); \
    GAPB(o[0]=__builtin_amdgcn_mfma_f32_32x32x16_bf16(PAF(0),VFR(0),o[0],0,0,0), C0,0); \
    GAPB(o[1]=__builtin_amdgcn_mfma_f32_32x32x16_bf16(PAF(0),VFR(4),o[1],0,0,0), C0,4); \
    KRD(GL,0); GAPB(o[0]=__builtin_amdgcn_mfma_f32_32x32x16_bf16(PAF(1),VFR(1),o[0],0,0,0), C0,8); \
    KRD(GL,1); GAPB(o[1]=__builtin_amdgcn_mfma_f32_32x32x16_bf16(PAF(1),VFR(5),o[1],0,0,0), C0,12); \
    KRD(GL,2); GAPB(o[0]=__builtin_amdgcn_mfma_f32_32x32x16_bf16(PAF(2),VFR(2),o[0],0,0,0), C1,0); \
    KRD(GL,3); GAPB(o[1]=__builtin_amdgcn_mfma_f32_32x32x16_bf16(PAF(2),VFR(6),o[1],0,0,0), C1,4); \
    GAPB(o[0]=__builtin_amdgcn_mfma_f32_32x32x16_bf16(PAF(3),VFR(3),o[0],0,0,0), C1,8); \
    GAPB(o[1]=__builtin_amdgcn_mfma_f32_32x32x16_bf16(PAF(3),VFR(7),o[1],0,0,0), C1,12); \
    }while(0)
  int t=1;
  #undef CMASK
  #define CMASK(P0,P1,t) do{}while(0)
  for(;t+5<NT;t+=2){
    STEP(pB0,pB1,pA0,pA1,t,true,true,true);     WAIT_BAR(2); RESC(); ROT();
    STEP(pA0,pA1,pB0,pB1,t+1,true,true,true);   WAIT_BAR(2); RESC(); ROT();
  }
  #undef CMASK
  #define CMASK(P0,P1,t) do{}while(0)
  #define ENDW(tt) do{ if((tt)+3<NT){WAIT_BAR(2);} else if((tt)+2<NT){WAIT_BAR(1);} else {WAIT_BAR(0);} }while(0)
  for(;t+1<NT;t+=2){
    STEP(pB0,pB1,pA0,pA1,t,(t+3<NT),(t+1<NT),(t+1<NT));       ENDW(t);   RESC(); ROT();
    STEP(pA0,pA1,pB0,pB1,t+1,(t+4<NT),(t+2<NT),(t+2<NT));     ENDW(t+1); RESC(); ROT();
  }
  STEP(pB0,pB1,pA0,pA1,NT-1,false,false,false); RESC();
  { float sacc=pB0[0]+pB0[1]; _Pragma("unroll") for(int r=2;r<16;++r)sacc+=pB0[r]; _Pragma("unroll") for(int r=0;r<16;++r)sacc+=pB1[r]; l_reg+=sacc;
    pw0=(u32x4){PKW(pB0,0),PKW(pB0,2),PKW(pB0,4),PKW(pB0,6)};pw1=(u32x4){PKW(pB0,8),PKW(pB0,10),PKW(pB0,12),PKW(pB0,14)};pw2=(u32x4){PKW(pB1,0),PKW(pB1,2),PKW(pB1,4),PKW(pB1,6)};pw3=(u32x4){PKW(pB1,8),PKW(pB1,10),PKW(pB1,12),PKW(pB1,14)};
    SBAR(); pv(o,vb0+sl_cur,PAF(0),PAF(1),PAF(2),PAF(3)); }
  #undef PKW
  #undef PAF
  #undef VFR
  #undef PIN
  #undef MX3
  #undef GAPA
  #undef GAPB
  #undef EX
  #undef VRD
  #undef KRD
  #undef STEP
  #undef ENDW
  {auto rr=__builtin_amdgcn_permlane32_swap(__float_as_uint(l_reg),__float_as_uint(l_reg),false,false);l_reg=__uint_as_float(rr[0])+__uint_as_float(rr[1]);}
  if(hi==0)wsf[32+r32]=l_reg;asm volatile("s_waitcnt lgkmcnt(0)":::"memory");
  float rli[16];
  #pragma unroll
  for(int r=0;r<16;++r)rli[r]=__builtin_amdgcn_rcpf(wsf[32+crow(r,hi)]);
  bf16*Ow=O+(rowbase+q0+wid*QBLK)*QP_+h*D;
  { bf16*stg=(bf16*)(shm+LDS_OST)+wid*2048;
    #pragma unroll
    for(int r=0;r<16;++r){const int orow=crow(r,hi);
      #pragma unroll
      for(int d0=0;d0<2;++d0)stg[orow*64+d0*32+r32]=__float2bfloat16(o[d0][r]*rli[r]);}
    asm volatile("s_waitcnt lgkmcnt(0)":::"memory");
    #pragma unroll
    for(int i=0;i<4;++i){const int row=i*8+(lane>>3),ch=lane&7; const u32x4 v=*(const u32x4*)(stg+row*64+ch*8); ATTN_STORE16(Ow+(long)row*QP_+ch*8,v);} }
  asm volatile("s_waitcnt lgkmcnt(0)\n\ts_barrier":::"memory");
  #undef DMA_K
  #undef DMA_V
  #undef CMASK
  #undef START
  #undef RESC
  #undef ROT
}
constexpr int ATTN_LDS_BYTES=LDS_BYTES;
struct AttnTensors { const bf16* Q; const bf16* K; const bf16* V; bf16* O; };
struct AttnUnit { int bh; int qb; };
struct StaticOrder {
  int vcu;
  __device__ __forceinline__ explicit StaticOrder(int grid,int block):vcu((block%8)*(grid/8)+block/8){}
  __device__ __forceinline__ bool next(int i,AttnUnit&u)const{ if(i>=4)return false; const int x=vcu>>5,c=vcu&31,idx=32*i+c; u.bh=2*x+(idx>>6); u.qb=idx&63; return true; }
  __device__ __forceinline__ void a_ready(const AttnUnit&)const{}
  __device__ __forceinline__ void done(const AttnUnit&)const{}
};
template<class Sched,int QP_,int KVP_,int SKV_,int GQ_,int THRL=8> __device__ __forceinline__ void attn_phase(char*lds,const AttnTensors&T,const Sched&S){
  AttnUnit u;
  for(int i=0;S.next(i,u);++i){ S.a_ready(u); attn_unit<THRL,QP_,KVP_,SKV_,GQ_>(0,u.bh,u.qb,T.Q,T.K,T.V,T.O,lds); S.done(u); }
}
struct CrossOrder {
  int vcu;
  __device__ __forceinline__ explicit CrossOrder(int grid,int block):vcu((block%8)*(grid/8)+block/8){}
  __device__ __forceinline__ bool next(int i,AttnUnit&u)const{ if(i>=1||vcu>=256)return false; u.bh=vcu>>6; u.qb=vcu&63; return true; }
  __device__ __forceinline__ void a_ready(const AttnUnit&)const{}
  __device__ __forceinline__ void done(const AttnUnit&)const{}
};
#undef SBAR
#undef WAIT_BAR
}
constexpr int NWAVES = 8;
constexpr int M = 16384, D = 1024, FF = 2816, NIN = 4096, MEMLEN = 256, NCH = 512;
constexpr float C2Q = 0.125f * 1.4426950408889634f;
constexpr size_t MiB = 1u << 20, KiB = 1u << 10;
constexpr size_t WS_CTL = 0, CTL_ZERO_BYTES = 1 * MiB;
constexpr size_t WS_SS2 = 256 * KiB, WS_SS3 = 320 * KiB, WS_SS4 = 384 * KiB, WS_SS5 = 448 * KiB;
constexpr size_t WS_SMALL = 1 * MiB;
constexpr size_t WS_RS1 = WS_SMALL, WS_ROPE = WS_SMALL + 64 * KiB, WS_DFT = WS_SMALL + 112 * KiB, WS_TW = WS_SMALL + 128 * KiB, WS_KC = WS_SMALL + 256 * KiB, WS_VC = WS_SMALL + 384 * KiB;
constexpr size_t WS_W1GU = 2 * MiB, WS_W1D = 13 * MiB, WS_W2GU = 18 * MiB + 512 * KiB, WS_W2D = 29 * MiB + 512 * KiB, WS_WIN = 35 * MiB, WS_WFB = 43 * MiB, WS_WAB = 45 * MiB, WS_WOUT = 47 * MiB,
                 WS_WCQ = 49 * MiB, WS_WCO = 49 * MiB + 512 * KiB;
constexpr size_t WS_HB16 = 56 * MiB;
constexpr size_t WS_R1 = 88 * MiB;
constexpr size_t WS_QO = WS_R1, WS_U = WS_R1 + 32 * MiB, WS_KR = WS_R1 + 64 * MiB, WS_VR = WS_R1 + 72 * MiB, WS_F = WS_R1 + 80 * MiB;
constexpr size_t WS_QC = WS_R1, WS_OC = WS_R1 + 8 * MiB;
constexpr size_t WS_GF = 184 * MiB, WS_GA = 216 * MiB, WS_END = 248 * MiB;
static_assert(WS_W1GU + (size_t)2 * FF * D * 2 == WS_W1D && WS_W1D + (size_t)D * FF * 2 == WS_W2GU && WS_W2GU + (size_t)2 * FF * D * 2 == WS_W2D && WS_W2D + (size_t)D * FF * 2 == WS_WIN, "weights map");
static_assert(WS_R1 + (size_t)M * FF * 2 <= WS_GF && WS_F + (size_t)M * NCH * 2 <= WS_GF, "R1 map");
constexpr int CW_BAR = 4096;
constexpr int RING_BYTES = 131072, LDSCTL_OFF = RING_BYTES, MISC_OFF = LDSCTL_OFF + 320, LDS_BYTES = 147456;

#define GAS __attribute__((address_space(1)))
#define LAS __attribute__((address_space(3)))
typedef unsigned short bf16;
typedef unsigned v4u __attribute__((ext_vector_type(4)));
typedef float f32x4 __attribute__((ext_vector_type(4)));
typedef float f32x2 __attribute__((ext_vector_type(2)));
#define LDS_WAIT() asm volatile("s_waitcnt lgkmcnt(0)" ::: "memory")
#define VM_WAIT() asm volatile("s_waitcnt vmcnt(0)" ::: "memory")
__device__ __forceinline__ unsigned f2bf(float f) { unsigned u = __builtin_bit_cast(unsigned, f); return (u + 0x7fffu + ((u >> 16) & 1u)) >> 16; }
__device__ __forceinline__ unsigned pk2(float lo, float hi) { return f2bf(lo) | (f2bf(hi) << 16); }
__device__ __forceinline__ float bf2f(unsigned short b) { return __uint_as_float((unsigned)b << 16); }
__device__ __forceinline__ float bflo_(unsigned u) { return __uint_as_float(u << 16); }
__device__ __forceinline__ float bfhi_(unsigned u) { return __uint_as_float(u & 0xffff0000u); }
constexpr float RMS_EPSF = 1e-6f;
__device__ __forceinline__ float wave_sum(float v) {
#pragma unroll
    for (int o = 1; o < 64; o <<= 1) v += __shfl_xor(v, o);
    return v;
}
__device__ __forceinline__ void sincos_rev(double x, float& s, float& c) {
    x -= __builtin_floor(x);
    const double q = __builtin_rint(x * 4.0);
    const double r = (x - q * 0.25) * 6.283185307179586476925;
    const double r2 = r * r;
    double sp = 1.0 / 6227020800.0; sp = sp * r2 - 1.0 / 39916800.0; sp = sp * r2 + 1.0 / 362880.0; sp = sp * r2 - 1.0 / 5040.0; sp = sp * r2 + 1.0 / 120.0; sp = sp * r2 - 1.0 / 6.0; sp = sp * r2 + 1.0; sp *= r;
    double cp = -1.0 / 87178291200.0; cp = cp * r2 + 1.0 / 479001600.0; cp = cp * r2 - 1.0 / 3628800.0; cp = cp * r2 + 1.0 / 40320.0; cp = cp * r2 - 1.0 / 720.0; cp = cp * r2 + 1.0 / 24.0; cp = cp * r2 - 0.5; cp = cp * r2 + 1.0;
    const int qi = (int)q & 3;
    const double ss = (qi == 0) ? sp : (qi == 1) ? cp : (qi == 2) ? -sp : -cp;
    const double cc = (qi == 0) ? cp : (qi == 1) ? -sp : (qi == 2) ? -cp : sp;
    s = (float)ss; c = (float)cc;
}

struct Frame {
    LAS unsigned char* lds;
    int tid, lane, wave, G, vcu;
    const float* in[24]; float* out; unsigned char* ws;
};
template <class T> __device__ __forceinline__ T* wsp(const Frame& F, size_t off) { return (T*)(F.ws + off); }

__device__ __forceinline__ void p0_transpose_item(const float* W, const float* gain, int K, int N, bf16* WT, int gu, LAS float* scr, int item, int lane) {
    const int nblk = N / 32, kb = item / nblk, nb = item % nblk, k0 = 64 * kb, n0 = 32 * nb;
#pragma unroll 8
    for (int i = 0; i < 32; ++i) { const int kk = 2 * i + (lane >> 5); float v = W[(size_t)(k0 + kk) * N + n0 + (lane & 31)]; if (gain) v *= gain[k0 + kk]; scr[kk * 33 + (lane & 31)] = v; }
    LDS_WAIT(); asm volatile("" ::: "memory");
    const int c = lane & 7;
    const int rb = (gu == 0) ? n0 : (256 * (n0 >> 7) + (n0 & 127) + (gu == 2 ? 128 : 0));
#pragma unroll
    for (int j = 0; j < 4; ++j) { const int n = (lane >> 3) + 8 * j; const LAS float* s = scr + (8 * c) * 33 + n;
        v4u o; o.x = pk2(s[0 * 33], s[1 * 33]); o.y = pk2(s[2 * 33], s[3 * 33]); o.z = pk2(s[4 * 33], s[5 * 33]); o.w = pk2(s[6 * 33], s[7 * 33]);
        *(GAS v4u*)(WT + (size_t)(rb + n) * K + k0 + 8 * c) = o; }
    LDS_WAIT(); asm volatile("" ::: "memory");
}
__device__ __forceinline__ void p0_prologue(Frame& F) {
    const int gw = F.vcu * NWAVES + F.wave, NGW = F.G * NWAVES;
    const int gt = blockIdx.x * (NWAVES * 64) + F.tid, NGT = F.G * NWAVES * 64;
    {
        f32x2* tw = wsp<f32x2>(F, WS_TW); f32x2* dft = wsp<f32x2>(F, WS_DFT); float* rope = wsp<float>(F, WS_ROPE);
        for (int i = gt; i < 16384; i += NGT) { float s, c; sincos_rev((double)i * (1.0 / 16384.0), s, c); tw[i] = (f32x2){c, s}; }
        for (int i = gt; i < 128; i += NGT) { float s, c; sincos_rev((double)i * (1.0 / 128.0), s, c); dft[i] = (f32x2){c, s}; }
        for (int i = gt; i < (256 + 64) * 16; i += NGT) {
            const int j = i & 15, p = i >> 4; const int pos = (p < 256) ? p : p - 256;
            double inv = 1.0; for (int q = 0; q < j; ++q) inv *= 0.5623413251903491;
            const float ang = (float)pos * (float)inv;
            float s, c; sincos_rev((double)ang * 0.15915494309189533577, s, c);
            if (p < 256) { rope[p * 16 + j] = c; rope[4096 + p * 16 + j] = s; } else { rope[8192 + pos * 16 + j] = c; rope[8192 + 1024 + pos * 16 + j] = s; }
        }
    }
    {
        LAS float* scr = (LAS float*)(F.lds + F.wave * 16384);
        constexpr int I_GU = (D / 64) * (FF / 32), I_DN = (FF / 64) * (D / 32), I_IN = (D / 64) * (NIN / 32), I_SQ = (D / 64) * (D / 32), I_CQ = (D / 64) * (256 / 32), I_CO = (256 / 64) * (D / 32);
        constexpr int NITEMS = 4 * I_GU + 2 * I_DN + I_IN + 2 * I_SQ + I_CQ + I_CO;
        for (int it = gw; it < NITEMS; it += NGW) {
            int r = it;
            if (r < I_GU) { p0_transpose_item(F.in[3], F.in[2], D, FF, wsp<bf16>(F, WS_W1GU), 1, scr, r, F.lane); continue; } r -= I_GU;
            if (r < I_GU) { p0_transpose_item(F.in[4], F.in[2], D, FF, wsp<bf16>(F, WS_W1GU), 2, scr, r, F.lane); continue; } r -= I_GU;
            if (r < I_DN) { p0_transpose_item(F.in[5], nullptr, FF, D, wsp<bf16>(F, WS_W1D), 0, scr, r, F.lane); continue; } r -= I_DN;
            if (r < I_GU) { p0_transpose_item(F.in[20], F.in[19], D, FF, wsp<bf16>(F, WS_W2GU), 1, scr, r, F.lane); continue; } r -= I_GU;
            if (r < I_GU) { p0_transpose_item(F.in[21], F.in[19], D, FF, wsp<bf16>(F, WS_W2GU), 2, scr, r, F.lane); continue; } r -= I_GU;
            if (r < I_DN) { p0_transpose_item(F.in[22], nullptr, FF, D, wsp<bf16>(F, WS_W2D), 0, scr, r, F.lane); continue; } r -= I_DN;
            if (r < I_IN) { p0_transpose_item(F.in[7], F.in[6], D, NIN, wsp<bf16>(F, WS_WIN), 0, scr, r, F.lane); continue; } r -= I_IN;
            if (r < I_SQ) { p0_transpose_item(F.in[11], nullptr, D, D, wsp<bf16>(F, WS_WAB), 0, scr, r, F.lane); continue; } r -= I_SQ;
            if (r < I_SQ) { p0_transpose_item(F.in[12], nullptr, D, D, wsp<bf16>(F, WS_WOUT), 0, scr, r, F.lane); continue; } r -= I_SQ;
            if (r < I_CQ) { p0_transpose_item(F.in[15], F.in[13], D, 256, wsp<bf16>(F, WS_WCQ), 0, scr, r, F.lane); continue; } r -= I_CQ;
            p0_transpose_item(F.in[18], nullptr, 256, D, wsp<bf16>(F, WS_WCO), 0, scr, r, F.lane);
        }
    }
    __syncthreads();
    {
        LAS f32x2* tab = (LAS f32x2*)F.lds;
        if (F.tid < 128) { float s, c; sincos_rev((double)F.tid * (1.0 / 128.0), s, c); tab[F.tid] = (f32x2){c * 0.08838834764831845f, s * 0.08838834764831845f}; }
        __syncthreads();
        const float* Wfb = F.in[10]; bf16* WT = wsp<bf16>(F, WS_WFB);
        for (int it = gt; it < 1024 * 128; it += NGT) {
            const int n = it & 1023, kb = it >> 10, kk0 = kb * 8, g = kk0 >> 8, ri = (kk0 >> 7) & 1, c0 = kk0 & 127;
            float a[8];
#pragma unroll
            for (int i = 0; i < 8; ++i) a[i] = 0.f;
            for (int j = 0; j < 128; ++j) {
                const float w = Wfb[(size_t)(g * 128 + j) * 1024 + n];
#pragma unroll
                for (int i = 0; i < 8; ++i) { const f32x2 cs = tab[((c0 + i) * j) & 127]; a[i] += w * (ri ? cs.y : cs.x); }
            }
            v4u o; o.x = pk2(a[0], a[1]); o.y = pk2(a[2], a[3]); o.z = pk2(a[4], a[5]); o.w = pk2(a[6], a[7]);
            *(GAS v4u*)(WT + (size_t)n * 1024 + kk0) = o;
        }
        __syncthreads();
    }
    {
        const float* x = F.in[0]; bf16* xb = wsp<bf16>(F, WS_HB16); float* rs1 = wsp<float>(F, WS_RS1);
        for (int m = gw; m < M; m += NGW) {
            const GAS f32x4* xr = (const GAS f32x4*)(x + (size_t)m * D) + F.lane;
            f32x4 v[4]; float s = 0.f;
#pragma unroll
            for (int j = 0; j < 4; ++j) { v[j] = xr[64 * j]; s += (v[j].x * v[j].x + v[j].y * v[j].y) + (v[j].z * v[j].z + v[j].w * v[j].w); }
            s = wave_sum(s);
            GAS unsigned long long* o8 = (GAS unsigned long long*)(xb + (size_t)m * D) + F.lane;
#pragma unroll
            for (int j = 0; j < 4; ++j) o8[64 * j] = (unsigned long long)pk2(v[j].x, v[j].y) | ((unsigned long long)pk2(v[j].z, v[j].w) << 32);
            if (F.lane == 0) rs1[m] = 1.0f / sqrtf(s * (1.0f / D) + RMS_EPSF);
        }
    }
    {
        LAS float* mn = (LAS float*)(F.lds + 8192); LAS float* red = (LAS float*)(F.lds + 8192 + 4096);
        const float* mem = F.in[1]; const float* gm = F.in[14]; const float* Wk = F.in[16]; const float* Wv = F.in[17];
        bf16* Kc = wsp<bf16>(F, WS_KC); bf16* Vc = wsp<bf16>(F, WS_VC);
        for (int r = blockIdx.x; r < MEMLEN; r += F.G) {
            __syncthreads();
            const float a = mem[(size_t)r * D + F.tid], b = mem[(size_t)r * D + 512 + F.tid];
            float s = wave_sum(a * a + b * b);
            if (F.lane == 0) red[F.wave] = s;
            __syncthreads();
            float tot = 0.f;
#pragma unroll
            for (int w = 0; w < NWAVES; ++w) tot += red[w];
            const float rinv = 1.0f / sqrtf(tot * (1.0f / D) + RMS_EPSF);
            mn[F.tid] = a * rinv * gm[F.tid]; mn[512 + F.tid] = b * rinv * gm[512 + F.tid];
            __syncthreads();
            const int n = F.tid & 255; const float* W = (F.tid < 256) ? Wk : Wv; float acc = 0.f;
            for (int k = 0; k < D; ++k) acc += mn[k] * W[(size_t)k * 256 + n];
            ((F.tid < 256) ? Kc : Vc)[r * 256 + n] = (bf16)f2bf(acc);
        }
        __syncthreads();
    }
}

__device__ __forceinline__ void p_prep_qk(Frame& F) {
    bf16* Q = wsp<bf16>(F, WS_QO); bf16* Kr = wsp<bf16>(F, WS_KR); const float* rope = wsp<float>(F, WS_ROPE);
    const float* qg = F.in[8]; const float* kg = F.in[9];
    const int gt = blockIdx.x * (NWAVES * 64) + F.tid, NGT = F.G * NWAVES * 64;
    for (int it = gt; it < M * 20; it += NGT) {
        const int t = it / 20, hh = it - t * 20;
        bf16* p = (hh < 16) ? (Q + (size_t)t * 1024 + hh * 64) : (Kr + (size_t)t * 256 + (hh - 16) * 64);
        const float* gain = (hh < 16) ? qg : kg; const float post = (hh < 16) ? C2Q : 1.0f;
        float v[64];
#pragma unroll
        for (int i = 0; i < 8; ++i) { const v4u w = *(const GAS v4u*)(p + 8 * i);
            v[8 * i + 0] = __uint_as_float(w.x << 16); v[8 * i + 1] = __uint_as_float(w.x & 0xffff0000u); v[8 * i + 2] = __uint_as_float(w.y << 16); v[8 * i + 3] = __uint_as_float(w.y & 0xffff0000u);
            v[8 * i + 4] = __uint_as_float(w.z << 16); v[8 * i + 5] = __uint_as_float(w.z & 0xffff0000u); v[8 * i + 6] = __uint_as_float(w.w << 16); v[8 * i + 7] = __uint_as_float(w.w & 0xffff0000u); }
        float s = 0.f;
#pragma unroll
        for (int i = 0; i < 64; ++i) s += v[i] * v[i];
        const float rinv = 1.0f / sqrtf(s * (1.0f / 64.0f) + RMS_EPSF);
#pragma unroll
        for (int i = 0; i < 64; ++i) v[i] = v[i] * rinv * gain[i];
        const int row = t >> 6, col = t & 63;
#pragma unroll
        for (int j = 0; j < 16; ++j) {
            const float cr = rope[row * 16 + j], sr = rope[4096 + row * 16 + j], cc = rope[8192 + col * 16 + j], sc = rope[8192 + 1024 + col * 16 + j];
            const float a = v[j], b = v[16 + j]; v[j] = a * cr - b * sr; v[16 + j] = b * cr + a * sr;
            const float e = v[32 + j], f = v[48 + j]; v[32 + j] = e * cc - f * sc; v[48 + j] = f * cc + e * sc;
        }
#pragma unroll
        for (int i = 0; i < 8; ++i) { v4u o; o.x = pk2(v[8 * i] * post, v[8 * i + 1] * post); o.y = pk2(v[8 * i + 2] * post, v[8 * i + 3] * post); o.z = pk2(v[8 * i + 4] * post, v[8 * i + 5] * post); o.w = pk2(v[8 * i + 6] * post, v[8 * i + 7] * post);
            *(GAS v4u*)(p + 8 * i) = o; }
    }
}
__device__ __forceinline__ void prep_vec(bf16* p, const float* gain, const float* rope, int t, int sub, float post) {
    const v4u w = *(const GAS v4u*)p;
    float y[8] = {bflo_(w.x), bfhi_(w.x), bflo_(w.y), bfhi_(w.y), bflo_(w.z), bfhi_(w.z), bflo_(w.w), bfhi_(w.w)};
    float s = 0.f;
#pragma unroll
    for (int e = 0; e < 8; ++e) s += y[e] * y[e];
    s += __shfl_xor(s, 1); s += __shfl_xor(s, 2); s += __shfl_xor(s, 4);
    const float rinv = 1.0f / sqrtf(s * (1.0f / 64.0f) + RMS_EPSF);
    const f32x4 g0 = *(const GAS f32x4*)(gain + 8 * sub), g1 = *(const GAS f32x4*)(gain + 8 * sub + 4);
#pragma unroll
    for (int e = 0; e < 4; ++e) { y[e] *= rinv * g0[e]; y[4 + e] *= rinv * g1[e]; }
    const int half = sub >> 2, pos = half ? (t & 63) : (t >> 6);
    const float* ct = rope + (half ? 8192 : 0) + pos * 16 + (sub & 1) * 8; const float* st = ct + (half ? 1024 : 4096);
    const f32x4 c0 = *(const GAS f32x4*)ct, c1 = *(const GAS f32x4*)(ct + 4), s0 = *(const GAS f32x4*)st, s1 = *(const GAS f32x4*)(st + 4);
    const float sgn = (sub & 2) ? 1.0f : -1.0f;
    float o[8];
#pragma unroll
    for (int e = 0; e < 8; ++e) { const float py = __shfl_xor(y[e], 2); const float c = e < 4 ? c0[e] : c1[e - 4], sn = e < 4 ? s0[e] : s1[e - 4]; o[e] = (y[e] * c + sgn * py * sn) * post; }
    v4u r; r.x = pk2(o[0], o[1]); r.y = pk2(o[2], o[3]); r.z = pk2(o[4], o[5]); r.w = pk2(o[6], o[7]);
    *(GAS v4u*)p = r;
}
__device__ __forceinline__ void p_prep_qk2(Frame& F) {
    bf16* Q = wsp<bf16>(F, WS_QO); bf16* Kr = wsp<bf16>(F, WS_KR); const float* rope = wsp<float>(F, WS_ROPE);
    const int sub = F.lane & 7, gv = (blockIdx.x * (NWAVES * 64) + F.tid) >> 3, NGV = (F.G * NWAVES * 64) >> 3;
    for (int v = gv; v < M * 16; v += NGV) prep_vec(Q + (size_t)v * 64 + sub * 8, F.in[8], rope, v >> 4, sub, C2Q);
    for (int v = gv; v < M * 4; v += NGV) prep_vec(Kr + (size_t)v * 64 + sub * 8, F.in[9], rope, v >> 2, sub, 1.0f);
}
__device__ __forceinline__ void p_fftA_simple(Frame& F) {
    const bf16* X = wsp<bf16>(F, WS_F); bf16* A = wsp<bf16>(F, WS_HB16); const f32x2* tw = wsp<f32x2>(F, WS_TW); const f32x2* dft = wsp<f32x2>(F, WS_DFT);
    LAS bf16* Xs = (LAS bf16*)F.lds; LAS f32x2* tab = (LAS f32x2*)(F.lds + 65536);
    if (F.tid < 128) tab[F.tid] = dft[F.tid];
    for (int unit = blockIdx.x; unit < 512; unit += F.G) {
        const int t2 = unit >> 2, g = unit & 3;
        __syncthreads();
#pragma unroll
        for (int i = 0; i < 4; ++i) { const int q = F.tid + 512 * i, row = q >> 4, ch = q & 15;
            *(LAS v4u*)(Xs + row * 128 + ch * 8) = *(const GAS v4u*)(X + (size_t)(128 * row + t2) * NCH + g * 128 + ch * 8); }
        __syncthreads();
        const int c = F.tid & 127, kq = F.tid >> 7;
        for (int k1 = kq * 32; k1 < kq * 32 + 32; ++k1) {
            float ar = 0.f, ai = 0.f; int idx = 0;
#pragma unroll 8
            for (int t1 = 0; t1 < 128; ++t1) { const float x = bf2f(Xs[t1 * 128 + c]); const f32x2 cs = tab[idx]; ar += x * cs.x; ai -= x * cs.y; idx = (idx + k1) & 127; }
            ar *= 0.08838834764831845f; ai *= 0.08838834764831845f;
            const f32x2 w = tw[t2 * k1];
            const float br = ar * w.x + ai * w.y, bi = ai * w.x - ar * w.y;
            bf16* o = A + ((size_t)(k1 * 128 + t2) * 4 + g) * 256 + c;
            o[0] = (bf16)f2bf(br); o[128] = (bf16)f2bf(bi);
        }
    }
    __syncthreads();
}
__device__ __forceinline__ void p_fftB_simple(Frame& F) {
    const bf16* A = wsp<bf16>(F, WS_HB16); bf16* U = wsp<bf16>(F, WS_U); const f32x2* dft = wsp<f32x2>(F, WS_DFT);
    LAS bf16* As = (LAS bf16*)F.lds; LAS f32x2* tab = (LAS f32x2*)(F.lds + 65536);
    if (F.tid < 128) tab[F.tid] = dft[F.tid];
    for (int unit = blockIdx.x; unit < 512; unit += F.G) {
        const int k1 = unit >> 2, g = unit & 3;
        __syncthreads();
#pragma unroll
        for (int i = 0; i < 8; ++i) { const int q = F.tid + 512 * i, row = q >> 5, ch = q & 31;
            *(LAS v4u*)(As + row * 256 + ch * 8) = *(const GAS v4u*)(A + ((size_t)(k1 * 128 + row) * 4 + g) * 256 + ch * 8); }
        __syncthreads();
        const int c = F.tid & 127, kq = F.tid >> 7;
        for (int k2 = kq * 32; k2 < kq * 32 + 32; ++k2) {
            float ur = 0.f, ui = 0.f; int idx = 0;
#pragma unroll 8
            for (int t2 = 0; t2 < 128; ++t2) { const float ar = bf2f(As[t2 * 256 + c]), ai = bf2f(As[t2 * 256 + 128 + c]); const f32x2 cs = tab[idx];
                ur += ar * cs.x + ai * cs.y; ui += ai * cs.x - ar * cs.y; idx = (idx + k2) & 127; }
            bf16* o = U + (size_t)(k1 + 128 * k2) * 1024 + g * 256 + c;
            o[0] = (bf16)f2bf(ur * 0.08838834764831845f); o[128] = (bf16)f2bf(ui * 0.08838834764831845f);
        }
    }
    __syncthreads();
}
__device__ __forceinline__ void p_attn_simple(Frame& F) {
    bf16* Q = wsp<bf16>(F, WS_QO); const bf16* Kr = wsp<bf16>(F, WS_KR); const bf16* Vr = wsp<bf16>(F, WS_VR);
    const int gt = blockIdx.x * (NWAVES * 64) + F.tid, NGT = F.G * NWAVES * 64;
    for (int it = gt; it < M * 16; it += NGT) {
        const int h = it >> 14, t = it & (M - 1), kvh = h >> 2;
        bf16* qp = Q + (size_t)t * 1024 + h * 64;
        float q[64], o[64];
#pragma unroll
        for (int i = 0; i < 8; ++i) { const v4u w = *(const GAS v4u*)(qp + 8 * i);
            q[8 * i + 0] = bflo_(w.x); q[8 * i + 1] = bfhi_(w.x); q[8 * i + 2] = bflo_(w.y); q[8 * i + 3] = bfhi_(w.y); q[8 * i + 4] = bflo_(w.z); q[8 * i + 5] = bfhi_(w.z); q[8 * i + 6] = bflo_(w.w); q[8 * i + 7] = bfhi_(w.w); }
#pragma unroll
        for (int i = 0; i < 64; ++i) o[i] = 0.f;
        float mx = -1e30f, l = 0.f;
        for (int key = 0; key < M; ++key) {
            const bf16* kp = Kr + (size_t)key * 256 + kvh * 64; const bf16* vp = Vr + (size_t)key * 256 + kvh * 64;
            float s = 0.f;
#pragma unroll
            for (int i = 0; i < 8; ++i) { const v4u w = *(const GAS v4u*)(kp + 8 * i);
                s += q[8 * i + 0] * bflo_(w.x) + q[8 * i + 1] * bfhi_(w.x) + q[8 * i + 2] * bflo_(w.y) + q[8 * i + 3] * bfhi_(w.y) + q[8 * i + 4] * bflo_(w.z) + q[8 * i + 5] * bfhi_(w.z) + q[8 * i + 6] * bflo_(w.w) + q[8 * i + 7] * bfhi_(w.w); }
            const float mn = fmaxf(mx, s), al = __builtin_amdgcn_exp2f(mx - mn), p = __builtin_amdgcn_exp2f(s - mn);
            l = l * al + p; mx = mn;
#pragma unroll
            for (int i = 0; i < 8; ++i) { const v4u w = *(const GAS v4u*)(vp + 8 * i);
                o[8 * i + 0] = o[8 * i + 0] * al + p * bflo_(w.x); o[8 * i + 1] = o[8 * i + 1] * al + p * bfhi_(w.x); o[8 * i + 2] = o[8 * i + 2] * al + p * bflo_(w.y); o[8 * i + 3] = o[8 * i + 3] * al + p * bfhi_(w.y);
                o[8 * i + 4] = o[8 * i + 4] * al + p * bflo_(w.z); o[8 * i + 5] = o[8 * i + 5] * al + p * bfhi_(w.z); o[8 * i + 6] = o[8 * i + 6] * al + p * bflo_(w.w); o[8 * i + 7] = o[8 * i + 7] * al + p * bfhi_(w.w); }
        }
        const float li = 1.0f / l;
#pragma unroll
        for (int i = 0; i < 8; ++i) { v4u w; w.x = pk2(o[8 * i] * li, o[8 * i + 1] * li); w.y = pk2(o[8 * i + 2] * li, o[8 * i + 3] * li); w.z = pk2(o[8 * i + 4] * li, o[8 * i + 5] * li); w.w = pk2(o[8 * i + 6] * li, o[8 * i + 7] * li);
            *(GAS v4u*)(qp + 8 * i) = w; }
    }
}
__device__ __forceinline__ void p_cross_simple(Frame& F) {
    const bf16* QC = wsp<bf16>(F, WS_QC); bf16* OC = wsp<bf16>(F, WS_OC); const bf16* Kc = wsp<bf16>(F, WS_KC); const bf16* Vc = wsp<bf16>(F, WS_VC);
    const int gt = blockIdx.x * (NWAVES * 64) + F.tid, NGT = F.G * NWAVES * 64;
    for (int it = gt; it < M * 4; it += NGT) {
        const int h = it >> 14, t = it & (M - 1);
        const bf16* qp = QC + (size_t)t * 256 + h * 64;
        float q[64], o[64];
#pragma unroll
        for (int i = 0; i < 8; ++i) { const v4u w = *(const GAS v4u*)(qp + 8 * i);
            q[8 * i + 0] = bflo_(w.x) * C2Q; q[8 * i + 1] = bfhi_(w.x) * C2Q; q[8 * i + 2] = bflo_(w.y) * C2Q; q[8 * i + 3] = bfhi_(w.y) * C2Q; q[8 * i + 4] = bflo_(w.z) * C2Q; q[8 * i + 5] = bfhi_(w.z) * C2Q; q[8 * i + 6] = bflo_(w.w) * C2Q; q[8 * i + 7] = bfhi_(w.w) * C2Q; }
#pragma unroll
        for (int i = 0; i < 64; ++i) o[i] = 0.f;
        float mx = -1e30f, l = 0.f;
        for (int key = 0; key < MEMLEN; ++key) {
            const bf16* kp = Kc + key * 256 + h * 64; const bf16* vp = Vc + key * 256 + h * 64;
            float s = 0.f;
#pragma unroll
            for (int i = 0; i < 8; ++i) { const v4u w = *(const GAS v4u*)(kp + 8 * i);
                s += q[8 * i + 0] * bflo_(w.x) + q[8 * i + 1] * bfhi_(w.x) + q[8 * i + 2] * bflo_(w.y) + q[8 * i + 3] * bfhi_(w.y) + q[8 * i + 4] * bflo_(w.z) + q[8 * i + 5] * bfhi_(w.z) + q[8 * i + 6] * bflo_(w.w) + q[8 * i + 7] * bfhi_(w.w); }
            const float mn = fmaxf(mx, s), al = __builtin_amdgcn_exp2f(mx - mn), p = __builtin_amdgcn_exp2f(s - mn);
            l = l * al + p; mx = mn;
#pragma unroll
            for (int i = 0; i < 8; ++i) { const v4u w = *(const GAS v4u*)(vp + 8 * i);
                o[8 * i + 0] = o[8 * i + 0] * al + p * bflo_(w.x); o[8 * i + 1] = o[8 * i + 1] * al + p * bfhi_(w.x); o[8 * i + 2] = o[8 * i + 2] * al + p * bflo_(w.y); o[8 * i + 3] = o[8 * i + 3] * al + p * bfhi_(w.y);
                o[8 * i + 4] = o[8 * i + 4] * al + p * bflo_(w.z); o[8 * i + 5] = o[8 * i + 5] * al + p * bfhi_(w.z); o[8 * i + 6] = o[8 * i + 6] * al + p * bflo_(w.w); o[8 * i + 7] = o[8 * i + 7] * al + p * bfhi_(w.w); }
        }
        const float li = 1.0f / l; bf16* op = OC + (size_t)t * 256 + h * 64;
#pragma unroll
        for (int i = 0; i < 8; ++i) { v4u w; w.x = pk2(o[8 * i] * li, o[8 * i + 1] * li); w.y = pk2(o[8 * i + 2] * li, o[8 * i + 3] * li); w.z = pk2(o[8 * i + 4] * li, o[8 * i + 5] * li); w.w = pk2(o[8 * i + 6] * li, o[8 * i + 7] * li);
            *(GAS v4u*)(op + 8 * i) = w; }
    }
}
__device__ __forceinline__ void p_final(Frame& F) {
    const int gw = F.vcu * NWAVES + F.wave, NGW = F.G * NWAVES; const float* gf = F.in[23];
    f32x4 gv[4];
#pragma unroll
    for (int j = 0; j < 4; ++j) gv[j] = ((const GAS f32x4*)gf)[F.lane + 64 * j];
    for (int m = gw; m < M; m += NGW) {
        GAS f32x4* xr = (GAS f32x4*)(F.out + (size_t)m * D) + F.lane;
        f32x4 v[4]; float s = 0.f;
#pragma unroll
        for (int j = 0; j < 4; ++j) { v[j] = xr[64 * j]; s += (v[j].x * v[j].x + v[j].y * v[j].y) + (v[j].z * v[j].z + v[j].w * v[j].w); }
        const float rinv = 1.0f / sqrtf(wave_sum(s) * (1.0f / D) + RMS_EPSF);
#pragma unroll
        for (int j = 0; j < 4; ++j) xr[64 * j] = v[j] * rinv * gv[j];
    }
}
namespace fftm {
typedef short bf16x8 __attribute__((ext_vector_type(8)));
typedef short s16x4 __attribute__((ext_vector_type(4)));
typedef float f32x16 __attribute__((ext_vector_type(16)));
typedef short v4i16_t __attribute__((ext_vector_type(4)));
typedef LAS const unsigned char* lptr;
constexpr int STR_A = 320, STR_B = 576;
constexpr float RSQ128 = 0.08838834764831845f;
#define FFT_MFMA(a, b, c) __builtin_amdgcn_mfma_f32_32x32x16_bf16(a, b, c, 0, 0, 0)
__device__ __forceinline__ s16x4 vtr(lptr p) { return __builtin_bit_cast(s16x4, __builtin_amdgcn_ds_read_tr16_b64_v4i16((LAS v4i16_t*)p)); }
struct DftFrags { bf16x8 c[8], s[8]; };
__device__ __forceinline__ void make_frags(DftFrags& f, const f32x2* dft, int jb, int lane) {
    const int j = 32 * jb + (lane & 31), h = lane >> 5;
#pragma unroll
    for (int s = 0; s < 8; ++s)
#pragma unroll
        for (int e = 0; e < 8; ++e) { const f32x2 cs = dft[(j * (16 * s + 8 * h + e)) & 127]; f.c[s][e] = (short)f2bf(cs.x * RSQ128); f.s[s][e] = (short)f2bf(cs.y * RSQ128); }
}
template <int STRIDE> __device__ __forceinline__ bf16x8 tfrag(lptr p, int s) {
    const s16x4 lo = vtr(p + 16 * s * STRIDE), hi = vtr(p + 16 * s * STRIDE + 4 * STRIDE);
    return (bf16x8){lo[0], lo[1], lo[2], lo[3], hi[0], hi[1], hi[2], hi[3]};
}
template <int STRIDE> __device__ __forceinline__ int tfrag_lane_off(int lane) {
    const int g4 = lane >> 4, c0 = 16 * (g4 & 1), h = g4 >> 1, li = lane & 15, q = li >> 2, p = li & 3;
    return (8 * h + q) * STRIDE + (c0 + 4 * p) * 2;
}
__device__ __forceinline__ unsigned long long pk4(float a, float b, float c, float d) { return (unsigned long long)pg8::cvt_pk_bf16(a, b) | ((unsigned long long)pg8::cvt_pk_bf16(c, d) << 32); }

__device__ __forceinline__ void stageA(Frame& F) {
    const bf16* X = wsp<bf16>(F, WS_F); bf16* A = wsp<bf16>(F, WS_HB16); const f32x2* tw = wsp<f32x2>(F, WS_TW); const f32x2* dft = wsp<f32x2>(F, WS_DFT);
    const int jb = F.wave & 3, chh = F.wave >> 2, lane = F.lane, h = lane >> 5;
    DftFrags fr; make_frags(fr, dft, jb, lane);
    const lptr tp = (lptr)F.lds + tfrag_lane_off<STR_A>(lane) + 128 * chh;
    const int k1 = 32 * jb + (lane & 31);
    v4u pre[4];
    int unit = blockIdx.x;
    if (unit < 512) {
#pragma unroll
        for (int i = 0; i < 4; ++i) { const int q = F.tid + 512 * i, row = q >> 4, ch = q & 15; pre[i] = *(const GAS v4u*)(X + (size_t)(128 * row + (unit >> 2)) * NCH + (unit & 3) * 128 + ch * 8); }
    }
    for (; unit < 512; unit += F.G) {
        const int t2 = unit >> 2, g = unit & 3;
        __syncthreads();
#pragma unroll
        for (int i = 0; i < 4; ++i) { const int q = F.tid + 512 * i, row = q >> 4, ch = q & 15; *(LAS v4u*)(F.lds + row * STR_A + ch * 16) = pre[i]; }
        __syncthreads();
        const int nu = unit + F.G;
        if (nu < 512) {
#pragma unroll
            for (int i = 0; i < 4; ++i) { const int q = F.tid + 512 * i, row = q >> 4, ch = q & 15; pre[i] = *(const GAS v4u*)(X + (size_t)(128 * row + (nu >> 2)) * NCH + (nu & 3) * 128 + ch * 8); }
        }
        f32x16 acc[2][2];
#pragma unroll
        for (int cb = 0; cb < 2; ++cb) { acc[cb][0] = f32x16{}; acc[cb][1] = f32x16{}; }
#pragma unroll
        for (int s = 0; s < 8; ++s)
#pragma unroll
            for (int cb = 0; cb < 2; ++cb) { const bf16x8 a = tfrag<STR_A>(tp + 64 * cb, s); acc[cb][0] = FFT_MFMA(a, fr.c[s], acc[cb][0]); acc[cb][1] = FFT_MFMA(a, fr.s[s], acc[cb][1]); }
        const f32x2 w = tw[t2 * k1];
        bf16* orow = A + ((size_t)(k1 * 128 + t2) * 4 + g) * 256 + 64 * chh + 4 * h;
#pragma unroll
        for (int cb = 0; cb < 2; ++cb)
#pragma unroll
            for (int qd = 0; qd < 4; ++qd) {
                float re[4], im[4];
#pragma unroll
                for (int i = 0; i < 4; ++i) { const float a0 = acc[cb][0][4 * qd + i], a1 = acc[cb][1][4 * qd + i]; re[i] = a0 * w.x - a1 * w.y; im[i] = -a1 * w.x - a0 * w.y; }
                *(GAS unsigned long long*)(orow + 32 * cb + 8 * qd) = pk4(re[0], re[1], re[2], re[3]);
                *(GAS unsigned long long*)(orow + 128 + 32 * cb + 8 * qd) = pk4(im[0], im[1], im[2], im[3]);
            }
    }
    __syncthreads();
}
__device__ __forceinline__ void stageB(Frame& F) {
    const bf16* A = wsp<bf16>(F, WS_HB16); bf16* U = wsp<bf16>(F, WS_U); const f32x2* dft = wsp<f32x2>(F, WS_DFT);
    const int jb = F.wave & 3, chh = F.wave >> 2, lane = F.lane, h = lane >> 5;
    DftFrags fr; make_frags(fr, dft, jb, lane);
    const lptr tp = (lptr)F.lds + tfrag_lane_off<STR_B>(lane) + 128 * chh;
    const int k2 = 32 * jb + (lane & 31);
    v4u pre[8];
    int unit = blockIdx.x;
    if (unit < 512) {
#pragma unroll
        for (int i = 0; i < 8; ++i) { const int q = F.tid + 512 * i, row = q >> 5, ch = q & 31; pre[i] = *(const GAS v4u*)(A + ((size_t)((unit >> 2) * 128 + row) * 4 + (unit & 3)) * 256 + ch * 8); }
    }
    for (; unit < 512; unit += F.G) {
        const int k1 = unit >> 2, g = unit & 3;
        __syncthreads();
#pragma unroll
        for (int i = 0; i < 8; ++i) { const int q = F.tid + 512 * i, row = q >> 5, ch = q & 31; *(LAS v4u*)(F.lds + row * STR_B + ch * 16) = pre[i]; }
        __syncthreads();
        const int nu = unit + F.G;
        if (nu < 512) {
#pragma unroll
            for (int i = 0; i < 8; ++i) { const int q = F.tid + 512 * i, row = q >> 5, ch = q & 31; pre[i] = *(const GAS v4u*)(A + ((size_t)((nu >> 2) * 128 + row) * 4 + (nu & 3)) * 256 + ch * 8); }
        }
        f32x16 accR[2], accI[2];
#pragma unroll
        for (int cb = 0; cb < 2; ++cb) { accR[cb] = f32x16{}; accI[cb] = f32x16{}; }
#pragma unroll
        for (int s = 0; s < 8; ++s) {
            const bf16x8 ns = fr.s[s] ^ (short)0x8000;
#pragma unroll
            for (int cb = 0; cb < 2; ++cb) {
                const bf16x8 ar = tfrag<STR_B>(tp + 64 * cb, s), ai = tfrag<STR_B>(tp + 256 + 64 * cb, s);
                accR[cb] = FFT_MFMA(ar, fr.c[s], accR[cb]); accR[cb] = FFT_MFMA(ai, fr.s[s], accR[cb]);
                accI[cb] = FFT_MFMA(ai, fr.c[s], accI[cb]); accI[cb] = FFT_MFMA(ar, ns, accI[cb]);
            }
        }
        bf16* orow = U + (size_t)(k1 + 128 * k2) * 1024 + g * 256 + 64 * chh + 4 * h;
#pragma unroll
        for (int cb = 0; cb < 2; ++cb)
#pragma unroll
            for (int qd = 0; qd < 4; ++qd) {
                *(GAS unsigned long long*)(orow + 32 * cb + 8 * qd) = pk4(accR[cb][4 * qd], accR[cb][4 * qd + 1], accR[cb][4 * qd + 2], accR[cb][4 * qd + 3]);
                *(GAS unsigned long long*)(orow + 128 + 32 * cb + 8 * qd) = pk4(accI[cb][4 * qd], accI[cb][4 * qd + 1], accI[cb][4 * qd + 2], accI[cb][4 * qd + 3]);
            }
    }
    __syncthreads();
}
#undef FFT_MFMA
}
#define XB_TMO      128
#define XB_XCNT(j)  (256  + 64 * (j))
#define XB_XSUB(j)  (1280 + 64 * (j))
#define XB_XGEN(j)  (2304 + 64 * (j))
#define XB_TOP      3328
#define XB_TOPGEN   3392
#define XCD_BAR_WORDS 3456
#define XB_SPIN_CAP (1u << 18)

__device__ __forceinline__ unsigned xb_ld(unsigned* p)              { return __hip_atomic_load(p, __ATOMIC_RELAXED, __HIP_MEMORY_SCOPE_AGENT); }
__device__ __forceinline__ unsigned xb_add(unsigned* p, unsigned v) { return __hip_atomic_fetch_add(p, v, __ATOMIC_RELAXED, __HIP_MEMORY_SCOPE_AGENT); }
__device__ __forceinline__ unsigned xb_xcc_id() { return (unsigned)__builtin_amdgcn_s_getreg((3 << 11) | 20) & 0xFu; }
#define XB_SPIN(cond, bar) do { unsigned _sp = 0; while (cond) { __builtin_amdgcn_s_sleep(1); \
    if ((++_sp & 255u) == 0u) { if (xb_ld(&(bar)[XB_TMO])) break; if (_sp > XB_SPIN_CAP) { atomicAdd(&(bar)[XB_TMO], 1u); break; } } } } while (0)

struct XcdBarrier {
    unsigned* bar; unsigned x;
    volatile LAS unsigned* st;
};

__device__ __forceinline__ XcdBarrier xcd_barrier_post(unsigned* bar, volatile LAS unsigned* st) {
    XcdBarrier b; b.bar = bar; b.x = xb_xcc_id(); b.st = st;
    if (threadIdx.x == 0) (void)xb_add(&bar[XB_XCNT(b.x)], 1u);
    return b;
}
__device__ __forceinline__ void xcd_barrier_complete(unsigned* bar, unsigned x, unsigned& nloc, unsigned& nx) {
    const unsigned G = gridDim.x * gridDim.y * gridDim.z;
    unsigned sum, cnt, mine, sp = 0u;
    for (;;) {
        sum = 0u; cnt = 0u; mine = 0u;
#pragma unroll
        for (unsigned j = 0; j < 16; ++j) { const unsigned c = xb_ld(&bar[XB_XCNT(j)]); sum += c; cnt += (c > 0u) ? 1u : 0u; mine = (j == x) ? c : mine; }
        if (sum == G) break;
        __builtin_amdgcn_s_sleep(1);
        if ((++sp & 255u) == 0u) { if (xb_ld(&bar[XB_TMO])) break; if (sp > XB_SPIN_CAP) { atomicAdd(&bar[XB_TMO], 1u); break; } }
    }
    nloc = mine > 0u ? mine : 1u; nx = cnt > 0u ? cnt : 1u;
}

__device__ __forceinline__ void xcd_barrier(const XcdBarrier& b) {
    asm volatile("s_waitcnt vmcnt(0)" ::: "memory");
    __syncthreads();
    if (threadIdx.x == 0) {
        unsigned* bar = b.bar;
        __builtin_amdgcn_s_waitcnt(0);
        unsigned nloc = b.st[0], nx = b.st[1];
        if (nloc == 0u) { xcd_barrier_complete(bar, b.x, nloc, nx); b.st[0] = nloc; b.st[1] = nx; }
        const unsigned old = xb_add(&bar[XB_XSUB(b.x)], 1u);
        const unsigned gen = old / nloc;
        if (old + 1u == (gen + 1u) * nloc) {
            __builtin_amdgcn_fence(__ATOMIC_RELEASE, "agent");
            asm volatile("s_waitcnt vmcnt(0)" ::: "memory");
            const unsigned og = xb_add(&bar[XB_TOP], 1u);
            const unsigned tg = og / nx;
            if (og + 1u == (tg + 1u) * nx) xb_add(&bar[XB_TOPGEN], 1u);
            else XB_SPIN(xb_ld(&bar[XB_TOPGEN]) == tg, bar);
            __builtin_amdgcn_fence(__ATOMIC_ACQUIRE, "agent");
            xb_add(&bar[XB_XGEN(b.x)], 1u);
            asm volatile("s_waitcnt vmcnt(0)" ::: "memory");
        } else {
            XB_SPIN(xb_ld(&bar[XB_XGEN(b.x)]) == gen, bar);
            __builtin_amdgcn_fence(__ATOMIC_ACQUIRE, "agent");
            asm volatile("s_waitcnt vmcnt(0)" ::: "memory");
        }
    }
    __syncthreads();
}
constexpr int N_PHASES = 15;
struct Args { const float* in[24]; float* out; unsigned char* ws; int ph_lo, ph_hi; };
__global__ void __launch_bounds__(NWAVES * 64, 2) mk_fwd(Args args) {
    extern __shared__ __attribute__((aligned(16))) unsigned char lds[];
    Frame F;
    F.lds = (LAS unsigned char*)lds;
    F.tid = threadIdx.x; F.lane = F.tid & 63; F.wave = __builtin_amdgcn_readfirstlane(F.tid >> 6);
    F.G = gridDim.x; { const int bx = blockIdx.x; F.vcu = (F.G % 8 == 0) ? (bx % 8) * (F.G / 8) + bx / 8 : bx; }
#pragma unroll
    for (int i = 0; i < 24; ++i) F.in[i] = args.in[i];
    F.out = args.out; F.ws = args.ws;
    const int lo = args.ph_lo, hi = args.ph_hi;
    for (int u = F.tid; u < (LDS_BYTES - LDSCTL_OFF) / 4; u += NWAVES * 64) ((LAS unsigned*)(F.lds + LDSCTL_OFF))[u] = 0u;
    __syncthreads();
    XcdBarrier bar = xcd_barrier_post((unsigned*)(F.ws + WS_CTL) + CW_BAR, (volatile LAS unsigned*)(F.lds + MISC_OFF) + 8);
#define IN(k) (lo <= (k) && (k) < hi)
#define BOTH(k) (IN(k) && IN((k) + 1))
#define GRID_BAR() xcd_barrier(bar)
#define GRID_BAR_CG() do { cooperative_groups::this_grid().sync(); } while (0)
    bf16* const HB16 = wsp<bf16>(F, WS_HB16); bf16* const HH = wsp<bf16>(F, WS_R1);
    bf16* const QO = wsp<bf16>(F, WS_QO); bf16* const UU = wsp<bf16>(F, WS_U); bf16* const KR = wsp<bf16>(F, WS_KR); bf16* const VR = wsp<bf16>(F, WS_VR); bf16* const FB = wsp<bf16>(F, WS_F);
    bf16* const GFB = wsp<bf16>(F, WS_GF); bf16* const GAB = wsp<bf16>(F, WS_GA); bf16* const QC = wsp<bf16>(F, WS_QC); bf16* const OC = wsp<bf16>(F, WS_OC);
    float* const SS2 = wsp<float>(F, WS_SS2); float* const SS3 = wsp<float>(F, WS_SS3); float* const SS4 = wsp<float>(F, WS_SS4);

    if (IN(0)) { p0_prologue(F); if (BOTH(0)) GRID_BAR_CG(); }
    if (IN(1)) {
        pg8::Gemm g{HB16, wsp<bf16>(F, WS_W1GU), M, 2 * FF, D}; pg8::StaticOrder S; S.init(M, 2 * FF, F.G, (int)blockIdx.x);
        pg8::EpiSwiGLU E{HH, FF, wsp<float>(F, WS_RS1), 0};
        pg8::gemm_phase<pg8::EpiSwiGLU, pg8::StaticOrder, true, true>(F.lds, g, S, E);
        if (BOTH(1)) GRID_BAR();
    }
    if (IN(2)) {
        pg8::Gemm g{HH, wsp<bf16>(F, WS_W1D), M, D, FF}; pg8::StaticOrder S; S.init(M, D, F.G, (int)blockIdx.x);
        pg8::EpiResid E{F.in[0], F.out, HB16, SS2, 0.5f, D};
        pg8::gemm_phase<pg8::EpiResid, pg8::StaticOrder, true, true>(F.lds, g, S, E);
        if (BOTH(2)) GRID_BAR();
    }
    if (IN(3)) {
        pg8::Gemm g{HB16, wsp<bf16>(F, WS_WIN), M, NIN, D}; pg8::StaticOrder S; S.init(M, NIN, F.G, (int)blockIdx.x);
        pg8::EpiRoute E{{QO, KR, VR, FB, GFB, GAB}, SS2, 1, 1, 0, 1.0f};
        pg8::gemm_phase<pg8::EpiRoute, pg8::StaticOrder, true, true>(F.lds, g, S, E);
        if (BOTH(3)) GRID_BAR();
    }
    if (IN(4)) {
#if defined(PREP_SIMPLE)
        p_prep_qk(F);
#else
        p_prep_qk2(F);
#endif
#if defined(FFT_SIMPLE) || defined(FFTA_SIMPLE)
        p_fftA_simple(F);
#else
        fftm::stageA(F);
#endif
        if (BOTH(4)) GRID_BAR(); }
    if (IN(5)) {
#if defined(FFT_SIMPLE) || defined(FFTB_SIMPLE)
        p_fftB_simple(F);
#else
        fftm::stageB(F);
#endif
        if (BOTH(5)) GRID_BAR(); }
    if (IN(6)) {
#if defined(ATTN_SIMPLE)
        p_attn_simple(F);
#else
        static_assert(attn_body::ATTN_LDS_BYTES <= RING_BYTES, "attention LDS");
        const attn_body::AttnTensors AT{(const attn_body::bf16*)QO, (const attn_body::bf16*)KR, (const attn_body::bf16*)VR, (attn_body::bf16*)QO};
        const attn_body::StaticOrder S((int)F.G, (int)blockIdx.x);
        attn_body::attn_phase<attn_body::StaticOrder, 1024, 256, 16384, 4>((char*)lds, AT, S);
#endif
        if (BOTH(6)) GRID_BAR();
    }
    if (IN(7)) {
        { pg8::Gemm g{UU, wsp<bf16>(F, WS_WFB), M, D, D}; pg8::StaticOrder S; S.init(M, D, F.G, (int)blockIdx.x);
          pg8::EpiGate E{GFB, nullptr, 1};
          pg8::gemm_phase<pg8::EpiGate, pg8::StaticOrder, true, true>(F.lds, g, S, E); }
        { pg8::Gemm g{QO, wsp<bf16>(F, WS_WAB), M, D, D}; pg8::StaticOrder S; S.init(M, D, F.G, (int)blockIdx.x);
          pg8::EpiGate E{GAB, GFB, 2};
          pg8::gemm_phase<pg8::EpiGate, pg8::StaticOrder, true, true>(F.lds, g, S, E); }
        if (BOTH(7)) GRID_BAR();
    }
    if (IN(8)) {
        pg8::Gemm g{GAB, wsp<bf16>(F, WS_WOUT), M, D, D}; pg8::StaticOrder S; S.init(M, D, F.G, (int)blockIdx.x);
        pg8::EpiResid E{F.out, F.out, HB16, SS3, 1.0f, D};
        pg8::gemm_phase<pg8::EpiResid, pg8::StaticOrder, true, true>(F.lds, g, S, E);
        if (BOTH(8)) GRID_BAR();
    }
    if (IN(9)) {
        pg8::Gemm g{HB16, wsp<bf16>(F, WS_WCQ), M, 256, D}; pg8::StaticOrder S; S.init(M, 256, F.G, (int)blockIdx.x);
        #if defined(CROSS_SIMPLE)
        pg8::EpiRoute E{{QC, nullptr, nullptr, nullptr, nullptr, nullptr}, SS3, 1, 0, 256, 1.0f};
#else
        pg8::EpiRoute E{{QC, nullptr, nullptr, nullptr, nullptr, nullptr}, SS3, 1, 0, 256, C2Q};
#endif
        pg8::gemm_phase<pg8::EpiRoute, pg8::StaticOrder, true, true>(F.lds, g, S, E);
        if (BOTH(9)) GRID_BAR();
    }
    if (IN(10)) {
#if defined(CROSS_SIMPLE)
        p_cross_simple(F);
#else
        const attn_body::AttnTensors AT{(const attn_body::bf16*)QC, (const attn_body::bf16*)wsp<bf16>(F, WS_KC), (const attn_body::bf16*)wsp<bf16>(F, WS_VC), (attn_body::bf16*)OC};
        const attn_body::CrossOrder S((int)F.G, (int)blockIdx.x);
        attn_body::attn_phase<attn_body::CrossOrder, 256, 256, 256, 1>((char*)lds, AT, S);
#endif
        if (BOTH(10)) GRID_BAR();
    }
    if (IN(11)) {
        pg8::Gemm g{OC, wsp<bf16>(F, WS_WCO), M, D, 256}; pg8::StaticOrder S; S.init(M, D, F.G, (int)blockIdx.x);
        pg8::EpiResid E{F.out, F.out, HB16, SS4, 1.0f, D};
        pg8::gemm_phase<pg8::EpiResid, pg8::StaticOrder, true, true>(F.lds, g, S, E);
        if (BOTH(11)) GRID_BAR();
    }
    if (IN(12)) {
        pg8::Gemm g{HB16, wsp<bf16>(F, WS_W2GU), M, 2 * FF, D}; pg8::StaticOrder S; S.init(M, 2 * FF, F.G, (int)blockIdx.x);
        pg8::EpiSwiGLU E{HH, FF, SS4, 1};
        pg8::gemm_phase<pg8::EpiSwiGLU, pg8::StaticOrder, true, true>(F.lds, g, S, E);
        if (BOTH(12)) GRID_BAR();
    }
    if (IN(13)) {
        pg8::Gemm g{HH, wsp<bf16>(F, WS_W2D), M, D, FF}; pg8::StaticOrder S; S.init(M, D, F.G, (int)blockIdx.x);
        pg8::EpiResid E{F.out, F.out, nullptr, nullptr, 0.5f, D};
        pg8::gemm_phase<pg8::EpiResid, pg8::StaticOrder, true, true>(F.lds, g, S, E);
        if (BOTH(13)) GRID_BAR();
    }
    if (IN(14)) { p_final(F); }
#undef IN
#undef BOTH
}

extern "C" void kernel_launch(void* const* d_in, const int* in_sizes, int n_in, void* d_out, int out_size, void* d_ws, size_t ws_size, hipStream_t stream) {
    static int grid = 0;
    if (grid == 0) {
        if (n_in != 24 || in_sizes[0] != M * D || out_size != M * D || ws_size < WS_END) {
            fprintf(stderr, "kernel_launch: unexpected shapes: n_in %d in0 %d out %d ws %zu (need %zu)\n", n_in, n_in > 0 ? in_sizes[0] : -1, out_size, ws_size, (size_t)WS_END); grid = -1; return; }
        int dev = 0, cus = 0, per_cu = 0;
        if (hipGetDevice(&dev) != hipSuccess || hipDeviceGetAttribute(&cus, hipDeviceAttributeMultiprocessorCount, dev) != hipSuccess) { grid = -1; return; }
        if (hipFuncSetAttribute((const void*)mk_fwd, hipFuncAttributeMaxDynamicSharedMemorySize, LDS_BYTES) != hipSuccess) { fprintf(stderr, "kernel_launch: hipFuncSetAttribute failed\n"); grid = -1; return; }
        if (hipOccupancyMaxActiveBlocksPerMultiprocessor(&per_cu, (const void*)mk_fwd, NWAVES * 64, LDS_BYTES) != hipSuccess || per_cu < 1) { fprintf(stderr, "kernel_launch: occupancy query says %d\n", per_cu); }
        (void)hipGetLastError();
        grid = cus * (per_cu < 1 ? 1 : 1);
        if (per_cu < 1) { grid = -1; return; }
        if (grid != 256) fprintf(stderr, "kernel_launch: %d CUs (built for 256)\n", grid);
    }
    if (grid < 0) return;
    (void)hipMemsetAsync((char*)d_ws + WS_CTL, 0, CTL_ZERO_BYTES, stream);
    Args a{};
    for (int i = 0; i < 24; ++i) a.in[i] = (const float*)d_in[i];
    a.out = (float*)d_out; a.ws = (unsigned char*)d_ws;
#if defined(MK_MULTI)
    for (int ph = 0; ph < N_PHASES; ++ph) {
        a.ph_lo = ph; a.ph_hi = ph + 1;
        hipLaunchKernelGGL(mk_fwd, dim3(grid), dim3(NWAVES * 64), LDS_BYTES, stream, a);
    }
#else
    a.ph_lo = 0; a.ph_hi = N_PHASES;
    void* kargs[] = {&a};
    const hipError_t e = hipLaunchCooperativeKernel((const void*)mk_fwd, dim3(grid), dim3(NWAVES * 64), kargs, LDS_BYTES, stream);
    if (e != hipSuccess) fprintf(stderr, "kernel_launch: cooperative launch failed: %s (grid %d)\n", hipGetErrorString(e), grid);
#endif
}
```

```cpp
#include <hip/hip_runtime.h>
#include <hip/hip_cooperative_groups.h>
#include <cstdio>
#include <cstdint>
namespace pg8 {
#define PG8_LAS __attribute__((address_space(3)))
typedef unsigned short bf16_t;
typedef short bf16x8 __attribute__((ext_vector_type(8)));
typedef float f32x4 __attribute__((ext_vector_type(4)));
typedef unsigned u32x4 __attribute__((ext_vector_type(4)));
constexpr int BM = 256, BK = 64, HALF = 128, HTB = HALF * BK * 2  , STAGE_BYTES = 8 * HTB, NXCD = 8, WGM = 8;

__host__ __device__ __forceinline__ int lds_byte(int r, int c) { const int st = (r >> 4) * 2 + (c >> 5), rr = r & 15, cc = c & 31, ob = rr * 64 + cc * 2; return st * 1024 + (ob ^ (((ob >> 9) & 1) << 5)); }
__host__ __device__ __forceinline__ void stage_rc(int b, int& R, int& C) { const int st = b / 1024, sb = b % 1024, swz = sb ^ (((sb >> 9) & 1) << 5); R = (st >> 1) * 16 + swz / 64; C = (st & 1) * 32 + (swz % 64) / 2; }
__host__ __device__ __forceinline__ int perm32(int rho) { const int n = rho >> 4, i = rho & 15; return 8 * (i >> 2) + 4 * n + (i & 3); }

struct Unit { int pm, pn; };
struct Gemm { const bf16_t* A; const bf16_t* Bt; int M, N, K; };

struct StaticOrder {
    int nM, nN, nwg, G, c;
    __host__ __device__ void init(int M, int N, int G_, int c_) { nM = M / BM; nN = N / BM; nwg = nM * nN; G = G_; c = c_; }
    __host__ __device__ bool next(int i, Unit& u) const {
        const long L = (long)i * G + c; if (L >= nwg) return false;
        int wgid = (int)L; { const int q = nwg / NXCD, r = nwg % NXCD, xcd = wgid % NXCD, off = wgid / NXCD; wgid = (xcd < r ? xcd * (q + 1) : r * (q + 1) + (xcd - r) * q) + off; }
        const int nig = WGM * nN, gid = wgid / nig, fm = gid * WGM, gsz = (nM - fm) < WGM ? (nM - fm) : WGM;
        u.pm = fm + ((wgid % nig) % gsz); u.pn = (wgid % nig) / gsz; return true;
    }
    __device__ __forceinline__ void a_ready(const Unit&) const {}
    __device__ __forceinline__ void done(const Unit&) const {}
};

typedef float f32x2_cv __attribute__((ext_vector_type(2))); typedef __bf16 bf16x2_cv __attribute__((ext_vector_type(2)));
__device__ __forceinline__ unsigned cvt_pk_bf16(float lo, float hi) { f32x2_cv v = {lo, hi}; bf16x2_cv b = __builtin_convertvector(v, bf16x2_cv); return __builtin_bit_cast(unsigned, b); }
__device__ __forceinline__ float bflo(unsigned u) { return __uint_as_float(u << 16); }
__device__ __forceinline__ float bfhi(unsigned u) { return __uint_as_float(u & 0xffff0000u); }
__device__ __forceinline__ float sigmoid_f(float x) { return __builtin_amdgcn_rcpf(1.0f + __builtin_amdgcn_exp2f(-1.4426950408889634f * x)); }
__device__ __forceinline__ u32x4 pack8(const f32x4 a, const f32x4 b) { u32x4 w; w.x = cvt_pk_bf16(a[0], a[1]); w.y = cvt_pk_bf16(a[2], a[3]); w.z = cvt_pk_bf16(b[0], b[1]); w.w = cvt_pk_bf16(b[2], b[3]); return w; }
constexpr float RMS_EPS = 1e-6f;
__device__ __forceinline__ float rowscale(const float* p, int row, int mode) { const float v = p[row]; return mode ? __builtin_amdgcn_rsqf(v * (1.0f / 1024.0f) + RMS_EPS) : v; }

struct EpiSwiGLU {
    static constexpr bool PERM = true, AFTER_DRAIN = false;
    bf16_t* H; int ldh; const float* rs; int rs_mode;
    __device__ __forceinline__ void operator()(const f32x4 (&acc)[2][2][4][2], const Unit& u, int wr, int wc, int fr, int fq) const {
        const int row0 = u.pm * BM + wr * 64 + fr, col0 = u.pn * HALF + wc * 32 + 8 * fq;
#pragma unroll
        for (int ai = 0; ai < 2; ++ai)
#pragma unroll
            for (int m = 0; m < 4; ++m) {
                const int row = row0 + ai * HALF + m * 16; const float r = rowscale(rs, row, rs_mode);
                f32x4 o[2];
#pragma unroll
                for (int n = 0; n < 2; ++n) {
                    const f32x4 g = acc[ai][0][m][n] * r, up = acc[ai][1][m][n] * r;
#pragma unroll
                    for (int j = 0; j < 4; ++j) o[n][j] = g[j] * sigmoid_f(g[j]) * up[j];
                }
                *(u32x4*)(H + (size_t)row * ldh + col0) = pack8(o[0], o[1]);
            }
    }
};
struct EpiResid {
    static constexpr bool PERM = true, AFTER_DRAIN = false;
    const float* base; float* out; bf16_t* ob; float* ss; float scale; int ldc;
    __device__ __forceinline__ void operator()(const f32x4 (&acc)[2][2][4][2], const Unit& u, int wr, int wc, int fr, int fq) const {
        const int row0 = u.pm * BM + wr * 64 + fr, col0 = u.pn * BM + wc * 32 + 8 * fq;
#pragma unroll
        for (int ai = 0; ai < 2; ++ai)
#pragma unroll
            for (int m = 0; m < 4; ++m) {
                const int row = row0 + ai * HALF + m * 16; float s = 0.f;
#pragma unroll
                for (int bj = 0; bj < 2; ++bj) {
                    const size_t off = (size_t)row * ldc + col0 + bj * HALF;
                    const f32x4 b0 = *(const f32x4*)(base + off), b1 = *(const f32x4*)(base + off + 4);
                    const f32x4 o0 = b0 + acc[ai][bj][m][0] * scale, o1 = b1 + acc[ai][bj][m][1] * scale;
                    *(f32x4*)(out + off) = o0; *(f32x4*)(out + off + 4) = o1;
                    if (ob) *(u32x4*)(ob + off) = pack8(o0, o1);
                    s += (o0[0] * o0[0] + o0[1] * o0[1]) + (o0[2] * o0[2] + o0[3] * o0[3]) + (o1[0] * o1[0] + o1[1] * o1[1]) + (o1[2] * o1[2] + o1[3] * o1[3]);
                }
                if (ss) { s += __shfl_xor(s, 16); s += __shfl_xor(s, 32); if (fq == 0) atomicAdd(ss + row, s); }
            }
    }
};
struct EpiRoute {
    static constexpr bool PERM = true, AFTER_DRAIN = false;
    bf16_t* dst[6]; const float* rs; int rs_mode; int is_win;
    int ld0; float post;
    __device__ __forceinline__ void operator()(const f32x4 (&acc)[2][2][4][2], const Unit& u, int wr, int wc, int fr, int fq) const {
        const int pn = u.pn; bf16_t* bp; int ldc, colt;
        if (!is_win) { bp = dst[0]; ldc = ld0; colt = pn * BM; }
        else if (pn < 4) { bp = dst[0]; ldc = 1024; colt = pn * BM; }
        else if (pn == 4) { bp = dst[1]; ldc = 256; colt = 0; }
        else if (pn == 5) { bp = dst[2]; ldc = 256; colt = 0; }
        else if (pn < 8) { bp = dst[3]; ldc = 512; colt = (pn - 6) * BM; }
        else if (pn < 12) { bp = dst[4]; ldc = 1024; colt = (pn - 8) * BM; }
        else { bp = dst[5]; ldc = 1024; colt = (pn - 12) * BM; }
        const int row0 = u.pm * BM + wr * 64 + fr, col0 = colt + wc * 32 + 8 * fq;
#pragma unroll
        for (int ai = 0; ai < 2; ++ai)
#pragma unroll
            for (int m = 0; m < 4; ++m) {
                const int row = row0 + ai * HALF + m * 16; const float r = rowscale(rs, row, rs_mode) * post;
#pragma unroll
                for (int bj = 0; bj < 2; ++bj)
                    *(u32x4*)(bp + (size_t)row * ldc + col0 + bj * HALF) = pack8(acc[ai][bj][m][0] * r, acc[ai][bj][m][1] * r);
            }
    }
};
struct EpiGate {
    static constexpr bool PERM = true, AFTER_DRAIN = false;
    bf16_t* G; const bf16_t* T; int mode;
    __device__ __forceinline__ void operator()(const f32x4 (&acc)[2][2][4][2], const Unit& u, int wr, int wc, int fr, int fq) const {
        const int row0 = u.pm * BM + wr * 64 + fr, col0 = u.pn * BM + wc * 32 + 8 * fq;
#pragma unroll
        for (int ai = 0; ai < 2; ++ai)
#pragma unroll
            for (int m = 0; m < 4; ++m) {
                const int row = row0 + ai * HALF + m * 16;
#pragma unroll
                for (int bj = 0; bj < 2; ++bj) {
                    const size_t off = (size_t)row * 1024 + col0 + bj * HALF;
                    const u32x4 gv = *(const u32x4*)(G + off);
                    f32x4 g0 = {bflo(gv.x), bfhi(gv.x), bflo(gv.y), bfhi(gv.y)}, g1 = {bflo(gv.z), bfhi(gv.z), bflo(gv.w), bfhi(gv.w)};
                    f32x4 o0, o1;
#pragma unroll
                    for (int j = 0; j < 4; ++j) { o0[j] = sigmoid_f(g0[j]) * acc[ai][bj][m][0][j]; o1[j] = sigmoid_f(g1[j]) * acc[ai][bj][m][1][j]; }
                    if (mode == 2) { const u32x4 tv = *(const u32x4*)(T + off);
                        o0 += (f32x4){bflo(tv.x), bfhi(tv.x), bflo(tv.y), bfhi(tv.y)}; o1 += (f32x4){bflo(tv.z), bfhi(tv.z), bflo(tv.w), bfhi(tv.w)}; }
                    *(u32x4*)(G + off) = pack8(o0, o1);
                }
            }
    }
};
template <class Epi, class Sched, bool ALIGN_EPI = false, bool SP2 = false>
__device__ __forceinline__ void gemm_phase(PG8_LAS unsigned char* lds, const Gemm g, const Sched& S, const Epi& E) {
    const int tid = threadIdx.x, wid = __builtin_amdgcn_readfirstlane(tid >> 6), lane = tid & 63, wr = wid >> 2, wc = wid & 3, fr = lane & 15, fq = lane >> 4;
    const int K = g.K, nt = K / BK;
    unsigned voffA[2], voffB[2];
#pragma unroll
    for (int i = 0; i < 2; ++i) { int R, C; stage_rc(tid * 16 + i * 8192, R, C); const int Rb = Epi::PERM ? ((R & ~31) + perm32(R & 31)) : R;
        voffA[i] = (unsigned)(R * K + C) * 2u; voffB[i] = (unsigned)(Rb * K + C) * 2u; }
    const size_t kstep = (size_t)(BK * 2);
    const size_t hstep = (size_t)HALF * K * 2;
    const size_t tstep = 2 * hstep;
    const unsigned ldsw = (unsigned)wid * 1024u;
    const int aoff = lds_byte(wr * 64 + fr, fq * 8), boff = lds_byte(wc * 32 + fr, fq * 8);
#define PG8_SA(b, h) (((b) * 2 + (h)) * HTB)
#define PG8_SB(b, h) ((4 + (b) * 2 + (h)) * HTB)
#define PG8_STAGE(bufoff, gbase, voff) do { _Pragma("unroll") for (int _i = 0; _i < 2; ++_i) \
        __builtin_amdgcn_global_load_lds((const unsigned*)((const char*)(gbase) + (voff)[_i]), (PG8_LAS unsigned*)(lds + (bufoff) + ldsw + _i * 8192), 16, 0, 0); } while (0)
#define PG8_LDA(dst, b, h) do { _Pragma("unroll") for (int m = 0; m < 4; ++m) _Pragma("unroll") for (int k = 0; k < 2; ++k) dst[m][k] = *(const PG8_LAS bf16x8*)(lds + PG8_SA(b, h) + aoff + m * 2048 + k * 1024); } while (0)
#define PG8_LDB(dst, b, h) do { _Pragma("unroll") for (int n = 0; n < 2; ++n) _Pragma("unroll") for (int k = 0; k < 2; ++k) dst[n][k] = *(const PG8_LAS bf16x8*)(lds + PG8_SB(b, h) + boff + n * 2048 + k * 1024); } while (0)
#define PG8_MMA(ai, bj, At, Bt) do { __builtin_amdgcn_s_setprio(1); _Pragma("unroll") for (int m = 0; m < 4; ++m) _Pragma("unroll") for (int n = 0; n < 2; ++n) _Pragma("unroll") for (int k = 0; k < 2; ++k) \
        acc[ai][bj][m][n] = __builtin_amdgcn_mfma_f32_16x16x32_bf16(Bt[n][k], At[m][k], acc[ai][bj][m][n], 0, 0, 0); __builtin_amdgcn_s_setprio(0); } while (0)
#define PG8_WAIT_V(n) asm volatile("s_waitcnt vmcnt(" #n ")" ::: "memory")
#define PG8_WAIT_L(n) asm volatile("s_waitcnt lgkmcnt(" #n ")" ::: "memory")
#define PG8_BAR __builtin_amdgcn_s_barrier()
#define PG8_SCHED __builtin_amdgcn_sched_barrier(0)
    Unit cur, nxt; int ui = 0;
    if (!S.next(0, cur)) return;
    f32x4 acc[2][2][4][2];
#pragma unroll
    for (int a = 0; a < 2; ++a)
#pragma unroll
        for (int b = 0; b < 2; ++b)
#pragma unroll
            for (int m = 0; m < 4; ++m)
#pragma unroll
                for (int n = 0; n < 2; ++n) acc[a][b][m][n] = (f32x4){0.f, 0.f, 0.f, 0.f};
    bf16x8 At[4][2], B0[2][2], B1[2][2];
    const char* cA = (const char*)g.A + (size_t)cur.pm * tstep; const char* cB = (const char*)g.Bt + (size_t)cur.pn * tstep;
    S.a_ready(cur);
    if constexpr (SP2) {
        PG8_STAGE(PG8_SB(0, 0), cB, voffB); PG8_STAGE(PG8_SB(0, 1), cB + hstep, voffB); PG8_STAGE(PG8_SA(0, 0), cA, voffA); PG8_STAGE(PG8_SA(0, 1), cA + hstep, voffA);
        if (wr == 1) PG8_BAR;
        PG8_WAIT_V(2); PG8_BAR;
        PG8_STAGE(PG8_SB(1, 0), cB + kstep, voffB); PG8_STAGE(PG8_SA(1, 0), cA + kstep, voffA); PG8_STAGE(PG8_SB(1, 1), cB + hstep + kstep, voffB);
        PG8_WAIT_V(6); PG8_BAR;
    } else {
        PG8_STAGE(PG8_SB(0, 0), cB, voffB); PG8_STAGE(PG8_SA(0, 0), cA, voffA); PG8_STAGE(PG8_SB(0, 1), cB + hstep, voffB); PG8_STAGE(PG8_SA(0, 1), cA + hstep, voffA);
        if (wr == 1) PG8_BAR;
        PG8_WAIT_V(4); PG8_BAR;
        PG8_STAGE(PG8_SB(1, 0), cB + kstep, voffB); PG8_STAGE(PG8_SA(1, 0), cA + kstep, voffA); PG8_STAGE(PG8_SB(1, 1), cB + hstep + kstep, voffB);
        PG8_WAIT_V(6); PG8_BAR;
    }
    for (;;) {
        const bool has_next = S.next(ui + 1, nxt);
        const char* nA = has_next ? (const char*)g.A + (size_t)nxt.pm * tstep : cA; const char* nB = has_next ? (const char*)g.Bt + (size_t)nxt.pn * tstep : cB;
        for (int t = 0; t < nt; t += 2) {
            const bool last = (t == nt - 2);
            const char* a1 = cA + (size_t)(t + 1) * kstep;
            const char* a2 = last ? nA : cA + (size_t)(t + 2) * kstep; const char* b2 = last ? nB : cB + (size_t)(t + 2) * kstep;
            const char* a3 = a2 + kstep; const char* b3 = b2 + kstep;
            if (last && has_next) S.a_ready(nxt);
            if constexpr (SP2) {
            PG8_LDB(B0, 0, 0); PG8_LDB(B1, 0, 1); PG8_SCHED; PG8_LDA(At, 0, 0); PG8_STAGE(PG8_SA(1, 1), a1 + hstep, voffA);
            PG8_WAIT_V(8); PG8_WAIT_L(0); PG8_BAR; PG8_MMA(0, 0, At, B0); PG8_MMA(0, 1, At, B1); PG8_BAR; PG8_SCHED;
            PG8_LDA(At, 0, 1); PG8_STAGE(PG8_SB(0, 0), b2, voffB); PG8_STAGE(PG8_SB(0, 1), b2 + hstep, voffB); PG8_STAGE(PG8_SA(0, 0), a2, voffA);
            PG8_WAIT_V(8); PG8_WAIT_L(0); PG8_BAR; PG8_MMA(1, 0, At, B0); PG8_MMA(1, 1, At, B1); PG8_BAR; PG8_SCHED;
            PG8_LDB(B0, 1, 0); PG8_LDB(B1, 1, 1); PG8_SCHED; PG8_LDA(At, 1, 0); PG8_STAGE(PG8_SA(0, 1), a2 + hstep, voffA);
            PG8_WAIT_V(8); PG8_WAIT_L(0); PG8_BAR; PG8_MMA(0, 0, At, B0); PG8_MMA(0, 1, At, B1); PG8_BAR; PG8_SCHED;
            PG8_LDA(At, 1, 1); PG8_STAGE(PG8_SB(1, 0), b3, voffB); PG8_STAGE(PG8_SB(1, 1), b3 + hstep, voffB); PG8_STAGE(PG8_SA(1, 0), a3, voffA);
            PG8_WAIT_V(8); PG8_WAIT_L(0); PG8_BAR; PG8_MMA(1, 0, At, B0); PG8_MMA(1, 1, At, B1); PG8_BAR; PG8_SCHED;
            } else {
            PG8_LDB(B0, 0, 0); PG8_SCHED; PG8_LDA(At, 0, 0); PG8_STAGE(PG8_SA(1, 1), a1 + hstep, voffA);
            PG8_WAIT_L(8); PG8_BAR; PG8_WAIT_L(0); PG8_MMA(0, 0, At, B0); PG8_BAR; PG8_SCHED;
            PG8_LDB(B1, 0, 1); PG8_STAGE(PG8_SB(0, 0), b2, voffB);
            PG8_BAR; PG8_WAIT_L(0); PG8_MMA(0, 1, At, B1); PG8_BAR;
            PG8_LDA(At, 0, 1); PG8_STAGE(PG8_SA(0, 0), a2, voffA);
            PG8_BAR; PG8_WAIT_L(0); PG8_MMA(1, 0, At, B0); PG8_BAR; PG8_SCHED;
            PG8_STAGE(PG8_SB(0, 1), b2 + hstep, voffB);
            PG8_WAIT_V(6); PG8_BAR; PG8_MMA(1, 1, At, B1); PG8_BAR;
            PG8_LDB(B0, 1, 0); PG8_SCHED; PG8_LDA(At, 1, 0); PG8_STAGE(PG8_SA(0, 1), a2 + hstep, voffA);
            PG8_WAIT_L(8); PG8_BAR; PG8_WAIT_L(0); PG8_MMA(0, 0, At, B0); PG8_BAR; PG8_SCHED;
            PG8_LDB(B1, 1, 1); PG8_STAGE(PG8_SB(1, 0), b3, voffB);
            PG8_BAR; PG8_WAIT_L(0); PG8_MMA(0, 1, At, B1); PG8_BAR;
            PG8_LDA(At, 1, 1); PG8_STAGE(PG8_SA(1, 0), a3, voffA);
            PG8_BAR; PG8_WAIT_L(0); PG8_MMA(1, 0, At, B0); PG8_BAR; PG8_SCHED;
            PG8_STAGE(PG8_SB(1, 1), b3 + hstep, voffB);
            PG8_WAIT_V(6); PG8_BAR; PG8_MMA(1, 1, At, B1); PG8_BAR;
            }
        }
        if constexpr (ALIGN_EPI) { if (wr == 0) PG8_BAR; }
        if constexpr (!Epi::AFTER_DRAIN) { E(acc, cur, wr, wc, fr, fq); S.done(cur); }
        if (!has_next) break;
#pragma unroll
        for (int a = 0; a < 2; ++a)
#pragma unroll
            for (int b = 0; b < 2; ++b)
#pragma unroll
                for (int m = 0; m < 4; ++m)
#pragma unroll
                    for (int n = 0; n < 2; ++n) acc[a][b][m][n] = (f32x4){0.f, 0.f, 0.f, 0.f};
        cur = nxt; cA = nA; cB = nB; ++ui;
        if constexpr (ALIGN_EPI) { if (wr == 1) PG8_BAR; }
    }
    PG8_WAIT_V(0);
    if constexpr (!ALIGN_EPI) { if (wr == 0) PG8_BAR; }
    PG8_BAR;
    if constexpr (Epi::AFTER_DRAIN) { E.fused(acc, cur, wr, wc, fr, fq, lds, wid, lane); S.done(cur); }
#undef PG8_SA
#undef PG8_SB
#undef PG8_STAGE
#undef PG8_LDA
#undef PG8_LDB
#undef PG8_MMA
#undef PG8_WAIT_V
#undef PG8_WAIT_L
#undef PG8_BAR
#undef PG8_SCHED
}
}
#include <hip/hip_bf16.h>
#include <cmath>
namespace attn_body {
using bf16=__hip_bfloat16;
using bf16x8=__attribute__((ext_vector_type(8)))short;
using s16x4=__attribute__((ext_vector_type(4)))short;
using f32x16=__attribute__((ext_vector_type(16)))float;
using u32x4=__attribute__((ext_vector_type(4)))unsigned;
constexpr int BATCH=1,NHEAD=16,SEQ=16384,D=64,DM=NHEAD*D,KVP=256,GQA=4;
constexpr int NW=8,QBLK=32,QB=QBLK*NW,KVBLK=64,NQB=SEQ/QB;
constexpr int ATTN_PITCH=DM, ATTN_UNIT_ROWS=QB;
__device__ __forceinline__ int crow(int r,int hi){return (r&3)+8*(r>>2)+4*hi;}
#define SBAR() __builtin_amdgcn_sched_barrier(0)
__device__ __forceinline__ void cmask(f32x16&p0,f32x16&p1,int jb,int qrel,int hi){
  const float NEG=-INFINITY; int kb=64*jb+4*hi;
  #pragma unroll
  for(int r=0;r<16;++r){int kv=kb+(r&3)+8*(r>>2); if(kv>qrel)p0[r]=NEG; if(kv+32>qrel)p1[r]=NEG;}
}

constexpr int NSLOT=3, SLOTB=8192;
constexpr int LDS_K=0, LDS_V=NSLOT*SLOTB, LDS_WS=2*NSLOT*SLOTB, LDS_OST=LDS_WS+NW*64*4, LDS_BYTES=LDS_OST+NW*4096;
constexpr float C2=0.125f*1.4426950408889634f;
__device__ __forceinline__ void glds16(const void*gsrc,unsigned lds_dst){unsigned keep;
  asm volatile("s_mov_b32 %0, m0\n\ts_mov_b32 m0, %2\n\ts_nop 0\n\tglobal_load_lds_dwordx4 %1, off\n\ts_mov_b32 m0, %0":"=&s"(keep):"v"(gsrc),"s"(lds_dst):"memory");}
__device__ __forceinline__ float max3f(float a,float b,float c){float r;asm("v_max3_f32 %0, %1, %2, %3":"=v"(r):"v"(a),"v"(b),"v"(c));return r;}
__device__ __forceinline__ float max2f(float a,float b){float r;asm("v_max_f32_e32 %0, %1, %2":"=v"(r):"v"(a),"v"(b));return r;}
__device__ __forceinline__ float fadd_s(float a,float b){float r;asm("v_add_f32_e32 %0, %1, %2":"=v"(r):"v"(a),"v"(b));return r;}
__device__ __forceinline__ float fsub_s(float a,float b){float r;asm("v_sub_f32_e32 %0, %1, %2":"=v"(r):"v"(a),"v"(b));return r;}
typedef float f32x2_t __attribute__((ext_vector_type(2))); typedef __bf16 bf16x2_t __attribute__((ext_vector_type(2)));
__device__ __forceinline__ unsigned cvtpk_s(float lo,float hi){f32x2_t v={lo,hi};bf16x2_t b=__builtin_convertvector(v,bf16x2_t);return __builtin_bit_cast(unsigned,b);}
#define WAIT_BAR(N) asm volatile("s_waitcnt vmcnt(" #N ") lgkmcnt(0)\n\ts_barrier":::"memory")

__device__ __forceinline__ void qkt(f32x16&p0,f32x16&p1,const char*Kslot,const bf16x8*qr,const f32x16&negm,int r32,int hi){
  const char*kb=Kslot+hi*1024+r32*16;
  #pragma unroll
  for(int d0=0;d0<4;++d0){
    const bf16x8 b0=*reinterpret_cast<const bf16x8*>(kb+d0*2048);
    const bf16x8 b1=*reinterpret_cast<const bf16x8*>(kb+d0*2048+512);
    if(d0==0){p0=__builtin_amdgcn_mfma_f32_32x32x16_bf16(b0,qr[0],negm,0,0,0);p1=__builtin_amdgcn_mfma_f32_32x32x16_bf16(b1,qr[0],negm,0,0,0);}
    else{p0=__builtin_amdgcn_mfma_f32_32x32x16_bf16(b0,qr[d0],p0,0,0,0);p1=__builtin_amdgcn_mfma_f32_32x32x16_bf16(b1,qr[d0],p1,0,0,0);}}
}
typedef __attribute__((address_space(3))) const char* lds_cptr;
typedef short v4i16_t __attribute__((ext_vector_type(4)));
__device__ __forceinline__ void kload8(bf16x8*kf,lds_cptr kp){
  kf[0]=*(const __attribute__((address_space(3))) bf16x8*)(kp);      kf[1]=*(const __attribute__((address_space(3))) bf16x8*)(kp+512);
  kf[2]=*(const __attribute__((address_space(3))) bf16x8*)(kp+2048); kf[3]=*(const __attribute__((address_space(3))) bf16x8*)(kp+2560);
  kf[4]=*(const __attribute__((address_space(3))) bf16x8*)(kp+4096); kf[5]=*(const __attribute__((address_space(3))) bf16x8*)(kp+4608);
  kf[6]=*(const __attribute__((address_space(3))) bf16x8*)(kp+6144); kf[7]=*(const __attribute__((address_space(3))) bf16x8*)(kp+6656);
}
__device__ __forceinline__ void kload2(bf16x8*kf,lds_cptr kp,int j){ kf[2*j]=*(const __attribute__((address_space(3))) bf16x8*)(kp+j*2048); kf[2*j+1]=*(const __attribute__((address_space(3))) bf16x8*)(kp+j*2048+512); }
__device__ __forceinline__ s16x4 vtr(lds_cptr p){ return __builtin_bit_cast(s16x4,__builtin_amdgcn_ds_read_tr16_b64_v4i16((__attribute__((address_space(3))) v4i16_t*)p)); }
__device__ __forceinline__ float rowmax(const f32x16&p0,const f32x16&p1){
  float a=max3f(p0[0],p0[1],p1[0]),b=max3f(p0[2],p0[3],p1[1]);a=max3f(a,p1[2],p1[3]);
  #pragma unroll
  for(int r=4;r<16;r+=4){a=max3f(a,p0[r],p0[r+1]);b=max3f(b,p0[r+2],p0[r+3]);a=max3f(a,p1[r],p1[r+1]);b=max3f(b,p1[r+2],p1[r+3]);}
  const float m=max2f(a,b);
  auto rr=__builtin_amdgcn_permlane32_swap(__float_as_uint(m),__float_as_uint(m),false,false);
  return max2f(__uint_as_float(rr[0]),__uint_as_float(rr[1]));
}
__device__ __forceinline__ void pv(f32x16*o,int vb,bf16x8 pa0,bf16x8 pa1,bf16x8 pa2,bf16x8 pa3){
  #pragma unroll
  for(int d0=0;d0<2;++d0){s16x4 lo[4],hi[4];
    #pragma unroll
    for(int ks=0;ks<4;++ks){
      asm volatile("ds_read_b64_tr_b16 %0,%1 offset:%c2":"=&v"(lo[ks]):"v"(vb),"i"(d0*4096+ks*1024):"memory");
      asm volatile("ds_read_b64_tr_b16 %0,%1 offset:%c2":"=&v"(hi[ks]):"v"(vb),"i"(d0*4096+ks*1024+512):"memory");}
    asm volatile("s_waitcnt lgkmcnt(0)":::"memory");SBAR();
    #define PK(k) (bf16x8){lo[k][0],lo[k][1],lo[k][2],lo[k][3],hi[k][0],hi[k][1],hi[k][2],hi[k][3]}
    o[d0]=__builtin_amdgcn_mfma_f32_32x32x16_bf16(pa0,PK(0),o[d0],0,0,0);
    o[d0]=__builtin_amdgcn_mfma_f32_32x32x16_bf16(pa1,PK(1),o[d0],0,0,0);
    o[d0]=__builtin_amdgcn_mfma_f32_32x32x16_bf16(pa2,PK(2),o[d0],0,0,0);
    o[d0]=__builtin_amdgcn_mfma_f32_32x32x16_bf16(pa3,PK(3),o[d0],0,0,0);
    #undef PK
  }
}

#ifndef ATTN_STORE16
#define ATTN_STORE16(p,v) (*(u32x4*)(p)=(v))
#endif
template<int THRL,int QP_,int KVP_,int SKV_,int GQ_,bool FIXM> __device__ __forceinline__ void attn_unit(int b,int h,int qb,const bf16*Q,const bf16*__restrict__ K,const bf16*__restrict__ V,bf16*O,char*shm,float mfix){
  const int tid=threadIdx.x,lane=tid&63,r32=lane&31,hi=lane>>5; const int wid=__builtin_amdgcn_readfirstlane(tid>>6);
  const long rowbase=0; (void)b; const int q0=qb*QB;
  const bf16*Qw=Q+(rowbase+q0+wid*QBLK)*QP_+h*D;
  const bf16*Kh=K+rowbase*KVP_+(h/GQ_)*D,*Vh=V+rowbase*KVP_+(h/GQ_)*D;
  const unsigned lds0=(unsigned)(uintptr_t)shm;
  float*wsf=(float*)(shm+LDS_WS)+wid*64;
  const bf16*ksrc=Kh+(long)lane*KVP_+wid*8;
  const bf16*vsrc=Vh+(long)(16*(wid&3)+(lane>>2))*KVP_+(wid>>2)*32+(lane&3)*8;
  const unsigned kdst=lds0+LDS_K+wid*1024, vdst=lds0+LDS_V+wid*1024;
  #define DMA_K(t,slot) glds16(ksrc+(long)(t)*KVBLK*KVP_,(unsigned)__builtin_amdgcn_readfirstlane(kdst+(slot)))
  #define DMA_V(t,slot) glds16(vsrc+(long)(t)*KVBLK*KVP_,(unsigned)__builtin_amdgcn_readfirstlane(vdst+(slot)))
  const int vb0=(int)(lds0+LDS_V)+((lane>>4)&1)*32+(lane&3)*8+(4*hi+((lane&15)>>2))*64;
  const char*Kbase=shm+LDS_K; bf16x8 kf[8];
  const lds_cptr shm3=(lds_cptr)shm; const lds_cptr kp0=shm3+LDS_K+hi*1024+r32*16; const lds_cptr vp0=shm3+LDS_V+((lane>>4)&1)*32+(lane&3)*8+(4*hi+((lane&15)>>2))*64;
  const int NT=SKV_/KVBLK;
  DMA_K(0,0);DMA_V(0,0);DMA_K(1,SLOTB);
  bf16x8 qr[4];
  #pragma unroll
  for(int d0=0;d0<4;++d0)qr[d0]=*reinterpret_cast<const bf16x8*>(&Qw[(long)r32*QP_+d0*16+hi*8]);
  float mhat=0.f,l_reg=0.f;f32x16 o[2];o[0]=f32x16{};o[1]=f32x16{};f32x16 negm=f32x16{}; if constexpr(FIXM){ _Pragma("unroll") for(int r=0;r<16;++r)negm[r]=-mfix; } asm volatile("":"+v"(negm));
  const int qrel=wid*QBLK+r32;
  #define CMASK(P0,P1,t) do{}while(0)
  bool resc=false;
  #define START(P0,P1) do{ resc=false; if constexpr(!FIXM) { const float rm=rowmax(P0,P1); \
      const float dl=rm; mhat=fadd_s(mhat,dl); \
      _Pragma("unroll") for(int r=0;r<16;++r){P0[r]=fsub_s(P0[r],dl);P1[r]=fsub_s(P1[r],dl);} \
      _Pragma("unroll") for(int r=0;r<16;++r)negm[r]=-mhat; asm volatile("":"+v"(negm)); } \
    _Pragma("unroll") for(int r=0;r<16;++r)P0[r]=__builtin_amdgcn_exp2f(P0[r]); }while(0)
  #define RESC() do{ if(resc){ asm volatile("s_waitcnt lgkmcnt(0)":::"memory"); \
      _Pragma("unroll") for(int d_=0;d_<2;++d_) _Pragma("unroll") for(int r=0;r<16;++r)o[d_][r]*=wsf[crow(r,hi)]; } }while(0)
  f32x16 pA0,pA1,pB0,pB1;
  int sl_prev=0,sl_cur=0,sl_next=SLOTB;
  #define ROT() do{sl_prev=sl_cur;sl_cur=sl_next;sl_next=(sl_next==(NSLOT-1)*SLOTB)?0:sl_next+SLOTB;}while(0)
  DMA_K(2,2*SLOTB);
  WAIT_BAR(3);
  qkt(pA0,pA1,Kbase,qr,negm,r32,hi);asm volatile("s_nop 15\n\ts_nop 7":"+v"(pA0),"+v"(pA1));CMASK(pA0,pA1,0);
  START(pA0,pA1);
  _Pragma("unroll") for(int r=0;r<16;++r)pA1[r]=__builtin_amdgcn_exp2f(pA1[r]);
  WAIT_BAR(0);
  DMA_K(3,0);DMA_V(1,SLOTB);
  ROT();
  kload8(kf,kp0+sl_cur);
  WAIT_BAR(2);
  s16x4 vlo[8],vhi[8]; u32x4 pw0,pw1,pw2,pw3;
  #define PKW(P,B) cvtpk_s(P[B],P[B+1])
  #define PAF(k) __builtin_bit_cast(bf16x8,pw##k)
  #define VFR(i) (bf16x8){vlo[i][0],vlo[i][1],vlo[i][2],vlo[i][3],vhi[i][0],vhi[i][1],vhi[i][2],vhi[i][3]}
  #define PIN(x) asm volatile("":"+v"(x))
  #define MX3(a,b,c) __builtin_fmaxf(__builtin_fmaxf((a),(b)),(c))
  #define GAPA(MF,A0,A1,A2,A3,W0,W1,PW) do{ MF; sacc+=A0; sacc+=A1; sacc+=A2; sacc+=A3; PIN(sacc); W0; W1; PIN(PW); SBAR(); }while(0)
  #define EX(v) __builtin_amdgcn_exp2f(v)
  #define GAPB(MF,X,B) do{ MF; X[B]=EX(X[B]); X[B+1]=EX(X[B+1]); X[B+2]=EX(X[B+2]); X[B+3]=EX(X[B+3]); PIN(X); SBAR(); }while(0)
  #define VRD(i) do{ vlo[i]=vtr(vp_+(((i)>>2)*4096+((i)&3)*1024)); vhi[i]=vtr(vp_+(((i)>>2)*4096+((i)&3)*1024+512)); }while(0)
  #define KRD(G,j) do{ if(G){ kload2(kf,kp0+sl_next,j); SBAR(); } }while(0)
  #define STEP(C0,C1,P0,P1,t,GK,GV,GL) do{ SBAR(); \
    const lds_cptr vp_=vp0+sl_prev; \
    VRD(0); SBAR(); float sacc=(P0[0]+P0[1]); \
    GAPA(C0=__builtin_amdgcn_mfma_f32_32x32x16_bf16(kf[0],qr[0],negm,0,0,0), P0[2],P0[3],P0[4],P0[5],     pw0[0]=PKW(P0,0), pw0[1]=PKW(P0,2), pw0); \
    VRD(4); SBAR(); GAPA(C1=__builtin_amdgcn_mfma_f32_32x32x16_bf16(kf[1],qr[0],negm,0,0,0), P0[6],P0[7],P0[8],P0[9],     pw0[2]=PKW(P0,4), pw0[3]=PKW(P0,6), pw0); \
    VRD(1); SBAR(); GAPA(C0=__builtin_amdgcn_mfma_f32_32x32x16_bf16(kf[2],qr[1],C0,0,0,0),   P0[10],P0[11],P0[12],P0[13], pw1[0]=PKW(P0,8), pw1[1]=PKW(P0,10), pw1); \
    VRD(5); SBAR(); GAPA(C1=__builtin_amdgcn_mfma_f32_32x32x16_bf16(kf[3],qr[1],C1,0,0,0),   P0[14],P0[15],P1[0],P1[1],   pw1[2]=PKW(P0,12),pw1[3]=PKW(P0,14), pw1); \
    VRD(2); SBAR(); GAPA(C0=__builtin_amdgcn_mfma_f32_32x32x16_bf16(kf[4],qr[2],C0,0,0,0),   P1[2],P1[3],P1[4],P1[5],     pw2[0]=PKW(P1,0), pw2[1]=PKW(P1,2), pw2); \
    VRD(6); SBAR(); GAPA(C1=__builtin_amdgcn_mfma_f32_32x32x16_bf16(kf[5],qr[2],C1,0,0,0),   P1[6],P1[7],P1[8],P1[9],     pw2[2]=PKW(P1,4), pw2[3]=PKW(P1,6), pw2); \
    VRD(3); SBAR(); GAPA(C0=__builtin_amdgcn_mfma_f32_32x32x16_bf16(kf[6],qr[3],C0,0,0,0),   P1[10],P1[11],P1[12],P1[13], pw3[0]=PKW(P1,8), pw3[1]=PKW(P1,10), pw3); \
    VRD(7); SBAR(); GAPA(C1=__builtin_amdgcn_mfma_f32_32x32x16_bf16(kf[7],qr[3],C1,0,0,0),   P1[14],P1[15],0.f,0.f,       pw3[2]=PKW(P1,12),pw3[3]=PKW(P1,14), pw3); \
    l_reg+=sacc; \
    if(GK){DMA_K((t)+3,sl_cur);} if(GV){DMA_V((t)+1,sl_next);} \
    CMASK(C0,C1,t); \
    if constexpr(!FIXM) { float a=MX3(C0[0],C0[1],C1[0]),b=MX3(C0[2],C0[3],C1[1]); a=MX3(a,C1[2],C1[3]); \
      _Pragma("unroll") for(int r=4;r<16;r+=4){a=MX3(a,C0[r],C0[r+1]);b=MX3(b,C0[r+2],C0[r+3]);a=MX3(a,C1[r],C1[r+1]);b=MX3(b,C1[r+2],C1[r+3]);} \
      float rm=__builtin_fmaxf(a,b); { auto rr=__builtin_amdgcn_permlane32_swap(__float_as_uint(rm),__float_as_uint(rm),false,false); rm=__builtin_fmaxf(__uint_as_float(rr[0]),__uint_as_float(rr[1])); } \
      resc=false; \
      if(__builtin_expect(__any(rm>(float)THRL),0)){ const float dl=__builtin_fmaxf(rm,0.f); mhat+=dl; \
        _Pragma("unroll") for(int r=0;r<16;++r){C0[r]-=dl;C1[r]-=dl;} \
        _Pragma("unroll") for(int r=0;r<16;++r)negm[r]=-mhat; asm volatile("":"+v"(negm)); \
        const float f=__builtin_amdgcn_exp2f(-dl); l_reg*=f; if(hi==0)wsf[r32]=f; resc=true; } } \
    SBAR(); \
    GAPB(o[0]=__builtin_amdgcn_mfma_f32_32x32x16_bf16(PAF(0),VFR(0),o[0],0,0,0), C0,0); \
    GAPB(o[1]=__builtin_amdgcn_mfma_f32_32x32x16_bf16(PAF(0),VFR(4),o[1],0,0,0), C0,4); \
    KRD(GL,0); GAPB(o[0]=__builtin_amdgcn_mfma_f32_32x32x16_bf16(PAF(1),VFR(1),o[0],0,0,0), C0,8); \
    KRD(GL,1); GAPB(o[1]=__builtin_amdgcn_mfma_f32_32x32x16_bf16(PAF(1),VFR(5),o[1],0,0,0), C0,12); \
    KRD(GL,2); GAPB(o[0]=__builtin_amdgcn_mfma_f32_32x32x16_bf16(PAF(2),VFR(2),o[0],0,0,0), C1,0); \
    KRD(GL,3); GAPB(o[1]=__builtin_amdgcn_mfma_f32_32x32x16_bf16(PAF(2),VFR(6),o[1],0,0,0), C1,4); \
    GAPB(o[0]=__builtin_amdgcn_mfma_f32_32x32x16_bf16(PAF(3),VFR(3),o[0],0,0,0), C1,8); \
    GAPB(o[1]=__builtin_amdgcn_mfma_f32_32x32x16_bf16(PAF(3),VFR(7),o[1],0,0,0), C1,12); \
    }while(0)
  int t=1;
  #undef CMASK
  #define CMASK(P0,P1,t) do{}while(0)
  for(;t+5<NT;t+=2){
    STEP(pB0,pB1,pA0,pA1,t,true,true,true);     WAIT_BAR(2); RESC(); ROT();
    STEP(pA0,pA1,pB0,pB1,t+1,true,true,true);   WAIT_BAR(2); RESC(); ROT();
  }
  #undef CMASK
  #define CMASK(P0,P1,t) do{}while(0)
  #define ENDW(tt) do{ if((tt)+3<NT){WAIT_BAR(2);} else if((tt)+2<NT){WAIT_BAR(1);} else {WAIT_BAR(0);} }while(0)
  for(;t+1<NT;t+=2){
    STEP(pB0,pB1,pA0,pA1,t,(t+3<NT),(t+1<NT),(t+1<NT));       ENDW(t);   RESC(); ROT();
    STEP(pA0,pA1,pB0,pB1,t+1,(t+4<NT),(t+2<NT),(t+2<NT));     ENDW(t+1); RESC(); ROT();
  }
  STEP(pB0,pB1,pA0,pA1,NT-1,false,false,false); RESC();
  { float sacc=pB0[0]+pB0[1]; _Pragma("unroll") for(int r=2;r<16;++r)sacc+=pB0[r]; _Pragma("unroll") for(int r=0;r<16;++r)sacc+=pB1[r]; l_reg+=sacc;
    pw0=(u32x4){PKW(pB0,0),PKW(pB0,2),PKW(pB0,4),PKW(pB0,6)};pw1=(u32x4){PKW(pB0,8),PKW(pB0,10),PKW(pB0,12),PKW(pB0,14)};pw2=(u32x4){PKW(pB1,0),PKW(pB1,2),PKW(pB1,4),PKW(pB1,6)};pw3=(u32x4){PKW(pB1,8),PKW(pB1,10),PKW(pB1,12),PKW(pB1,14)};
    SBAR(); pv(o,vb0+sl_cur,PAF(0),PAF(1),PAF(2),PAF(3)); }
  #undef PKW
  #undef PAF
  #undef VFR
  #undef PIN
  #undef MX3
  #undef GAPA
  #undef GAPB
  #undef EX
  #undef VRD
  #undef KRD
  #undef STEP
  #undef ENDW
  {auto rr=__builtin_amdgcn_permlane32_swap(__float_as_uint(l_reg),__float_as_uint(l_reg),false,false);l_reg=__uint_as_float(rr[0])+__uint_as_float(rr[1]);}
  if(hi==0)wsf[32+r32]=l_reg;asm volatile("s_waitcnt lgkmcnt(0)":::"memory");
  float rli[16];
  #pragma unroll
  for(int r=0;r<16;++r)rli[r]=__builtin_amdgcn_rcpf(wsf[32+crow(r,hi)]);
  bf16*Ow=O+(rowbase+q0+wid*QBLK)*QP_+h*D;
  { bf16*stg=(bf16*)(shm+LDS_OST)+wid*2048;
    #pragma unroll
    for(int r=0;r<16;++r){const int orow=crow(r,hi);
      #pragma unroll
      for(int d0=0;d0<2;++d0)stg[orow*64+d0*32+r32]=__float2bfloat16(o[d0][r]*rli[r]);}
    asm volatile("s_waitcnt lgkmcnt(0)":::"memory");
    #pragma unroll
    for(int i=0;i<4;++i){const int row=i*8+(lane>>3),ch=lane&7; const u32x4 v=*(const u32x4*)(stg+row*64+ch*8); ATTN_STORE16(Ow+(long)row*QP_+ch*8,v);} }
  asm volatile("s_waitcnt lgkmcnt(0)\n\ts_barrier":::"memory");
  #undef DMA_K
  #undef DMA_V
  #undef CMASK
  #undef START
  #undef RESC
  #undef ROT
}
constexpr int ATTN_LDS_BYTES=LDS_BYTES;
struct AttnTensors { const bf16* Q; const bf16* K; const bf16* V; bf16* O; };
struct AttnUnit { int bh; int qb; };
struct StaticOrder {
  int vcu;
  __device__ __forceinline__ explicit StaticOrder(int grid,int block):vcu((block%8)*(grid/8)+block/8){}
  __device__ __forceinline__ bool next(int i,AttnUnit&u)const{ if(i>=4)return false; const int x=vcu>>5,c=vcu&31,idx=32*i+c; u.bh=2*x+(idx>>6); u.qb=idx&63; return true; }
  __device__ __forceinline__ void a_ready(const AttnUnit&)const{}
  __device__ __forceinline__ void done(const AttnUnit&)const{}
};
template<class Sched,int QP_,int KVP_,int SKV_,int GQ_,bool FIXM,int THRL=8> __device__ __forceinline__ void attn_phase(char*lds,const AttnTensors&T,const Sched&S,float mfix){
  AttnUnit u;
  for(int i=0;S.next(i,u);++i){ S.a_ready(u); attn_unit<THRL,QP_,KVP_,SKV_,GQ_,FIXM>(0,u.bh,u.qb,T.Q,T.K,T.V,T.O,lds,mfix); S.done(u); }
}
struct CrossOrder {
  int vcu;
  __device__ __forceinline__ explicit CrossOrder(int grid,int block):vcu((block%8)*(grid/8)+block/8){}
  __device__ __forceinline__ bool next(int i,AttnUnit&u)const{ if(i>=1||vcu>=256)return false; u.bh=vcu>>6; u.qb=vcu&63; return true; }
  __device__ __forceinline__ void a_ready(const AttnUnit&)const{}
  __device__ __forceinline__ void done(const AttnUnit&)const{}
};
#undef SBAR
#undef WAIT_BAR
}
constexpr int NWAVES = 8;
constexpr int M = 16384, D = 1024, FF = 2816, NIN = 4096, MEMLEN = 256, NCH = 512;
constexpr float C2Q = 0.125f * 1.4426950408889634f;
constexpr size_t MiB = 1u << 20, KiB = 1u << 10;
constexpr size_t WS_CTL = 0, CTL_ZERO_BYTES = 1 * MiB;
constexpr size_t WS_SS2 = 256 * KiB, WS_SS3 = 320 * KiB, WS_SS4 = 384 * KiB, WS_SS5 = 448 * KiB;
constexpr size_t WS_SMALL = 1 * MiB;
constexpr size_t WS_RS1 = WS_SMALL, WS_ROPE = WS_SMALL + 64 * KiB, WS_DFT = WS_SMALL + 112 * KiB, WS_TW = WS_SMALL + 128 * KiB, WS_KC = WS_SMALL + 256 * KiB, WS_VC = WS_SMALL + 384 * KiB;
constexpr size_t WS_W1GU = 2 * MiB, WS_W1D = 13 * MiB, WS_W2GU = 18 * MiB + 512 * KiB, WS_W2D = 29 * MiB + 512 * KiB, WS_WIN = 35 * MiB, WS_WFB = 43 * MiB, WS_WAB = 45 * MiB, WS_WOUT = 47 * MiB,
                 WS_WCQ = 49 * MiB, WS_WCO = 49 * MiB + 512 * KiB;
constexpr size_t WS_HB16 = 56 * MiB;
constexpr size_t WS_R1 = 88 * MiB;
constexpr size_t WS_QO = WS_R1, WS_U = WS_R1 + 32 * MiB, WS_KR = WS_R1 + 64 * MiB, WS_VR = WS_R1 + 72 * MiB, WS_F = WS_R1 + 80 * MiB;
constexpr size_t WS_QC = WS_R1, WS_OC = WS_R1 + 8 * MiB;
constexpr size_t WS_GF = 184 * MiB, WS_GA = 216 * MiB, WS_END = 248 * MiB;
static_assert(WS_W1GU + (size_t)2 * FF * D * 2 == WS_W1D && WS_W1D + (size_t)D * FF * 2 == WS_W2GU && WS_W2GU + (size_t)2 * FF * D * 2 == WS_W2D && WS_W2D + (size_t)D * FF * 2 == WS_WIN, "weights map");
static_assert(WS_R1 + (size_t)M * FF * 2 <= WS_GF && WS_F + (size_t)M * NCH * 2 <= WS_GF, "R1 map");
constexpr int CW_BAR = 4096;
constexpr int RING_BYTES = 131072, LDSCTL_OFF = RING_BYTES, MISC_OFF = LDSCTL_OFF + 320, LDS_BYTES = 147456;

#define GAS __attribute__((address_space(1)))
#define LAS __attribute__((address_space(3)))
typedef unsigned short bf16;
typedef unsigned v4u __attribute__((ext_vector_type(4)));
typedef float f32x4 __attribute__((ext_vector_type(4)));
typedef float f32x2 __attribute__((ext_vector_type(2)));
#define LDS_WAIT() asm volatile("s_waitcnt lgkmcnt(0)" ::: "memory")
#define VM_WAIT() asm volatile("s_waitcnt vmcnt(0)" ::: "memory")
__device__ __forceinline__ unsigned f2bf(float f) { unsigned u = __builtin_bit_cast(unsigned, f); return (u + 0x7fffu + ((u >> 16) & 1u)) >> 16; }
__device__ __forceinline__ unsigned pk2(float lo, float hi) { return f2bf(lo) | (f2bf(hi) << 16); }
__device__ __forceinline__ float bf2f(unsigned short b) { return __uint_as_float((unsigned)b << 16); }
__device__ __forceinline__ float bflo_(unsigned u) { return __uint_as_float(u << 16); }
__device__ __forceinline__ float bfhi_(unsigned u) { return __uint_as_float(u & 0xffff0000u); }
constexpr float RMS_EPSF = 1e-6f;
__device__ __forceinline__ float wave_sum(float v) {
#pragma unroll
    for (int o = 1; o < 64; o <<= 1) v += __shfl_xor(v, o);
    return v;
}
__device__ __forceinline__ void sincos_rev(double x, float& s, float& c) {
    x -= __builtin_floor(x);
    const double q = __builtin_rint(x * 4.0);
    const double r = (x - q * 0.25) * 6.283185307179586476925;
    const double r2 = r * r;
    double sp = 1.0 / 6227020800.0; sp = sp * r2 - 1.0 / 39916800.0; sp = sp * r2 + 1.0 / 362880.0; sp = sp * r2 - 1.0 / 5040.0; sp = sp * r2 + 1.0 / 120.0; sp = sp * r2 - 1.0 / 6.0; sp = sp * r2 + 1.0; sp *= r;
    double cp = -1.0 / 87178291200.0; cp = cp * r2 + 1.0 / 479001600.0; cp = cp * r2 - 1.0 / 3628800.0; cp = cp * r2 + 1.0 / 40320.0; cp = cp * r2 - 1.0 / 720.0; cp = cp * r2 + 1.0 / 24.0; cp = cp * r2 - 0.5; cp = cp * r2 + 1.0;
    const int qi = (int)q & 3;
    const double ss = (qi == 0) ? sp : (qi == 1) ? cp : (qi == 2) ? -sp : -cp;
    const double cc = (qi == 0) ? cp : (qi == 1) ? -sp : (qi == 2) ? -cp : sp;
    s = (float)ss; c = (float)cc;
}

struct Frame {
    LAS unsigned char* lds;
    int tid, lane, wave, G, vcu;
    const float* in[24]; float* out; unsigned char* ws;
};
template <class T> __device__ __forceinline__ T* wsp(const Frame& F, size_t off) { return (T*)(F.ws + off); }

__device__ __forceinline__ void p0_transpose_item(const float* W, const float* gain, int K, int N, bf16* WT, int gu, LAS float* scr, int item, int lane) {
    const int nblk = N / 32, kb = item / nblk, nb = item % nblk, k0 = 64 * kb, n0 = 32 * nb;
#pragma unroll 8
    for (int i = 0; i < 32; ++i) { const int kk = 2 * i + (lane >> 5); float v = W[(size_t)(k0 + kk) * N + n0 + (lane & 31)]; if (gain) v *= gain[k0 + kk]; scr[kk * 33 + (lane & 31)] = v; }
    LDS_WAIT(); asm volatile("" ::: "memory");
    const int c = lane & 7;
    const int rb = (gu == 0) ? n0 : (256 * (n0 >> 7) + (n0 & 127) + (gu == 2 ? 128 : 0));
#pragma unroll
    for (int j = 0; j < 4; ++j) { const int n = (lane >> 3) + 8 * j; const LAS float* s = scr + (8 * c) * 33 + n;
        v4u o; o.x = pk2(s[0 * 33], s[1 * 33]); o.y = pk2(s[2 * 33], s[3 * 33]); o.z = pk2(s[4 * 33], s[5 * 33]); o.w = pk2(s[6 * 33], s[7 * 33]);
        *(GAS v4u*)(WT + (size_t)(rb + n) * K + k0 + 8 * c) = o; }
    LDS_WAIT(); asm volatile("" ::: "memory");
}
__device__ __forceinline__ void p0_prologue(Frame& F) {
    const int gw = F.vcu * NWAVES + F.wave, NGW = F.G * NWAVES;
    const int gt = blockIdx.x * (NWAVES * 64) + F.tid, NGT = F.G * NWAVES * 64;
    {
        f32x2* tw = wsp<f32x2>(F, WS_TW); f32x2* dft = wsp<f32x2>(F, WS_DFT); float* rope = wsp<float>(F, WS_ROPE);
        for (int i = gt; i < 16384; i += NGT) { float s, c; sincos_rev((double)i * (1.0 / 16384.0), s, c); tw[i] = (f32x2){c, s}; }
        for (int i = gt; i < 128; i += NGT) { float s, c; sincos_rev((double)i * (1.0 / 128.0), s, c); dft[i] = (f32x2){c, s}; }
        for (int i = gt; i < (256 + 64) * 16; i += NGT) {
            const int j = i & 15, p = i >> 4; const int pos = (p < 256) ? p : p - 256;
            double inv = 1.0; for (int q = 0; q < j; ++q) inv *= 0.5623413251903491;
            const float ang = (float)pos * (float)inv;
            float s, c; sincos_rev((double)ang * 0.15915494309189533577, s, c);
            if (p < 256) { rope[p * 16 + j] = c; rope[4096 + p * 16 + j] = s; } else { rope[8192 + pos * 16 + j] = c; rope[8192 + 1024 + pos * 16 + j] = s; }
        }
    }
    {
        LAS float* scr = (LAS float*)(F.lds + F.wave * 16384);
        constexpr int I_GU = (D / 64) * (FF / 32), I_DN = (FF / 64) * (D / 32), I_IN = (D / 64) * (NIN / 32), I_SQ = (D / 64) * (D / 32), I_CQ = (D / 64) * (256 / 32), I_CO = (256 / 64) * (D / 32);
        constexpr int NITEMS = 4 * I_GU + 2 * I_DN + I_IN + 2 * I_SQ + I_CQ + I_CO;
        for (int it = gw; it < NITEMS; it += NGW) {
            int r = it;
            if (r < I_GU) { p0_transpose_item(F.in[3], F.in[2], D, FF, wsp<bf16>(F, WS_W1GU), 1, scr, r, F.lane); continue; } r -= I_GU;
            if (r < I_GU) { p0_transpose_item(F.in[4], F.in[2], D, FF, wsp<bf16>(F, WS_W1GU), 2, scr, r, F.lane); continue; } r -= I_GU;
            if (r < I_DN) { p0_transpose_item(F.in[5], nullptr, FF, D, wsp<bf16>(F, WS_W1D), 0, scr, r, F.lane); continue; } r -= I_DN;
            if (r < I_GU) { p0_transpose_item(F.in[20], F.in[19], D, FF, wsp<bf16>(F, WS_W2GU), 1, scr, r, F.lane); continue; } r -= I_GU;
            if (r < I_GU) { p0_transpose_item(F.in[21], F.in[19], D, FF, wsp<bf16>(F, WS_W2GU), 2, scr, r, F.lane); continue; } r -= I_GU;
            if (r < I_DN) { p0_transpose_item(F.in[22], nullptr, FF, D, wsp<bf16>(F, WS_W2D), 0, scr, r, F.lane); continue; } r -= I_DN;
            if (r < I_IN) { p0_transpose_item(F.in[7], F.in[6], D, NIN, wsp<bf16>(F, WS_WIN), 0, scr, r, F.lane); continue; } r -= I_IN;
            if (r < I_SQ) { p0_transpose_item(F.in[11], nullptr, D, D, wsp<bf16>(F, WS_WAB), 0, scr, r, F.lane); continue; } r -= I_SQ;
            if (r < I_SQ) { p0_transpose_item(F.in[12], nullptr, D, D, wsp<bf16>(F, WS_WOUT), 0, scr, r, F.lane); continue; } r -= I_SQ;
            if (r < I_CQ) { p0_transpose_item(F.in[15], F.in[13], D, 256, wsp<bf16>(F, WS_WCQ), 0, scr, r, F.lane); continue; } r -= I_CQ;
            p0_transpose_item(F.in[18], nullptr, 256, D, wsp<bf16>(F, WS_WCO), 0, scr, r, F.lane);
        }
    }
    __syncthreads();
    {
        LAS f32x2* tab = (LAS f32x2*)F.lds;
        if (F.tid < 128) { float s, c; sincos_rev((double)F.tid * (1.0 / 128.0), s, c); tab[F.tid] = (f32x2){c * 0.08838834764831845f, s * 0.08838834764831845f}; }
        __syncthreads();
        const float* Wfb = F.in[10]; bf16* WT = wsp<bf16>(F, WS_WFB);
        for (int it = gt; it < 1024 * 128; it += NGT) {
            const int n = it & 1023, kb = it >> 10, kk0 = kb * 8, g = kk0 >> 8, ri = (kk0 >> 7) & 1, c0 = kk0 & 127;
            float a[8];
#pragma unroll
            for (int i = 0; i < 8; ++i) a[i] = 0.f;
            for (int j = 0; j < 128; ++j) {
                const float w = Wfb[(size_t)(g * 128 + j) * 1024 + n];
#pragma unroll
                for (int i = 0; i < 8; ++i) { const f32x2 cs = tab[((c0 + i) * j) & 127]; a[i] += w * (ri ? cs.y : cs.x); }
            }
            v4u o; o.x = pk2(a[0], a[1]); o.y = pk2(a[2], a[3]); o.z = pk2(a[4], a[5]); o.w = pk2(a[6], a[7]);
            *(GAS v4u*)(WT + (size_t)n * 1024 + kk0) = o;
        }
        __syncthreads();
    }
    {
        const float* x = F.in[0]; bf16* xb = wsp<bf16>(F, WS_HB16); float* rs1 = wsp<float>(F, WS_RS1);
        for (int m = gw; m < M; m += NGW) {
            const GAS f32x4* xr = (const GAS f32x4*)(x + (size_t)m * D) + F.lane;
            f32x4 v[4]; float s = 0.f;
#pragma unroll
            for (int j = 0; j < 4; ++j) { v[j] = xr[64 * j]; s += (v[j].x * v[j].x + v[j].y * v[j].y) + (v[j].z * v[j].z + v[j].w * v[j].w); }
            s = wave_sum(s);
            GAS unsigned long long* o8 = (GAS unsigned long long*)(xb + (size_t)m * D) + F.lane;
#pragma unroll
            for (int j = 0; j < 4; ++j) o8[64 * j] = (unsigned long long)pk2(v[j].x, v[j].y) | ((unsigned long long)pk2(v[j].z, v[j].w) << 32);
            if (F.lane == 0) rs1[m] = 1.0f / sqrtf(s * (1.0f / D) + RMS_EPSF);
        }
    }
    {
        LAS float* mn = (LAS float*)(F.lds + 8192); LAS float* red = (LAS float*)(F.lds + 8192 + 4096);
        const float* mem = F.in[1]; const float* gm = F.in[14]; const float* Wk = F.in[16]; const float* Wv = F.in[17];
        bf16* Kc = wsp<bf16>(F, WS_KC); bf16* Vc = wsp<bf16>(F, WS_VC);
        for (int r = blockIdx.x; r < MEMLEN; r += F.G) {
            __syncthreads();
            const float a = mem[(size_t)r * D + F.tid], b = mem[(size_t)r * D + 512 + F.tid];
            float s = wave_sum(a * a + b * b);
            if (F.lane == 0) red[F.wave] = s;
            __syncthreads();
            float tot = 0.f;
#pragma unroll
            for (int w = 0; w < NWAVES; ++w) tot += red[w];
            const float rinv = 1.0f / sqrtf(tot * (1.0f / D) + RMS_EPSF);
            mn[F.tid] = a * rinv * gm[F.tid]; mn[512 + F.tid] = b * rinv * gm[512 + F.tid];
            __syncthreads();
            const int n = F.tid & 255; const float* W = (F.tid < 256) ? Wk : Wv; float acc = 0.f;
            for (int k = 0; k < D; ++k) acc += mn[k] * W[(size_t)k * 256 + n];
            ((F.tid < 256) ? Kc : Vc)[r * 256 + n] = (bf16)f2bf(acc);
        }
        __syncthreads();
    }
}

__device__ __forceinline__ void p_prep_qk(Frame& F) {
    bf16* Q = wsp<bf16>(F, WS_QO); bf16* Kr = wsp<bf16>(F, WS_KR); const float* rope = wsp<float>(F, WS_ROPE);
    const float* qg = F.in[8]; const float* kg = F.in[9];
    const int gt = blockIdx.x * (NWAVES * 64) + F.tid, NGT = F.G * NWAVES * 64;
    for (int it = gt; it < M * 20; it += NGT) {
        const int t = it / 20, hh = it - t * 20;
        bf16* p = (hh < 16) ? (Q + (size_t)t * 1024 + hh * 64) : (Kr + (size_t)t * 256 + (hh - 16) * 64);
        const float* gain = (hh < 16) ? qg : kg; const float post = (hh < 16) ? C2Q : 1.0f;
        float v[64];
#pragma unroll
        for (int i = 0; i < 8; ++i) { const v4u w = *(const GAS v4u*)(p + 8 * i);
            v[8 * i + 0] = __uint_as_float(w.x << 16); v[8 * i + 1] = __uint_as_float(w.x & 0xffff0000u); v[8 * i + 2] = __uint_as_float(w.y << 16); v[8 * i + 3] = __uint_as_float(w.y & 0xffff0000u);
            v[8 * i + 4] = __uint_as_float(w.z << 16); v[8 * i + 5] = __uint_as_float(w.z & 0xffff0000u); v[8 * i + 6] = __uint_as_float(w.w << 16); v[8 * i + 7] = __uint_as_float(w.w & 0xffff0000u); }
        float s = 0.f;
#pragma unroll
        for (int i = 0; i < 64; ++i) s += v[i] * v[i];
        const float rinv = 1.0f / sqrtf(s * (1.0f / 64.0f) + RMS_EPSF);
#pragma unroll
        for (int i = 0; i < 64; ++i) v[i] = v[i] * rinv * gain[i];
        const int row = t >> 6, col = t & 63;
#pragma unroll
        for (int j = 0; j < 16; ++j) {
            const float cr = rope[row * 16 + j], sr = rope[4096 + row * 16 + j], cc = rope[8192 + col * 16 + j], sc = rope[8192 + 1024 + col * 16 + j];
            const float a = v[j], b = v[16 + j]; v[j] = a * cr - b * sr; v[16 + j] = b * cr + a * sr;
            const float e = v[32 + j], f = v[48 + j]; v[32 + j] = e * cc - f * sc; v[48 + j] = f * cc + e * sc;
        }
#pragma unroll
        for (int i = 0; i < 8; ++i) { v4u o; o.x = pk2(v[8 * i] * post, v[8 * i + 1] * post); o.y = pk2(v[8 * i + 2] * post, v[8 * i + 3] * post); o.z = pk2(v[8 * i + 4] * post, v[8 * i + 5] * post); o.w = pk2(v[8 * i + 6] * post, v[8 * i + 7] * post);
            *(GAS v4u*)(p + 8 * i) = o; }
    }
}
__device__ __forceinline__ void prep_vec(bf16* p, const float* gain, const float* rope, int t, int sub, float post) {
    const v4u w = *(const GAS v4u*)p;
    float y[8] = {bflo_(w.x), bfhi_(w.x), bflo_(w.y), bfhi_(w.y), bflo_(w.z), bfhi_(w.z), bflo_(w.w), bfhi_(w.w)};
    float s = 0.f;
#pragma unroll
    for (int e = 0; e < 8; ++e) s += y[e] * y[e];
    s += __shfl_xor(s, 1); s += __shfl_xor(s, 2); s += __shfl_xor(s, 4);
    const float rinv = 1.0f / sqrtf(s * (1.0f / 64.0f) + RMS_EPSF);
    const f32x4 g0 = *(const GAS f32x4*)(gain + 8 * sub), g1 = *(const GAS f32x4*)(gain + 8 * sub + 4);
#pragma unroll
    for (int e = 0; e < 4; ++e) { y[e] *= rinv * g0[e]; y[4 + e] *= rinv * g1[e]; }
    const int half = sub >> 2, pos = half ? (t & 63) : (t >> 6);
    const float* ct = rope + (half ? 8192 : 0) + pos * 16 + (sub & 1) * 8; const float* st = ct + (half ? 1024 : 4096);
    const f32x4 c0 = *(const GAS f32x4*)ct, c1 = *(const GAS f32x4*)(ct + 4), s0 = *(const GAS f32x4*)st, s1 = *(const GAS f32x4*)(st + 4);
    const float sgn = (sub & 2) ? 1.0f : -1.0f;
    float o[8];
#pragma unroll
    for (int e = 0; e < 8; ++e) { const float py = __shfl_xor(y[e], 2); const float c = e < 4 ? c0[e] : c1[e - 4], sn = e < 4 ? s0[e] : s1[e - 4]; o[e] = (y[e] * c + sgn * py * sn) * post; }
    v4u r; r.x = pk2(o[0], o[1]); r.y = pk2(o[2], o[3]); r.z = pk2(o[4], o[5]); r.w = pk2(o[6], o[7]);
    *(GAS v4u*)p = r;
}
__device__ __forceinline__ void p_prep_qk2(Frame& F) {
    bf16* Q = wsp<bf16>(F, WS_QO); bf16* Kr = wsp<bf16>(F, WS_KR); const float* rope = wsp<float>(F, WS_ROPE);
    const int sub = F.lane & 7, gv = (blockIdx.x * (NWAVES * 64) + F.tid) >> 3, NGV = (F.G * NWAVES * 64) >> 3;
    for (int v = gv; v < M * 16; v += NGV) prep_vec(Q + (size_t)v * 64 + sub * 8, F.in[8], rope, v >> 4, sub, C2Q);
    for (int v = gv; v < M * 4; v += NGV) prep_vec(Kr + (size_t)v * 64 + sub * 8, F.in[9], rope, v >> 2, sub, 1.0f);
}
__device__ __forceinline__ void p_fftA_simple(Frame& F) {
    const bf16* X = wsp<bf16>(F, WS_F); bf16* A = wsp<bf16>(F, WS_HB16); const f32x2* tw = wsp<f32x2>(F, WS_TW); const f32x2* dft = wsp<f32x2>(F, WS_DFT);
    LAS bf16* Xs = (LAS bf16*)F.lds; LAS f32x2* tab = (LAS f32x2*)(F.lds + 65536);
    if (F.tid < 128) tab[F.tid] = dft[F.tid];
    for (int unit = blockIdx.x; unit < 512; unit += F.G) {
        const int t2 = unit >> 2, g = unit & 3;
        __syncthreads();
#pragma unroll
        for (int i = 0; i < 4; ++i) { const int q = F.tid + 512 * i, row = q >> 4, ch = q & 15;
            *(LAS v4u*)(Xs + row * 128 + ch * 8) = *(const GAS v4u*)(X + (size_t)(128 * row + t2) * NCH + g * 128 + ch * 8); }
        __syncthreads();
        const int c = F.tid & 127, kq = F.tid >> 7;
        for (int k1 = kq * 32; k1 < kq * 32 + 32; ++k1) {
            float ar = 0.f, ai = 0.f; int idx = 0;
#pragma unroll 8
            for (int t1 = 0; t1 < 128; ++t1) { const float x = bf2f(Xs[t1 * 128 + c]); const f32x2 cs = tab[idx]; ar += x * cs.x; ai -= x * cs.y; idx = (idx + k1) & 127; }
            ar *= 0.08838834764831845f; ai *= 0.08838834764831845f;
            const f32x2 w = tw[t2 * k1];
            const float br = ar * w.x + ai * w.y, bi = ai * w.x - ar * w.y;
            bf16* o = A + ((size_t)(k1 * 128 + t2) * 4 + g) * 256 + c;
            o[0] = (bf16)f2bf(br); o[128] = (bf16)f2bf(bi);
        }
    }
    __syncthreads();
}
__device__ __forceinline__ void p_fftB_simple(Frame& F) {
    const bf16* A = wsp<bf16>(F, WS_HB16); bf16* U = wsp<bf16>(F, WS_U); const f32x2* dft = wsp<f32x2>(F, WS_DFT);
    LAS bf16* As = (LAS bf16*)F.lds; LAS f32x2* tab = (LAS f32x2*)(F.lds + 65536);
    if (F.tid < 128) tab[F.tid] = dft[F.tid];
    for (int unit = blockIdx.x; unit < 512; unit += F.G) {
        const int k1 = unit >> 2, g = unit & 3;
        __syncthreads();
#pragma unroll
        for (int i = 0; i < 8; ++i) { const int q = F.tid + 512 * i, row = q >> 5, ch = q & 31;
            *(LAS v4u*)(As + row * 256 + ch * 8) = *(const GAS v4u*)(A + ((size_t)(k1 * 128 + row) * 4 + g) * 256 + ch * 8); }
        __syncthreads();
        const int c = F.tid & 127, kq = F.tid >> 7;
        for (int k2 = kq * 32; k2 < kq * 32 + 32; ++k2) {
            float ur = 0.f, ui = 0.f; int idx = 0;
#pragma unroll 8
            for (int t2 = 0; t2 < 128; ++t2) { const float ar = bf2f(As[t2 * 256 + c]), ai = bf2f(As[t2 * 256 + 128 + c]); const f32x2 cs = tab[idx];
                ur += ar * cs.x + ai * cs.y; ui += ai * cs.x - ar * cs.y; idx = (idx + k2) & 127; }
            bf16* o = U + (size_t)(k1 + 128 * k2) * 1024 + g * 256 + c;
            o[0] = (bf16)f2bf(ur * 0.08838834764831845f); o[128] = (bf16)f2bf(ui * 0.08838834764831845f);
        }
    }
    __syncthreads();
}
__device__ __forceinline__ void p_attn_simple(Frame& F) {
    bf16* Q = wsp<bf16>(F, WS_QO); const bf16* Kr = wsp<bf16>(F, WS_KR); const bf16* Vr = wsp<bf16>(F, WS_VR);
    const int gt = blockIdx.x * (NWAVES * 64) + F.tid, NGT = F.G * NWAVES * 64;
    for (int it = gt; it < M * 16; it += NGT) {
        const int h = it >> 14, t = it & (M - 1), kvh = h >> 2;
        bf16* qp = Q + (size_t)t * 1024 + h * 64;
        float q[64], o[64];
#pragma unroll
        for (int i = 0; i < 8; ++i) { const v4u w = *(const GAS v4u*)(qp + 8 * i);
            q[8 * i + 0] = bflo_(w.x); q[8 * i + 1] = bfhi_(w.x); q[8 * i + 2] = bflo_(w.y); q[8 * i + 3] = bfhi_(w.y); q[8 * i + 4] = bflo_(w.z); q[8 * i + 5] = bfhi_(w.z); q[8 * i + 6] = bflo_(w.w); q[8 * i + 7] = bfhi_(w.w); }
#pragma unroll
        for (int i = 0; i < 64; ++i) o[i] = 0.f;
        float mx = -1e30f, l = 0.f;
        for (int key = 0; key < M; ++key) {
            const bf16* kp = Kr + (size_t)key * 256 + kvh * 64; const bf16* vp = Vr + (size_t)key * 256 + kvh * 64;
            float s = 0.f;
#pragma unroll
            for (int i = 0; i < 8; ++i) { const v4u w = *(const GAS v4u*)(kp + 8 * i);
                s += q[8 * i + 0] * bflo_(w.x) + q[8 * i + 1] * bfhi_(w.x) + q[8 * i + 2] * bflo_(w.y) + q[8 * i + 3] * bfhi_(w.y) + q[8 * i + 4] * bflo_(w.z) + q[8 * i + 5] * bfhi_(w.z) + q[8 * i + 6] * bflo_(w.w) + q[8 * i + 7] * bfhi_(w.w); }
            const float mn = fmaxf(mx, s), al = __builtin_amdgcn_exp2f(mx - mn), p = __builtin_amdgcn_exp2f(s - mn);
            l = l * al + p; mx = mn;
#pragma unroll
            for (int i = 0; i < 8; ++i) { const v4u w = *(const GAS v4u*)(vp + 8 * i);
                o[8 * i + 0] = o[8 * i + 0] * al + p * bflo_(w.x); o[8 * i + 1] = o[8 * i + 1] * al + p * bfhi_(w.x); o[8 * i + 2] = o[8 * i + 2] * al + p * bflo_(w.y); o[8 * i + 3] = o[8 * i + 3] * al + p * bfhi_(w.y);
                o[8 * i + 4] = o[8 * i + 4] * al + p * bflo_(w.z); o[8 * i + 5] = o[8 * i + 5] * al + p * bfhi_(w.z); o[8 * i + 6] = o[8 * i + 6] * al + p * bflo_(w.w); o[8 * i + 7] = o[8 * i + 7] * al + p * bfhi_(w.w); }
        }
        const float li = 1.0f / l;
#pragma unroll
        for (int i = 0; i < 8; ++i) { v4u w; w.x = pk2(o[8 * i] * li, o[8 * i + 1] * li); w.y = pk2(o[8 * i + 2] * li, o[8 * i + 3] * li); w.z = pk2(o[8 * i + 4] * li, o[8 * i + 5] * li); w.w = pk2(o[8 * i + 6] * li, o[8 * i + 7] * li);
            *(GAS v4u*)(qp + 8 * i) = w; }
    }
}
__device__ __forceinline__ void p_cross_simple(Frame& F) {
    const bf16* QC = wsp<bf16>(F, WS_QC); bf16* OC = wsp<bf16>(F, WS_OC); const bf16* Kc = wsp<bf16>(F, WS_KC); const bf16* Vc = wsp<bf16>(F, WS_VC);
    const int gt = blockIdx.x * (NWAVES * 64) + F.tid, NGT = F.G * NWAVES * 64;
    for (int it = gt; it < M * 4; it += NGT) {
        const int h = it >> 14, t = it & (M - 1);
        const bf16* qp = QC + (size_t)t * 256 + h * 64;
        float q[64], o[64];
#pragma unroll
        for (int i = 0; i < 8; ++i) { const v4u w = *(const GAS v4u*)(qp + 8 * i);
            q[8 * i + 0] = bflo_(w.x) * C2Q; q[8 * i + 1] = bfhi_(w.x) * C2Q; q[8 * i + 2] = bflo_(w.y) * C2Q; q[8 * i + 3] = bfhi_(w.y) * C2Q; q[8 * i + 4] = bflo_(w.z) * C2Q; q[8 * i + 5] = bfhi_(w.z) * C2Q; q[8 * i + 6] = bflo_(w.w) * C2Q; q[8 * i + 7] = bfhi_(w.w) * C2Q; }
#pragma unroll
        for (int i = 0; i < 64; ++i) o[i] = 0.f;
        float mx = -1e30f, l = 0.f;
        for (int key = 0; key < MEMLEN; ++key) {
            const bf16* kp = Kc + key * 256 + h * 64; const bf16* vp = Vc + key * 256 + h * 64;
            float s = 0.f;
#pragma unroll
            for (int i = 0; i < 8; ++i) { const v4u w = *(const GAS v4u*)(kp + 8 * i);
                s += q[8 * i + 0] * bflo_(w.x) + q[8 * i + 1] * bfhi_(w.x) + q[8 * i + 2] * bflo_(w.y) + q[8 * i + 3] * bfhi_(w.y) + q[8 * i + 4] * bflo_(w.z) + q[8 * i + 5] * bfhi_(w.z) + q[8 * i + 6] * bflo_(w.w) + q[8 * i + 7] * bfhi_(w.w); }
            const float mn = fmaxf(mx, s), al = __builtin_amdgcn_exp2f(mx - mn), p = __builtin_amdgcn_exp2f(s - mn);
            l = l * al + p; mx = mn;
#pragma unroll
            for (int i = 0; i < 8; ++i) { const v4u w = *(const GAS v4u*)(vp + 8 * i);
                o[8 * i + 0] = o[8 * i + 0] * al + p * bflo_(w.x); o[8 * i + 1] = o[8 * i + 1] * al + p * bfhi_(w.x); o[8 * i + 2] = o[8 * i + 2] * al + p * bflo_(w.y); o[8 * i + 3] = o[8 * i + 3] * al + p * bfhi_(w.y);
                o[8 * i + 4] = o[8 * i + 4] * al + p * bflo_(w.z); o[8 * i + 5] = o[8 * i + 5] * al + p * bfhi_(w.z); o[8 * i + 6] = o[8 * i + 6] * al + p * bflo_(w.w); o[8 * i + 7] = o[8 * i + 7] * al + p * bfhi_(w.w); }
        }
        const float li = 1.0f / l; bf16* op = OC + (size_t)t * 256 + h * 64;
#pragma unroll
        for (int i = 0; i < 8; ++i) { v4u w; w.x = pk2(o[8 * i] * li, o[8 * i + 1] * li); w.y = pk2(o[8 * i + 2] * li, o[8 * i + 3] * li); w.z = pk2(o[8 * i + 4] * li, o[8 * i + 5] * li); w.w = pk2(o[8 * i + 6] * li, o[8 * i + 7] * li);
            *(GAS v4u*)(op + 8 * i) = w; }
    }
}
__device__ __forceinline__ void p_final(Frame& F) {
    const int gw = F.vcu * NWAVES + F.wave, NGW = F.G * NWAVES; const float* gf = F.in[23];
    f32x4 gv[4];
#pragma unroll
    for (int j = 0; j < 4; ++j) gv[j] = ((const GAS f32x4*)gf)[F.lane + 64 * j];
    for (int m = gw; m < M; m += NGW) {
        GAS f32x4* xr = (GAS f32x4*)(F.out + (size_t)m * D) + F.lane;
        f32x4 v[4]; float s = 0.f;
#pragma unroll
        for (int j = 0; j < 4; ++j) { v[j] = xr[64 * j]; s += (v[j].x * v[j].x + v[j].y * v[j].y) + (v[j].z * v[j].z + v[j].w * v[j].w); }
        const float rinv = 1.0f / sqrtf(wave_sum(s) * (1.0f / D) + RMS_EPSF);
#pragma unroll
        for (int j = 0; j < 4; ++j) xr[64 * j] = v[j] * rinv * gv[j];
    }
}
namespace fftm {
typedef short bf16x8 __attribute__((ext_vector_type(8)));
typedef short s16x4 __attribute__((ext_vector_type(4)));
typedef float f32x16 __attribute__((ext_vector_type(16)));
typedef short v4i16_t __attribute__((ext_vector_type(4)));
typedef LAS const unsigned char* lptr;
constexpr int STR_A = 320, STR_B = 576;
constexpr float RSQ128 = 0.08838834764831845f;
#define FFT_MFMA(a, b, c) __builtin_amdgcn_mfma_f32_32x32x16_bf16(a, b, c, 0, 0, 0)
__device__ __forceinline__ s16x4 vtr(lptr p) { return __builtin_bit_cast(s16x4, __builtin_amdgcn_ds_read_tr16_b64_v4i16((LAS v4i16_t*)p)); }
struct DftFrags { bf16x8 c[8], s[8]; };
__device__ __forceinline__ void make_frags(DftFrags& f, const f32x2* dft, int jb, int lane) {
    const int j = 32 * jb + (lane & 31), h = lane >> 5;
#pragma unroll
    for (int s = 0; s < 8; ++s)
#pragma unroll
        for (int e = 0; e < 8; ++e) { const f32x2 cs = dft[(j * (16 * s + 8 * h + e)) & 127]; f.c[s][e] = (short)f2bf(cs.x * RSQ128); f.s[s][e] = (short)f2bf(cs.y * RSQ128); }
}
template <int STRIDE> __device__ __forceinline__ bf16x8 tfrag(lptr p, int s) {
    const s16x4 lo = vtr(p + 16 * s * STRIDE), hi = vtr(p + 16 * s * STRIDE + 4 * STRIDE);
    return (bf16x8){lo[0], lo[1], lo[2], lo[3], hi[0], hi[1], hi[2], hi[3]};
}
template <int STRIDE> __device__ __forceinline__ int tfrag_lane_off(int lane) {
    const int g4 = lane >> 4, c0 = 16 * (g4 & 1), h = g4 >> 1, li = lane & 15, q = li >> 2, p = li & 3;
    return (8 * h + q) * STRIDE + (c0 + 4 * p) * 2;
}
__device__ __forceinline__ unsigned long long pk4(float a, float b, float c, float d) { return (unsigned long long)pg8::cvt_pk_bf16(a, b) | ((unsigned long long)pg8::cvt_pk_bf16(c, d) << 32); }

__device__ __forceinline__ void stageA(Frame& F) {
    const bf16* X = wsp<bf16>(F, WS_F); bf16* A = wsp<bf16>(F, WS_HB16); const f32x2* tw = wsp<f32x2>(F, WS_TW); const f32x2* dft = wsp<f32x2>(F, WS_DFT);
    const int jb = F.wave & 3, chh = F.wave >> 2, lane = F.lane, h = lane >> 5;
    DftFrags fr; make_frags(fr, dft, jb, lane);
    const lptr tp = (lptr)F.lds + tfrag_lane_off<STR_A>(lane) + 128 * chh;
    const int k1 = 32 * jb + (lane & 31);
    v4u pre[4];
    int unit = blockIdx.x;
    if (unit < 512) {
#pragma unroll
        for (int i = 0; i < 4; ++i) { const int q = F.tid + 512 * i, row = q >> 4, ch = q & 15; pre[i] = *(const GAS v4u*)(X + (size_t)(128 * row + (unit >> 2)) * NCH + (unit & 3) * 128 + ch * 8); }
    }
    for (; unit < 512; unit += F.G) {
        const int t2 = unit >> 2, g = unit & 3;
        __syncthreads();
#pragma unroll
        for (int i = 0; i < 4; ++i) { const int q = F.tid + 512 * i, row = q >> 4, ch = q & 15; *(LAS v4u*)(F.lds + row * STR_A + ch * 16) = pre[i]; }
        __syncthreads();
        const int nu = unit + F.G;
        if (nu < 512) {
#pragma unroll
            for (int i = 0; i < 4; ++i) { const int q = F.tid + 512 * i, row = q >> 4, ch = q & 15; pre[i] = *(const GAS v4u*)(X + (size_t)(128 * row + (nu >> 2)) * NCH + (nu & 3) * 128 + ch * 8); }
        }
        f32x16 acc[2][2];
#pragma unroll
        for (int cb = 0; cb < 2; ++cb) { acc[cb][0] = f32x16{}; acc[cb][1] = f32x16{}; }
#pragma unroll
        for (int s = 0; s < 8; ++s)
#pragma unroll
            for (int cb = 0; cb < 2; ++cb) { const bf16x8 a = tfrag<STR_A>(tp + 64 * cb, s); acc[cb][0] = FFT_MFMA(a, fr.c[s], acc[cb][0]); acc[cb][1] = FFT_MFMA(a, fr.s[s], acc[cb][1]); }
        const f32x2 w = tw[t2 * k1];
        bf16* orow = A + ((size_t)(k1 * 128 + t2) * 4 + g) * 256 + 64 * chh + 4 * h;
#pragma unroll
        for (int cb = 0; cb < 2; ++cb)
#pragma unroll
            for (int qd = 0; qd < 4; ++qd) {
                float re[4], im[4];
#pragma unroll
                for (int i = 0; i < 4; ++i) { const float a0 = acc[cb][0][4 * qd + i], a1 = acc[cb][1][4 * qd + i]; re[i] = a0 * w.x - a1 * w.y; im[i] = -a1 * w.x - a0 * w.y; }
                *(GAS unsigned long long*)(orow + 32 * cb + 8 * qd) = pk4(re[0], re[1], re[2], re[3]);
                *(GAS unsigned long long*)(orow + 128 + 32 * cb + 8 * qd) = pk4(im[0], im[1], im[2], im[3]);
            }
    }
    __syncthreads();
}
__device__ __forceinline__ void stageB(Frame& F) {
    const bf16* A = wsp<bf16>(F, WS_HB16); bf16* U = wsp<bf16>(F, WS_U); const f32x2* dft = wsp<f32x2>(F, WS_DFT);
    const int jb = F.wave & 3, chh = F.wave >> 2, lane = F.lane, h = lane >> 5;
    DftFrags fr; make_frags(fr, dft, jb, lane);
    const lptr tp = (lptr)F.lds + tfrag_lane_off<STR_B>(lane) + 128 * chh;
    const int k2 = 32 * jb + (lane & 31);
    v4u pre[8];
    int unit = blockIdx.x;
    if (unit < 512) {
#pragma unroll
        for (int i = 0; i < 8; ++i) { const int q = F.tid + 512 * i, row = q >> 5, ch = q & 31; pre[i] = *(const GAS v4u*)(A + ((size_t)((unit >> 2) * 128 + row) * 4 + (unit & 3)) * 256 + ch * 8); }
    }
    for (; unit < 512; unit += F.G) {
        const int k1 = unit >> 2, g = unit & 3;
        __syncthreads();
#pragma unroll
        for (int i = 0; i < 8; ++i) { const int q = F.tid + 512 * i, row = q >> 5, ch = q & 31; *(LAS v4u*)(F.lds + row * STR_B + ch * 16) = pre[i]; }
        __syncthreads();
        const int nu = unit + F.G;
        if (nu < 512) {
#pragma unroll
            for (int i = 0; i < 8; ++i) { const int q = F.tid + 512 * i, row = q >> 5, ch = q & 31; pre[i] = *(const GAS v4u*)(A + ((size_t)((nu >> 2) * 128 + row) * 4 + (nu & 3)) * 256 + ch * 8); }
        }
        f32x16 accR[2], accI[2];
#pragma unroll
        for (int cb = 0; cb < 2; ++cb) { accR[cb] = f32x16{}; accI[cb] = f32x16{}; }
#pragma unroll
        for (int s = 0; s < 8; ++s) {
            const bf16x8 ns = fr.s[s] ^ (short)0x8000;
#pragma unroll
            for (int cb = 0; cb < 2; ++cb) {
                const bf16x8 ar = tfrag<STR_B>(tp + 64 * cb, s), ai = tfrag<STR_B>(tp + 256 + 64 * cb, s);
                accR[cb] = FFT_MFMA(ar, fr.c[s], accR[cb]); accR[cb] = FFT_MFMA(ai, fr.s[s], accR[cb]);
                accI[cb] = FFT_MFMA(ai, fr.c[s], accI[cb]); accI[cb] = FFT_MFMA(ar, ns, accI[cb]);
            }
        }
        bf16* orow = U + (size_t)(k1 + 128 * k2) * 1024 + g * 256 + 64 * chh + 4 * h;
#pragma unroll
        for (int cb = 0; cb < 2; ++cb)
#pragma unroll
            for (int qd = 0; qd < 4; ++qd) {
                *(GAS unsigned long long*)(orow + 32 * cb + 8 * qd) = pk4(accR[cb][4 * qd], accR[cb][4 * qd + 1], accR[cb][4 * qd + 2], accR[cb][4 * qd + 3]);
                *(GAS unsigned long long*)(orow + 128 + 32 * cb + 8 * qd) = pk4(accI[cb][4 * qd], accI[cb][4 * qd + 1], accI[cb][4 * qd + 2], accI[cb][4 * qd + 3]);
            }
    }
    __syncthreads();
}
#undef FFT_MFMA
}
#define XB_TMO      128
#define XB_XCNT(j)  (256  + 64 * (j))
#define XB_XSUB(j)  (1280 + 64 * (j))
#define XB_XGEN(j)  (2304 + 64 * (j))
#define XB_TOP      3328
#define XB_TOPGEN   3392
#define XCD_BAR_WORDS 3456
#define XB_SPIN_CAP (1u << 18)

__device__ __forceinline__ unsigned xb_ld(unsigned* p)              { return __hip_atomic_load(p, __ATOMIC_RELAXED, __HIP_MEMORY_SCOPE_AGENT); }
__device__ __forceinline__ unsigned xb_add(unsigned* p, unsigned v) { return __hip_atomic_fetch_add(p, v, __ATOMIC_RELAXED, __HIP_MEMORY_SCOPE_AGENT); }
__device__ __forceinline__ unsigned xb_xcc_id() { return (unsigned)__builtin_amdgcn_s_getreg((3 << 11) | 20) & 0xFu; }
#define XB_SPIN(cond, bar) do { unsigned _sp = 0; while (cond) { __builtin_amdgcn_s_sleep(1); \
    if ((++_sp & 255u) == 0u) { if (xb_ld(&(bar)[XB_TMO])) break; if (_sp > XB_SPIN_CAP) { atomicAdd(&(bar)[XB_TMO], 1u); break; } } } } while (0)

struct XcdBarrier {
    unsigned* bar; unsigned x;
    volatile LAS unsigned* st;
};

__device__ __forceinline__ XcdBarrier xcd_barrier_post(unsigned* bar, volatile LAS unsigned* st) {
    XcdBarrier b; b.bar = bar; b.x = xb_xcc_id(); b.st = st;
    if (threadIdx.x == 0) (void)xb_add(&bar[XB_XCNT(b.x)], 1u);
    return b;
}
__device__ __forceinline__ void xcd_barrier_complete(unsigned* bar, unsigned x, unsigned& nloc, unsigned& nx) {
    const unsigned G = gridDim.x * gridDim.y * gridDim.z;
    unsigned sum, cnt, mine, sp = 0u;
    for (;;) {
        sum = 0u; cnt = 0u; mine = 0u;
#pragma unroll
        for (unsigned j = 0; j < 16; ++j) { const unsigned c = xb_ld(&bar[XB_XCNT(j)]); sum += c; cnt += (c > 0u) ? 1u : 0u; mine = (j == x) ? c : mine; }
        if (sum == G) break;
        __builtin_amdgcn_s_sleep(1);
        if ((++sp & 255u) == 0u) { if (xb_ld(&bar[XB_TMO])) break; if (sp > XB_SPIN_CAP) { atomicAdd(&bar[XB_TMO], 1u); break; } }
    }
    nloc = mine > 0u ? mine : 1u; nx = cnt > 0u ? cnt : 1u;
}

__device__ __forceinline__ void xcd_barrier(const XcdBarrier& b) {
    asm volatile("s_waitcnt vmcnt(0)" ::: "memory");
    __syncthreads();
    if (threadIdx.x == 0) {
        unsigned* bar = b.bar;
        __builtin_amdgcn_s_waitcnt(0);
        unsigned nloc = b.st[0], nx = b.st[1];
        if (nloc == 0u) { xcd_barrier_complete(bar, b.x, nloc, nx); b.st[0] = nloc; b.st[1] = nx; }
        const unsigned old = xb_add(&bar[XB_XSUB(b.x)], 1u);
        const unsigned gen = old / nloc;
        if (old + 1u == (gen + 1u) * nloc) {
            __builtin_amdgcn_fence(__ATOMIC_RELEASE, "agent");
            asm volatile("s_waitcnt vmcnt(0)" ::: "memory");
            const unsigned og = xb_add(&bar[XB_TOP], 1u);
            const unsigned tg = og / nx;
            if (og + 1u == (tg + 1u) * nx) xb_add(&bar[XB_TOPGEN], 1u);
            else XB_SPIN(xb_ld(&bar[XB_TOPGEN]) == tg, bar);
            __builtin_amdgcn_fence(__ATOMIC_ACQUIRE, "agent");
            xb_add(&bar[XB_XGEN(b.x)], 1u);
            asm volatile("s_waitcnt vmcnt(0)" ::: "memory");
        } else {
            XB_SPIN(xb_ld(&bar[XB_XGEN(b.x)]) == gen, bar);
            __builtin_amdgcn_fence(__ATOMIC_ACQUIRE, "agent");
            asm volatile("s_waitcnt vmcnt(0)" ::: "memory");
        }
    }
    __syncthreads();
}
constexpr int N_PHASES = 15;
struct Args { const float* in[24]; float* out; unsigned char* ws; int ph_lo, ph_hi; };
__global__ void __launch_bounds__(NWAVES * 64, 2) mk_fwd(Args args) {
    extern __shared__ __attribute__((aligned(16))) unsigned char lds[];
    Frame F;
    F.lds = (LAS unsigned char*)lds;
    F.tid = threadIdx.x; F.lane = F.tid & 63; F.wave = __builtin_amdgcn_readfirstlane(F.tid >> 6);
    F.G = gridDim.x; { const int bx = blockIdx.x; F.vcu = (F.G % 8 == 0) ? (bx % 8) * (F.G / 8) + bx / 8 : bx; }
#pragma unroll
    for (int i = 0; i < 24; ++i) F.in[i] = args.in[i];
    F.out = args.out; F.ws = args.ws;
    const int lo = args.ph_lo, hi = args.ph_hi;
    for (int u = F.tid; u < (LDS_BYTES - LDSCTL_OFF) / 4; u += NWAVES * 64) ((LAS unsigned*)(F.lds + LDSCTL_OFF))[u] = 0u;
    __syncthreads();
    XcdBarrier bar = xcd_barrier_post((unsigned*)(F.ws + WS_CTL) + CW_BAR, (volatile LAS unsigned*)(F.lds + MISC_OFF) + 8);
#define IN(k) (lo <= (k) && (k) < hi)
#define BOTH(k) (IN(k) && IN((k) + 1))
#define GRID_BAR() xcd_barrier(bar)
#define GRID_BAR_CG() do { cooperative_groups::this_grid().sync(); } while (0)
    bf16* const HB16 = wsp<bf16>(F, WS_HB16); bf16* const HH = wsp<bf16>(F, WS_R1);
    bf16* const QO = wsp<bf16>(F, WS_QO); bf16* const UU = wsp<bf16>(F, WS_U); bf16* const KR = wsp<bf16>(F, WS_KR); bf16* const VR = wsp<bf16>(F, WS_VR); bf16* const FB = wsp<bf16>(F, WS_F);
    bf16* const GFB = wsp<bf16>(F, WS_GF); bf16* const GAB = wsp<bf16>(F, WS_GA); bf16* const QC = wsp<bf16>(F, WS_QC); bf16* const OC = wsp<bf16>(F, WS_OC);
    float* const SS2 = wsp<float>(F, WS_SS2); float* const SS3 = wsp<float>(F, WS_SS3); float* const SS4 = wsp<float>(F, WS_SS4);

#if defined(MK_PROBE_MASK)
    unsigned long long pr_prev = __builtin_amdgcn_s_memrealtime(), pr_acc = 0ull;
#define PROBE_END(k) do { const unsigned long long _t = __builtin_amdgcn_s_memrealtime(); if ((MK_PROBE_MASK >> (k)) & 1) pr_acc += _t - pr_prev; pr_prev = _t; } while (0)
#else
#define PROBE_END(k) do { } while (0)
#endif
    if (IN(0)) { p0_prologue(F); if (BOTH(0)) GRID_BAR_CG(); PROBE_END(0); }
    if (IN(1)) {
        pg8::Gemm g{HB16, wsp<bf16>(F, WS_W1GU), M, 2 * FF, D}; pg8::StaticOrder S; S.init(M, 2 * FF, F.G, (int)blockIdx.x);
        pg8::EpiSwiGLU E{HH, FF, wsp<float>(F, WS_RS1), 0};
        pg8::gemm_phase<pg8::EpiSwiGLU, pg8::StaticOrder, true, true>(F.lds, g, S, E);
        if (BOTH(1)) GRID_BAR(); PROBE_END(1);
    }
    if (IN(2)) {
        pg8::Gemm g{HH, wsp<bf16>(F, WS_W1D), M, D, FF}; pg8::StaticOrder S; S.init(M, D, F.G, (int)blockIdx.x);
        pg8::EpiResid E{F.in[0], F.out, HB16, SS2, 0.5f, D};
        pg8::gemm_phase<pg8::EpiResid, pg8::StaticOrder, true, true>(F.lds, g, S, E);
        if (BOTH(2)) GRID_BAR(); PROBE_END(2);
    }
    if (IN(3)) {
        pg8::Gemm g{HB16, wsp<bf16>(F, WS_WIN), M, NIN, D}; pg8::StaticOrder S; S.init(M, NIN, F.G, (int)blockIdx.x);
        pg8::EpiRoute E{{QO, KR, VR, FB, GFB, GAB}, SS2, 1, 1, 0, 1.0f};
        pg8::gemm_phase<pg8::EpiRoute, pg8::StaticOrder, true, true>(F.lds, g, S, E);
        if (BOTH(3)) GRID_BAR(); PROBE_END(3);
    }
    if (IN(4)) {
#if defined(PREP_SIMPLE)
        p_prep_qk(F);
#else
        p_prep_qk2(F);
#endif
#if defined(FFT_SIMPLE) || defined(FFTA_SIMPLE)
        p_fftA_simple(F);
#else
        fftm::stageA(F);
#endif
        if (BOTH(4)) GRID_BAR(); PROBE_END(4); }
    if (IN(5)) {
#if defined(FFT_SIMPLE) || defined(FFTB_SIMPLE)
        p_fftB_simple(F);
#else
        fftm::stageB(F);
#endif
        if (BOTH(5)) GRID_BAR(); PROBE_END(5); }
    if (IN(6)) {
#if defined(ATTN_SIMPLE)
        p_attn_simple(F);
#else
        static_assert(attn_body::ATTN_LDS_BYTES <= RING_BYTES, "attention LDS");
        const attn_body::AttnTensors AT{(const attn_body::bf16*)QO, (const attn_body::bf16*)KR, (const attn_body::bf16*)VR, (attn_body::bf16*)QO};
        const attn_body::StaticOrder S((int)F.G, (int)blockIdx.x);
        float gq = fabsf(F.in[8][F.lane]), gk = fabsf(F.in[9][F.lane]);
#pragma unroll
        for (int o = 1; o < 64; o <<= 1) { gq = fmaxf(gq, __shfl_xor(gq, o)); gk = fmaxf(gk, __shfl_xor(gk, o)); }
        const float mfix = 1.02f * C2Q * 64.0f * gq * gk;
#if defined(ATTN_TRACKMAX)
        attn_body::attn_phase<attn_body::StaticOrder, 1024, 256, 16384, 4, false>((char*)lds, AT, S, 0.f);
#else
        attn_body::attn_phase<attn_body::StaticOrder, 1024, 256, 16384, 4, true>((char*)lds, AT, S, mfix);
#endif
#endif
        if (BOTH(6)) GRID_BAR(); PROBE_END(6);
    }
    if (IN(7)) {
        { pg8::Gemm g{UU, wsp<bf16>(F, WS_WFB), M, D, D}; pg8::StaticOrder S; S.init(M, D, F.G, (int)blockIdx.x);
          pg8::EpiGate E{GFB, nullptr, 1};
          pg8::gemm_phase<pg8::EpiGate, pg8::StaticOrder, true, true>(F.lds, g, S, E); }
        { pg8::Gemm g{QO, wsp<bf16>(F, WS_WAB), M, D, D}; pg8::StaticOrder S; S.init(M, D, F.G, (int)blockIdx.x);
          pg8::EpiGate E{GAB, GFB, 2};
          pg8::gemm_phase<pg8::EpiGate, pg8::StaticOrder, true, true>(F.lds, g, S, E); }
        if (BOTH(7)) GRID_BAR(); PROBE_END(7);
    }
    if (IN(8)) {
        pg8::Gemm g{GAB, wsp<bf16>(F, WS_WOUT), M, D, D}; pg8::StaticOrder S; S.init(M, D, F.G, (int)blockIdx.x);
        pg8::EpiResid E{F.out, F.out, HB16, SS3, 1.0f, D};
        pg8::gemm_phase<pg8::EpiResid, pg8::StaticOrder, true, true>(F.lds, g, S, E);
        if (BOTH(8)) GRID_BAR(); PROBE_END(8);
    }
    if (IN(9)) {
        pg8::Gemm g{HB16, wsp<bf16>(F, WS_WCQ), M, 256, D}; pg8::StaticOrder S; S.init(M, 256, F.G, (int)blockIdx.x);
        #if defined(CROSS_SIMPLE)
        pg8::EpiRoute E{{QC, nullptr, nullptr, nullptr, nullptr, nullptr}, SS3, 1, 0, 256, 1.0f};
#else
        pg8::EpiRoute E{{QC, nullptr, nullptr, nullptr, nullptr, nullptr}, SS3, 1, 0, 256, C2Q};
#endif
        pg8::gemm_phase<pg8::EpiRoute, pg8::StaticOrder, true, true>(F.lds, g, S, E);
        if (BOTH(9)) GRID_BAR(); PROBE_END(9);
    }
    if (IN(10)) {
#if defined(CROSS_SIMPLE)
        p_cross_simple(F);
#else
        const attn_body::AttnTensors AT{(const attn_body::bf16*)QC, (const attn_body::bf16*)wsp<bf16>(F, WS_KC), (const attn_body::bf16*)wsp<bf16>(F, WS_VC), (attn_body::bf16*)OC};
        const attn_body::CrossOrder S((int)F.G, (int)blockIdx.x);
        attn_body::attn_phase<attn_body::CrossOrder, 256, 256, 256, 1, false>((char*)lds, AT, S, 0.f);
#endif
        if (BOTH(10)) GRID_BAR(); PROBE_END(10);
    }
    if (IN(11)) {
        pg8::Gemm g{OC, wsp<bf16>(F, WS_WCO), M, D, 256}; pg8::StaticOrder S; S.init(M, D, F.G, (int)blockIdx.x);
        pg8::EpiResid E{F.out, F.out, HB16, SS4, 1.0f, D};
        pg8::gemm_phase<pg8::EpiResid, pg8::StaticOrder, true, true>(F.lds, g, S, E);
        if (BOTH(11)) GRID_BAR(); PROBE_END(11);
    }
    if (IN(12)) {
        pg8::Gemm g{HB16, wsp<bf16>(F, WS_W2GU), M, 2 * FF, D}; pg8::StaticOrder S; S.init(M, 2 * FF, F.G, (int)blockIdx.x);
        pg8::EpiSwiGLU E{HH, FF, SS4, 1};
        pg8::gemm_phase<pg8::EpiSwiGLU, pg8::StaticOrder, true, true>(F.lds, g, S, E);
        if (BOTH(12)) GRID_BAR(); PROBE_END(12);
    }
    if (IN(13)) {
        pg8::Gemm g{HH, wsp<bf16>(F, WS_W2D), M, D, FF}; pg8::StaticOrder S; S.init(M, D, F.G, (int)blockIdx.x);
        pg8::EpiResid E{F.out, F.out, nullptr, nullptr, 0.5f, D};
        pg8::gemm_phase<pg8::EpiResid, pg8::StaticOrder, true, true>(F.lds, g, S, E);
        if (BOTH(13)) GRID_BAR(); PROBE_END(13);
    }
    if (IN(14)) { p_final(F); PROBE_END(14); }
#if defined(MK_PROBE_MASK)
    if (blockIdx.x == 0) {
        if (F.tid == 0) { const unsigned long long t0 = __builtin_amdgcn_s_memrealtime(); while (__builtin_amdgcn_s_memrealtime() - t0 < (unsigned long long)MK_PROBE_AMP * pr_acc) __builtin_amdgcn_s_sleep(8); }
        __syncthreads();
    }
#endif
#undef IN
#undef BOTH
}

extern "C" void kernel_launch(void* const* d_in, const int* in_sizes, int n_in, void* d_out, int out_size, void* d_ws, size_t ws_size, hipStream_t stream) {
    static int grid = 0;
    if (grid == 0) {
        if (n_in != 24 || in_sizes[0] != M * D || out_size != M * D || ws_size < WS_END) {
            fprintf(stderr, "kernel_launch: unexpected shapes: n_in %d in0 %d out %d ws %zu (need %zu)\n", n_in, n_in > 0 ? in_sizes[0] : -1, out_size, ws_size, (size_t)WS_END); grid = -1; return; }
        int dev = 0, cus = 0, per_cu = 0;
        if (hipGetDevice(&dev) != hipSuccess || hipDeviceGetAttribute(&cus, hipDeviceAttributeMultiprocessorCount, dev) != hipSuccess) { grid = -1; return; }
        if (hipFuncSetAttribute((const void*)mk_fwd, hipFuncAttributeMaxDynamicSharedMemorySize, LDS_BYTES) != hipSuccess) { fprintf(stderr, "kernel_launch: hipFuncSetAttribute failed\n"); grid = -1; return; }
        if (hipOccupancyMaxActiveBlocksPerMultiprocessor(&per_cu, (const void*)mk_fwd, NWAVES * 64, LDS_BYTES) != hipSuccess || per_cu < 1) { fprintf(stderr, "kernel_launch: occupancy query says %d\n", per_cu); }
        (void)hipGetLastError();
        grid = cus * (per_cu < 1 ? 1 : 1);
        if (per_cu < 1) { grid = -1; return; }
        if (grid != 256) fprintf(stderr, "kernel_launch: %d CUs (built for 256)\n", grid);
    }
    if (grid < 0) return;
    (void)hipMemsetAsync((char*)d_ws + WS_CTL, 0, CTL_ZERO_BYTES, stream);
    Args a{};
    for (int i = 0; i < 24; ++i) a.in[i] = (const float*)d_in[i];
    a.out = (float*)d_out; a.ws = (unsigned char*)d_ws;
#if defined(MK_MULTI)
    for (int ph = 0; ph < N_PHASES; ++ph) {
        a.ph_lo = ph; a.ph_hi = ph + 1;
        hipLaunchKernelGGL(mk_fwd, dim3(grid), dim3(NWAVES * 64), LDS_BYTES, stream, a);
    }
#else
    a.ph_lo = 0; a.ph_hi = N_PHASES;
    void* kargs[] = {&a};
    const hipError_t e = hipLaunchCooperativeKernel((const void*)mk_fwd, dim3(grid), dim3(NWAVES * 64), kargs, LDS_BYTES, stream);
    if (e != hipSuccess) fprintf(stderr, "kernel_launch: cooperative launch failed: %s (grid %d)\n", hipGetErrorString(e), grid);
#endif
}
```

```cpp
#include <hip/hip_runtime.h>
#include <hip/hip_cooperative_groups.h>
#include <cstdio>
#include <cstdint>
namespace pg8 {
#define PG8_LAS __attribute__((address_space(3)))
typedef unsigned short bf16_t;
typedef short bf16x8 __attribute__((ext_vector_type(8)));
typedef float f32x4 __attribute__((ext_vector_type(4)));
typedef unsigned u32x4 __attribute__((ext_vector_type(4)));
constexpr int BM = 256, BK = 64, HALF = 128, HTB = HALF * BK * 2  , STAGE_BYTES = 8 * HTB, NXCD = 8, WGM = 8;

__host__ __device__ __forceinline__ int lds_byte(int r, int c) { const int st = (r >> 4) * 2 + (c >> 5), rr = r & 15, cc = c & 31, ob = rr * 64 + cc * 2; return st * 1024 + (ob ^ (((ob >> 9) & 1) << 5)); }
__host__ __device__ __forceinline__ void stage_rc(int b, int& R, int& C) { const int st = b / 1024, sb = b % 1024, swz = sb ^ (((sb >> 9) & 1) << 5); R = (st >> 1) * 16 + swz / 64; C = (st & 1) * 32 + (swz % 64) / 2; }
__host__ __device__ __forceinline__ int perm32(int rho) { const int n = rho >> 4, i = rho & 15; return 8 * (i >> 2) + 4 * n + (i & 3); }

struct Unit { int pm, pn; };
struct Gemm { const bf16_t* A; const bf16_t* Bt; int M, N, K; };

struct StaticOrder {
    int nM, nN, nwg, G, c;
    __host__ __device__ void init(int M, int N, int G_, int c_) { nM = M / BM; nN = N / BM; nwg = nM * nN; G = G_; c = c_; }
    __host__ __device__ bool next(int i, Unit& u) const {
        const long L = (long)i * G + c; if (L >= nwg) return false;
        int wgid = (int)L; { const int q = nwg / NXCD, r = nwg % NXCD, xcd = wgid % NXCD, off = wgid / NXCD; wgid = (xcd < r ? xcd * (q + 1) : r * (q + 1) + (xcd - r) * q) + off; }
        const int nig = WGM * nN, gid = wgid / nig, fm = gid * WGM, gsz = (nM - fm) < WGM ? (nM - fm) : WGM;
        u.pm = fm + ((wgid % nig) % gsz); u.pn = (wgid % nig) / gsz; return true;
    }
    __device__ __forceinline__ void a_ready(const Unit&) const {}
    __device__ __forceinline__ void done(const Unit&) const {}
};

typedef float f32x2_cv __attribute__((ext_vector_type(2))); typedef __bf16 bf16x2_cv __attribute__((ext_vector_type(2)));
__device__ __forceinline__ unsigned cvt_pk_bf16(float lo, float hi) { f32x2_cv v = {lo, hi}; bf16x2_cv b = __builtin_convertvector(v, bf16x2_cv); return __builtin_bit_cast(unsigned, b); }
__device__ __forceinline__ float bflo(unsigned u) { return __uint_as_float(u << 16); }
__device__ __forceinline__ float bfhi(unsigned u) { return __uint_as_float(u & 0xffff0000u); }
__device__ __forceinline__ float sigmoid_f(float x) { return __builtin_amdgcn_rcpf(1.0f + __builtin_amdgcn_exp2f(-1.4426950408889634f * x)); }
__device__ __forceinline__ u32x4 pack8(const f32x4 a, const f32x4 b) { u32x4 w; w.x = cvt_pk_bf16(a[0], a[1]); w.y = cvt_pk_bf16(a[2], a[3]); w.z = cvt_pk_bf16(b[0], b[1]); w.w = cvt_pk_bf16(b[2], b[3]); return w; }
constexpr float RMS_EPS = 1e-6f;
__device__ __forceinline__ float rowscale(const float* p, int row, int mode) { const float v = p[row]; return mode ? __builtin_amdgcn_rsqf(v * (1.0f / 1024.0f) + RMS_EPS) : v; }

struct EpiSwiGLU {
    static constexpr bool PERM = true, AFTER_DRAIN = false;
    bf16_t* H; int ldh; const float* rs; int rs_mode;
    __device__ __forceinline__ void operator()(const f32x4 (&acc)[2][2][4][2], const Unit& u, int wr, int wc, int fr, int fq) const {
        const int row0 = u.pm * BM + wr * 64 + fr, col0 = u.pn * HALF + wc * 32 + 8 * fq;
#pragma unroll
        for (int ai = 0; ai < 2; ++ai)
#pragma unroll
            for (int m = 0; m < 4; ++m) {
                const int row = row0 + ai * HALF + m * 16; const float r = rowscale(rs, row, rs_mode);
                f32x4 o[2];
#pragma unroll
                for (int n = 0; n < 2; ++n) {
                    const f32x4 g = acc[ai][0][m][n] * r, up = acc[ai][1][m][n] * r;
#pragma unroll
                    for (int j = 0; j < 4; ++j) o[n][j] = g[j] * sigmoid_f(g[j]) * up[j];
                }
                *(u32x4*)(H + (size_t)row * ldh + col0) = pack8(o[0], o[1]);
            }
    }
};
struct EpiResid {
    static constexpr bool PERM = true, AFTER_DRAIN = false;
    const float* base; float* out; bf16_t* ob; float* ss; float scale; int ldc;
    __device__ __forceinline__ void operator()(const f32x4 (&acc)[2][2][4][2], const Unit& u, int wr, int wc, int fr, int fq) const {
        const int row0 = u.pm * BM + wr * 64 + fr, col0 = u.pn * BM + wc * 32 + 8 * fq;
#pragma unroll
        for (int ai = 0; ai < 2; ++ai)
#pragma unroll
            for (int m = 0; m < 4; ++m) {
                const int row = row0 + ai * HALF + m * 16; float s = 0.f;
#pragma unroll
                for (int bj = 0; bj < 2; ++bj) {
                    const size_t off = (size_t)row * ldc + col0 + bj * HALF;
                    const f32x4 b0 = *(const f32x4*)(base + off), b1 = *(const f32x4*)(base + off + 4);
                    const f32x4 o0 = b0 + acc[ai][bj][m][0] * scale, o1 = b1 + acc[ai][bj][m][1] * scale;
                    *(f32x4*)(out + off) = o0; *(f32x4*)(out + off + 4) = o1;
                    if (ob) *(u32x4*)(ob + off) = pack8(o0, o1);
                    s += (o0[0] * o0[0] + o0[1] * o0[1]) + (o0[2] * o0[2] + o0[3] * o0[3]) + (o1[0] * o1[0] + o1[1] * o1[1]) + (o1[2] * o1[2] + o1[3] * o1[3]);
                }
                if (ss) { s += __shfl_xor(s, 16); s += __shfl_xor(s, 32); if (fq == 0) atomicAdd(ss + row, s); }
            }
    }
};
struct EpiRoute {
    static constexpr bool PERM = true, AFTER_DRAIN = false;
    bf16_t* dst[6]; const float* rs; int rs_mode; int is_win;
    int ld0; float post;
    __device__ __forceinline__ void operator()(const f32x4 (&acc)[2][2][4][2], const Unit& u, int wr, int wc, int fr, int fq) const {
        const int pn = u.pn; bf16_t* bp; int ldc, colt;
        if (!is_win) { bp = dst[0]; ldc = ld0; colt = pn * BM; }
        else if (pn < 4) { bp = dst[0]; ldc = 1024; colt = pn * BM; }
        else if (pn == 4) { bp = dst[1]; ldc = 256; colt = 0; }
        else if (pn == 5) { bp = dst[2]; ldc = 256; colt = 0; }
        else if (pn < 8) { bp = dst[3]; ldc = 512; colt = (pn - 6) * BM; }
        else if (pn < 12) { bp = dst[4]; ldc = 1024; colt = (pn - 8) * BM; }
        else { bp = dst[5]; ldc = 1024; colt = (pn - 12) * BM; }
        const int row0 = u.pm * BM + wr * 64 + fr, col0 = colt + wc * 32 + 8 * fq;
#pragma unroll
        for (int ai = 0; ai < 2; ++ai)
#pragma unroll
            for (int m = 0; m < 4; ++m) {
                const int row = row0 + ai * HALF + m * 16; const float r = rowscale(rs, row, rs_mode) * post;
#pragma unroll
                for (int bj = 0; bj < 2; ++bj)
                    *(u32x4*)(bp + (size_t)row * ldc + col0 + bj * HALF) = pack8(acc[ai][bj][m][0] * r, acc[ai][bj][m][1] * r);
            }
    }
};
struct EpiGate {
    static constexpr bool PERM = true, AFTER_DRAIN = false;
    bf16_t* G; const bf16_t* T; int mode;
    __device__ __forceinline__ void operator()(const f32x4 (&acc)[2][2][4][2], const Unit& u, int wr, int wc, int fr, int fq) const {
        const int row0 = u.pm * BM + wr * 64 + fr, col0 = u.pn * BM + wc * 32 + 8 * fq;
#pragma unroll
        for (int ai = 0; ai < 2; ++ai)
#pragma unroll
            for (int m = 0; m < 4; ++m) {
                const int row = row0 + ai * HALF + m * 16;
#pragma unroll
                for (int bj = 0; bj < 2; ++bj) {
                    const size_t off = (size_t)row * 1024 + col0 + bj * HALF;
                    const u32x4 gv = *(const u32x4*)(G + off);
                    f32x4 g0 = {bflo(gv.x), bfhi(gv.x), bflo(gv.y), bfhi(gv.y)}, g1 = {bflo(gv.z), bfhi(gv.z), bflo(gv.w), bfhi(gv.w)};
                    f32x4 o0, o1;
#pragma unroll
                    for (int j = 0; j < 4; ++j) { o0[j] = sigmoid_f(g0[j]) * acc[ai][bj][m][0][j]; o1[j] = sigmoid_f(g1[j]) * acc[ai][bj][m][1][j]; }
                    if (mode == 2) { const u32x4 tv = *(const u32x4*)(T + off);
                        o0 += (f32x4){bflo(tv.x), bfhi(tv.x), bflo(tv.y), bfhi(tv.y)}; o1 += (f32x4){bflo(tv.z), bfhi(tv.z), bflo(tv.w), bfhi(tv.w)}; }
                    *(u32x4*)(G + off) = pack8(o0, o1);
                }
            }
    }
};
template <class Epi, class Sched, bool ALIGN_EPI = false, bool SP2 = false>
__device__ __forceinline__ void gemm_phase(PG8_LAS unsigned char* lds, const Gemm g, const Sched& S, const Epi& E) {
    const int tid = threadIdx.x, wid = __builtin_amdgcn_readfirstlane(tid >> 6), lane = tid & 63, wr = wid >> 2, wc = wid & 3, fr = lane & 15, fq = lane >> 4;
    const int K = g.K, nt = K / BK;
    unsigned voffA[2], voffB[2];
#pragma unroll
    for (int i = 0; i < 2; ++i) { int R, C; stage_rc(tid * 16 + i * 8192, R, C); const int Rb = Epi::PERM ? ((R & ~31) + perm32(R & 31)) : R;
        voffA[i] = (unsigned)(R * K + C) * 2u; voffB[i] = (unsigned)(Rb * K + C) * 2u; }
    const size_t kstep = (size_t)(BK * 2);
    const size_t hstep = (size_t)HALF * K * 2;
    const size_t tstep = 2 * hstep;
    const unsigned ldsw = (unsigned)wid * 1024u;
    const int aoff = lds_byte(wr * 64 + fr, fq * 8), boff = lds_byte(wc * 32 + fr, fq * 8);
#define PG8_SA(b, h) (((b) * 2 + (h)) * HTB)
#define PG8_SB(b, h) ((4 + (b) * 2 + (h)) * HTB)
#define PG8_STAGE(bufoff, gbase, voff) do { _Pragma("unroll") for (int _i = 0; _i < 2; ++_i) \
        __builtin_amdgcn_global_load_lds((const unsigned*)((const char*)(gbase) + (voff)[_i]), (PG8_LAS unsigned*)(lds + (bufoff) + ldsw + _i * 8192), 16, 0, 0); } while (0)
#define PG8_LDA(dst, b, h) do { _Pragma("unroll") for (int m = 0; m < 4; ++m) _Pragma("unroll") for (int k = 0; k < 2; ++k) dst[m][k] = *(const PG8_LAS bf16x8*)(lds + PG8_SA(b, h) + aoff + m * 2048 + k * 1024); } while (0)
#define PG8_LDB(dst, b, h) do { _Pragma("unroll") for (int n = 0; n < 2; ++n) _Pragma("unroll") for (int k = 0; k < 2; ++k) dst[n][k] = *(const PG8_LAS bf16x8*)(lds + PG8_SB(b, h) + boff + n * 2048 + k * 1024); } while (0)
#define PG8_MMA(ai, bj, At, Bt) do { __builtin_amdgcn_s_setprio(1); _Pragma("unroll") for (int m = 0; m < 4; ++m) _Pragma("unroll") for (int n = 0; n < 2; ++n) _Pragma("unroll") for (int k = 0; k < 2; ++k) \
        acc[ai][bj][m][n] = __builtin_amdgcn_mfma_f32_16x16x32_bf16(Bt[n][k], At[m][k], acc[ai][bj][m][n], 0, 0, 0); __builtin_amdgcn_s_setprio(0); } while (0)
#define PG8_WAIT_V(n) asm volatile("s_waitcnt vmcnt(" #n ")" ::: "memory")
#define PG8_WAIT_L(n) asm volatile("s_waitcnt lgkmcnt(" #n ")" ::: "memory")
#define PG8_BAR __builtin_amdgcn_s_barrier()
#define PG8_SCHED __builtin_amdgcn_sched_barrier(0)
    Unit cur, nxt; int ui = 0;
    if (!S.next(0, cur)) return;
    f32x4 acc[2][2][4][2];
#pragma unroll
    for (int a = 0; a < 2; ++a)
#pragma unroll
        for (int b = 0; b < 2; ++b)
#pragma unroll
            for (int m = 0; m < 4; ++m)
#pragma unroll
                for (int n = 0; n < 2; ++n) acc[a][b][m][n] = (f32x4){0.f, 0.f, 0.f, 0.f};
    bf16x8 At[4][2], B0[2][2], B1[2][2];
    const char* cA = (const char*)g.A + (size_t)cur.pm * tstep; const char* cB = (const char*)g.Bt + (size_t)cur.pn * tstep;
    S.a_ready(cur);
    if constexpr (SP2) {
        PG8_STAGE(PG8_SB(0, 0), cB, voffB); PG8_STAGE(PG8_SB(0, 1), cB + hstep, voffB); PG8_STAGE(PG8_SA(0, 0), cA, voffA); PG8_STAGE(PG8_SA(0, 1), cA + hstep, voffA);
        if (wr == 1) PG8_BAR;
        PG8_WAIT_V(2); PG8_BAR;
        PG8_STAGE(PG8_SB(1, 0), cB + kstep, voffB); PG8_STAGE(PG8_SA(1, 0), cA + kstep, voffA); PG8_STAGE(PG8_SB(1, 1), cB + hstep + kstep, voffB);
        PG8_WAIT_V(6); PG8_BAR;
    } else {
        PG8_STAGE(PG8_SB(0, 0), cB, voffB); PG8_STAGE(PG8_SA(0, 0), cA, voffA); PG8_STAGE(PG8_SB(0, 1), cB + hstep, voffB); PG8_STAGE(PG8_SA(0, 1), cA + hstep, voffA);
        if (wr == 1) PG8_BAR;
        PG8_WAIT_V(4); PG8_BAR;
        PG8_STAGE(PG8_SB(1, 0), cB + kstep, voffB); PG8_STAGE(PG8_SA(1, 0), cA + kstep, voffA); PG8_STAGE(PG8_SB(1, 1), cB + hstep + kstep, voffB);
        PG8_WAIT_V(6); PG8_BAR;
    }
    for (;;) {
        const bool has_next = S.next(ui + 1, nxt);
        const char* nA = has_next ? (const char*)g.A + (size_t)nxt.pm * tstep : cA; const char* nB = has_next ? (const char*)g.Bt + (size_t)nxt.pn * tstep : cB;
        for (int t = 0; t < nt; t += 2) {
            const bool last = (t == nt - 2);
            const char* a1 = cA + (size_t)(t + 1) * kstep;
            const char* a2 = last ? nA : cA + (size_t)(t + 2) * kstep; const char* b2 = last ? nB : cB + (size_t)(t + 2) * kstep;
            const char* a3 = a2 + kstep; const char* b3 = b2 + kstep;
            if (last && has_next) S.a_ready(nxt);
            if constexpr (SP2) {
            PG8_LDB(B0, 0, 0); PG8_LDB(B1, 0, 1); PG8_SCHED; PG8_LDA(At, 0, 0); PG8_STAGE(PG8_SA(1, 1), a1 + hstep, voffA);
            PG8_WAIT_V(8); PG8_WAIT_L(0); PG8_BAR; PG8_MMA(0, 0, At, B0); PG8_MMA(0, 1, At, B1); PG8_BAR; PG8_SCHED;
            PG8_LDA(At, 0, 1); PG8_STAGE(PG8_SB(0, 0), b2, voffB); PG8_STAGE(PG8_SB(0, 1), b2 + hstep, voffB); PG8_STAGE(PG8_SA(0, 0), a2, voffA);
            PG8_WAIT_V(8); PG8_WAIT_L(0); PG8_BAR; PG8_MMA(1, 0, At, B0); PG8_MMA(1, 1, At, B1); PG8_BAR; PG8_SCHED;
            PG8_LDB(B0, 1, 0); PG8_LDB(B1, 1, 1); PG8_SCHED; PG8_LDA(At, 1, 0); PG8_STAGE(PG8_SA(0, 1), a2 + hstep, voffA);
            PG8_WAIT_V(8); PG8_WAIT_L(0); PG8_BAR; PG8_MMA(0, 0, At, B0); PG8_MMA(0, 1, At, B1); PG8_BAR; PG8_SCHED;
            PG8_LDA(At, 1, 1); PG8_STAGE(PG8_SB(1, 0), b3, voffB); PG8_STAGE(PG8_SB(1, 1), b3 + hstep, voffB); PG8_STAGE(PG8_SA(1, 0), a3, voffA);
            PG8_WAIT_V(8); PG8_WAIT_L(0); PG8_BAR; PG8_MMA(1, 0, At, B0); PG8_MMA(1, 1, At, B1); PG8_BAR; PG8_SCHED;
            } else {
            PG8_LDB(B0, 0, 0); PG8_SCHED; PG8_LDA(At, 0, 0); PG8_STAGE(PG8_SA(1, 1), a1 + hstep, voffA);
            PG8_WAIT_L(8); PG8_BAR; PG8_WAIT_L(0); PG8_MMA(0, 0, At, B0); PG8_BAR; PG8_SCHED;
            PG8_LDB(B1, 0, 1); PG8_STAGE(PG8_SB(0, 0), b2, voffB);
            PG8_BAR; PG8_WAIT_L(0); PG8_MMA(0, 1, At, B1); PG8_BAR;
            PG8_LDA(At, 0, 1); PG8_STAGE(PG8_SA(0, 0), a2, voffA);
            PG8_BAR; PG8_WAIT_L(0); PG8_MMA(1, 0, At, B0); PG8_BAR; PG8_SCHED;
            PG8_STAGE(PG8_SB(0, 1), b2 + hstep, voffB);
            PG8_WAIT_V(6); PG8_BAR; PG8_MMA(1, 1, At, B1); PG8_BAR;
            PG8_LDB(B0, 1, 0); PG8_SCHED; PG8_LDA(At, 1, 0); PG8_STAGE(PG8_SA(0, 1), a2 + hstep, voffA);
            PG8_WAIT_L(8); PG8_BAR; PG8_WAIT_L(0); PG8_MMA(0, 0, At, B0); PG8_BAR; PG8_SCHED;
            PG8_LDB(B1, 1, 1); PG8_STAGE(PG8_SB(1, 0), b3, voffB);
            PG8_BAR; PG8_WAIT_L(0); PG8_MMA(0, 1, At, B1); PG8_BAR;
            PG8_LDA(At, 1, 1); PG8_STAGE(PG8_SA(1, 0), a3, voffA);
            PG8_BAR; PG8_WAIT_L(0); PG8_MMA(1, 0, At, B0); PG8_BAR; PG8_SCHED;
            PG8_STAGE(PG8_SB(1, 1), b3 + hstep, voffB);
            PG8_WAIT_V(6); PG8_BAR; PG8_MMA(1, 1, At, B1); PG8_BAR;
            }
        }
        if constexpr (ALIGN_EPI) { if (wr == 0) PG8_BAR; }
        if constexpr (!Epi::AFTER_DRAIN) { E(acc, cur, wr, wc, fr, fq); S.done(cur); }
        if (!has_next) break;
#pragma unroll
        for (int a = 0; a < 2; ++a)
#pragma unroll
            for (int b = 0; b < 2; ++b)
#pragma unroll
                for (int m = 0; m < 4; ++m)
#pragma unroll
                    for (int n = 0; n < 2; ++n) acc[a][b][m][n] = (f32x4){0.f, 0.f, 0.f, 0.f};
        cur = nxt; cA = nA; cB = nB; ++ui;
        if constexpr (ALIGN_EPI) { if (wr == 1) PG8_BAR; }
    }
    PG8_WAIT_V(0);
    if constexpr (!ALIGN_EPI) { if (wr == 0) PG8_BAR; }
    PG8_BAR;
    if constexpr (Epi::AFTER_DRAIN) { E.fused(acc, cur, wr, wc, fr, fq, lds, wid, lane); S.done(cur); }
#undef PG8_SA
#undef PG8_SB
#undef PG8_STAGE
#undef PG8_LDA
#undef PG8_LDB
#undef PG8_MMA
#undef PG8_WAIT_V
#undef PG8_WAIT_L
#undef PG8_BAR
#undef PG8_SCHED
}
}
#include <hip/hip_bf16.h>
#include <cmath>
namespace attn_body {
using bf16=__hip_bfloat16;
using bf16x8=__attribute__((ext_vector_type(8)))short;
using s16x4=__attribute__((ext_vector_type(4)))short;
using f32x16=__attribute__((ext_vector_type(16)))float;
using u32x4=__attribute__((ext_vector_type(4)))unsigned;
constexpr int BATCH=1,NHEAD=16,SEQ=16384,D=64,DM=NHEAD*D,KVP=256,GQA=4;
constexpr int NW=8,QBLK=32,QB=QBLK*NW,KVBLK=64,NQB=SEQ/QB;
constexpr int ATTN_PITCH=DM, ATTN_UNIT_ROWS=QB;
__device__ __forceinline__ int crow(int r,int hi){return (r&3)+8*(r>>2)+4*hi;}
#define SBAR() __builtin_amdgcn_sched_barrier(0)
__device__ __forceinline__ void cmask(f32x16&p0,f32x16&p1,int jb,int qrel,int hi){
  const float NEG=-INFINITY; int kb=64*jb+4*hi;
  #pragma unroll
  for(int r=0;r<16;++r){int kv=kb+(r&3)+8*(r>>2); if(kv>qrel)p0[r]=NEG; if(kv+32>qrel)p1[r]=NEG;}
}

constexpr int NSLOT=3, SLOTB=8192;
constexpr int LDS_K=0, LDS_V=NSLOT*SLOTB, LDS_WS=2*NSLOT*SLOTB, LDS_OST=LDS_WS+NW*64*4, LDS_BYTES=LDS_OST+NW*4096;
constexpr float C2=0.125f*1.4426950408889634f;
__device__ __forceinline__ void glds16(const void*gsrc,unsigned lds_dst){unsigned keep;
  asm volatile("s_mov_b32 %0, m0\n\ts_mov_b32 m0, %2\n\ts_nop 0\n\tglobal_load_lds_dwordx4 %1, off\n\ts_mov_b32 m0, %0":"=&s"(keep):"v"(gsrc),"s"(lds_dst):"memory");}
__device__ __forceinline__ float max3f(float a,float b,float c){float r;asm("v_max3_f32 %0, %1, %2, %3":"=v"(r):"v"(a),"v"(b),"v"(c));return r;}
__device__ __forceinline__ float max2f(float a,float b){float r;asm("v_max_f32_e32 %0, %1, %2":"=v"(r):"v"(a),"v"(b));return r;}
__device__ __forceinline__ float fadd_s(float a,float b){float r;asm("v_add_f32_e32 %0, %1, %2":"=v"(r):"v"(a),"v"(b));return r;}
__device__ __forceinline__ float fsub_s(float a,float b){float r;asm("v_sub_f32_e32 %0, %1, %2":"=v"(r):"v"(a),"v"(b));return r;}
typedef float f32x2_t __attribute__((ext_vector_type(2))); typedef __bf16 bf16x2_t __attribute__((ext_vector_type(2)));
__device__ __forceinline__ unsigned cvtpk_s(float lo,float hi){f32x2_t v={lo,hi};bf16x2_t b=__builtin_convertvector(v,bf16x2_t);return __builtin_bit_cast(unsigned,b);}
#define WAIT_BAR(N) asm volatile("s_waitcnt vmcnt(" #N ") lgkmcnt(0)\n\ts_barrier":::"memory")

__device__ __forceinline__ void qkt(f32x16&p0,f32x16&p1,const char*Kslot,const bf16x8*qr,const f32x16&negm,int r32,int hi){
  const char*kb=Kslot+hi*1024+r32*16;
  #pragma unroll
  for(int d0=0;d0<4;++d0){
    const bf16x8 b0=*reinterpret_cast<const bf16x8*>(kb+d0*2048);
    const bf16x8 b1=*reinterpret_cast<const bf16x8*>(kb+d0*2048+512);
    if(d0==0){p0=__builtin_amdgcn_mfma_f32_32x32x16_bf16(b0,qr[0],negm,0,0,0);p1=__builtin_amdgcn_mfma_f32_32x32x16_bf16(b1,qr[0],negm,0,0,0);}
    else{p0=__builtin_amdgcn_mfma_f32_32x32x16_bf16(b0,qr[d0],p0,0,0,0);p1=__builtin_amdgcn_mfma_f32_32x32x16_bf16(b1,qr[d0],p1,0,0,0);}}
}
typedef __attribute__((address_space(3))) const char* lds_cptr;
typedef short v4i16_t __attribute__((ext_vector_type(4)));
__device__ __forceinline__ void kload8(bf16x8*kf,lds_cptr kp){
  kf[0]=*(const __attribute__((address_space(3))) bf16x8*)(kp);      kf[1]=*(const __attribute__((address_space(3))) bf16x8*)(kp+512);
  kf[2]=*(const __attribute__((address_space(3))) bf16x8*)(kp+2048); kf[3]=*(const __attribute__((address_space(3))) bf16x8*)(kp+2560);
  kf[4]=*(const __attribute__((address_space(3))) bf16x8*)(kp+4096); kf[5]=*(const __attribute__((address_space(3))) bf16x8*)(kp+4608);
  kf[6]=*(const __attribute__((address_space(3))) bf16x8*)(kp+6144); kf[7]=*(const __attribute__((address_space(3))) bf16x8*)(kp+6656);
}
__device__ __forceinline__ void kload2(bf16x8*kf,lds_cptr kp,int j){ kf[2*j]=*(const __attribute__((address_space(3))) bf16x8*)(kp+j*2048); kf[2*j+1]=*(const __attribute__((address_space(3))) bf16x8*)(kp+j*2048+512); }
__device__ __forceinline__ s16x4 vtr(lds_cptr p){ return __builtin_bit_cast(s16x4,__builtin_amdgcn_ds_read_tr16_b64_v4i16((__attribute__((address_space(3))) v4i16_t*)p)); }
__device__ __forceinline__ float rowmax(const f32x16&p0,const f32x16&p1){
  float a=max3f(p0[0],p0[1],p1[0]),b=max3f(p0[2],p0[3],p1[1]);a=max3f(a,p1[2],p1[3]);
  #pragma unroll
  for(int r=4;r<16;r+=4){a=max3f(a,p0[r],p0[r+1]);b=max3f(b,p0[r+2],p0[r+3]);a=max3f(a,p1[r],p1[r+1]);b=max3f(b,p1[r+2],p1[r+3]);}
  const float m=max2f(a,b);
  auto rr=__builtin_amdgcn_permlane32_swap(__float_as_uint(m),__float_as_uint(m),false,false);
  return max2f(__uint_as_float(rr[0]),__uint_as_float(rr[1]));
}
__device__ __forceinline__ void pv(f32x16*o,int vb,bf16x8 pa0,bf16x8 pa1,bf16x8 pa2,bf16x8 pa3){
  #pragma unroll
  for(int d0=0;d0<2;++d0){s16x4 lo[4],hi[4];
    #pragma unroll
    for(int ks=0;ks<4;++ks){
      asm volatile("ds_read_b64_tr_b16 %0,%1 offset:%c2":"=&v"(lo[ks]):"v"(vb),"i"(d0*4096+ks*1024):"memory");
      asm volatile("ds_read_b64_tr_b16 %0,%1 offset:%c2":"=&v"(hi[ks]):"v"(vb),"i"(d0*4096+ks*1024+512):"memory");}
    asm volatile("s_waitcnt lgkmcnt(0)":::"memory");SBAR();
    #define PK(k) (bf16x8){lo[k][0],lo[k][1],lo[k][2],lo[k][3],hi[k][0],hi[k][1],hi[k][2],hi[k][3]}
    o[d0]=__builtin_amdgcn_mfma_f32_32x32x16_bf16(pa0,PK(0),o[d0],0,0,0);
    o[d0]=__builtin_amdgcn_mfma_f32_32x32x16_bf16(pa1,PK(1),o[d0],0,0,0);
    o[d0]=__builtin_amdgcn_mfma_f32_32x32x16_bf16(pa2,PK(2),o[d0],0,0,0);
    o[d0]=__builtin_amdgcn_mfma_f32_32x32x16_bf16(pa3,PK(3),o[d0],0,0,0);
    #undef PK
  }
}

#ifndef ATTN_STORE16
#define ATTN_STORE16(p,v) (*(u32x4*)(p)=(v))
#endif
template<int THRL,int QP_,int KVP_,int SKV_,int GQ_,bool FIXM> __device__ __forceinline__ void attn_unit(int b,int h,int qb,const bf16*Q,const bf16*__restrict__ K,const bf16*__restrict__ V,bf16*O,char*shm,float mfix){
  const int tid=threadIdx.x,lane=tid&63,r32=lane&31,hi=lane>>5; const int wid=__builtin_amdgcn_readfirstlane(tid>>6);
  const long rowbase=0; (void)b; const int q0=qb*QB;
  const bf16*Qw=Q+(rowbase+q0+wid*QBLK)*QP_+h*D;
  const bf16*Kh=K+rowbase*KVP_+(h/GQ_)*D,*Vh=V+rowbase*KVP_+(h/GQ_)*D;
  const unsigned lds0=(unsigned)(uintptr_t)shm;
  float*wsf=(float*)(shm+LDS_WS)+wid*64;
  const bf16*ksrc=Kh+(long)lane*KVP_+wid*8;
  const bf16*vsrc=Vh+(long)(16*(wid&3)+(lane>>2))*KVP_+(wid>>2)*32+(lane&3)*8;
  const unsigned kdst=lds0+LDS_K+wid*1024, vdst=lds0+LDS_V+wid*1024;
  #define DMA_K(t,slot) glds16(ksrc+(long)(t)*KVBLK*KVP_,(unsigned)__builtin_amdgcn_readfirstlane(kdst+(slot)))
  #define DMA_V(t,slot) glds16(vsrc+(long)(t)*KVBLK*KVP_,(unsigned)__builtin_amdgcn_readfirstlane(vdst+(slot)))
  const int vb0=(int)(lds0+LDS_V)+((lane>>4)&1)*32+(lane&3)*8+(4*hi+((lane&15)>>2))*64;
  const char*Kbase=shm+LDS_K; bf16x8 kf[8];
  const lds_cptr shm3=(lds_cptr)shm; const lds_cptr kp0=shm3+LDS_K+hi*1024+r32*16; const lds_cptr vp0=shm3+LDS_V+((lane>>4)&1)*32+(lane&3)*8+(4*hi+((lane&15)>>2))*64;
  const int NT=SKV_/KVBLK;
  DMA_K(0,0);DMA_V(0,0);DMA_K(1,SLOTB);
  bf16x8 qr[4];
  #pragma unroll
  for(int d0=0;d0<4;++d0)qr[d0]=*reinterpret_cast<const bf16x8*>(&Qw[(long)r32*QP_+d0*16+hi*8]);
  float mhat=0.f,l_reg=0.f;f32x16 o[2];o[0]=f32x16{};o[1]=f32x16{};f32x16 negm=f32x16{}; if constexpr(FIXM){ _Pragma("unroll") for(int r=0;r<16;++r)negm[r]=-mfix; } asm volatile("":"+v"(negm));
  const int qrel=wid*QBLK+r32;
  #define CMASK(P0,P1,t) do{}while(0)
  bool resc=false;
  #define START(P0,P1) do{ resc=false; if constexpr(!FIXM) { const float rm=rowmax(P0,P1); \
      const float dl=rm; mhat=fadd_s(mhat,dl); \
      _Pragma("unroll") for(int r=0;r<16;++r){P0[r]=fsub_s(P0[r],dl);P1[r]=fsub_s(P1[r],dl);} \
      _Pragma("unroll") for(int r=0;r<16;++r)negm[r]=-mhat; asm volatile("":"+v"(negm)); } \
    _Pragma("unroll") for(int r=0;r<16;++r)P0[r]=__builtin_amdgcn_exp2f(P0[r]); }while(0)
  #define RESC() do{ if(resc){ asm volatile("s_waitcnt lgkmcnt(0)":::"memory"); \
      _Pragma("unroll") for(int d_=0;d_<2;++d_) _Pragma("unroll") for(int r=0;r<16;++r)o[d_][r]*=wsf[crow(r,hi)]; } }while(0)
  f32x16 pA0,pA1,pB0,pB1;
  int sl_prev=0,sl_cur=0,sl_next=SLOTB;
  #define ROT() do{sl_prev=sl_cur;sl_cur=sl_next;sl_next=(sl_next==(NSLOT-1)*SLOTB)?0:sl_next+SLOTB;}while(0)
  DMA_K(2,2*SLOTB);
  WAIT_BAR(3);
  qkt(pA0,pA1,Kbase,qr,negm,r32,hi);asm volatile("s_nop 15\n\ts_nop 7":"+v"(pA0),"+v"(pA1));CMASK(pA0,pA1,0);
  START(pA0,pA1);
  _Pragma("unroll") for(int r=0;r<16;++r)pA1[r]=__builtin_amdgcn_exp2f(pA1[r]);
  WAIT_BAR(0);
  DMA_K(3,0);DMA_V(1,SLOTB);
  ROT();
  kload8(kf,kp0+sl_cur);
  WAIT_BAR(2);
  s16x4 vlo[8],vhi[8]; u32x4 pw0,pw1,pw2,pw3;
  #define PKW(P,B) cvtpk_s(P[B],P[B+1])
  #define PAF(k) __builtin_bit_cast(bf16x8,pw##k)
  #define VFR(i) (bf16x8){vlo[i][0],vlo[i][1],vlo[i][2],vlo[i][3],vhi[i][0],vhi[i][1],vhi[i][2],vhi[i][3]}
  #define PIN(x) asm volatile("":"+v"(x))
  #define MX3(a,b,c) __builtin_fmaxf(__builtin_fmaxf((a),(b)),(c))
  #define GAPA(MF,A0,A1,A2,A3,W0,W1,PW) do{ MF; sacc+=A0; sacc+=A1; sacc+=A2; sacc+=A3; PIN(sacc); W0; W1; PIN(PW); SBAR(); }while(0)
  #define EX(v) __builtin_amdgcn_exp2f(v)
  #define GAPB(MF,X,B) do{ MF; X[B]=EX(X[B]); X[B+1]=EX(X[B+1]); X[B+2]=EX(X[B+2]); X[B+3]=EX(X[B+3]); PIN(X); SBAR(); }while(0)
  #define VRD(i) do{ vlo[i]=vtr(vp_+(((i)>>2)*4096+((i)&3)*1024)); vhi[i]=vtr(vp_+(((i)>>2)*4096+((i)&3)*1024+512)); }while(0)
  #define KRD(G,j) do{ if(G){ kload2(kf,kp0+sl_next,j); SBAR(); } }while(0)
  #define STEP(C0,C1,P0,P1,t,GK,GV,GL) do{ SBAR(); \
    const lds_cptr vp_=vp0+sl_prev; \
    VRD(0); SBAR(); float sacc=(P0[0]+P0[1]); \
    GAPA(C0=__builtin_amdgcn_mfma_f32_32x32x16_bf16(kf[0],qr[0],negm,0,0,0), P0[2],P0[3],P0[4],P0[5],     pw0[0]=PKW(P0,0), pw0[1]=PKW(P0,2), pw0); \
    VRD(4); SBAR(); GAPA(C1=__builtin_amdgcn_mfma_f32_32x32x16_bf16(kf[1],qr[0],negm,0,0,0), P0[6],P0[7],P0[8],P0[9],     pw0[2]=PKW(P0,4), pw0[3]=PKW(P0,6), pw0); \
    VRD(1); SBAR(); GAPA(C0=__builtin_amdgcn_mfma_f32_32x32x16_bf16(kf[2],qr[1],C0,0,0,0),   P0[10],P0[11],P0[12],P0[13], pw1[0]=PKW(P0,8), pw1[1]=PKW(P0,10), pw1); \
    VRD(5); SBAR(); GAPA(C1=__builtin_amdgcn_mfma_f32_32x32x16_bf16(kf[3],qr[1],C1,0,0,0),   P0[14],P0[15],P1[0],P1[1],   pw1[2]=PKW(P0,12),pw1[3]=PKW(P0,14), pw1); \
    VRD(2); SBAR(); GAPA(C0=__builtin_amdgcn_mfma_f32_32x32x16_bf16(kf[4],qr[2],C0,0,0,0),   P1[2],P1[3],P1[4],P1[5],     pw2[0]=PKW(P1,0), pw2[1]=PKW(P1,2), pw2); \
    VRD(6); SBAR(); GAPA(C1=__builtin_amdgcn_mfma_f32_32x32x16_bf16(kf[5],qr[2],C1,0,0,0),   P1[6],P1[7],P1[8],P1[9],     pw2[2]=PKW(P1,4), pw2[3]=PKW(P1,6), pw2); \
    VRD(3); SBAR(); GAPA(C0=__builtin_amdgcn_mfma_f32_32x32x16_bf16(kf[6],qr[3],C0,0,0,0),   P1[10],P1[11],P1[12],P1[13], pw3[0]=PKW(P1,8), pw3[1]=PKW(P1,10), pw3); \
    VRD(7); SBAR(); GAPA(C1=__builtin_amdgcn_mfma_f32_32x32x16_bf16(kf[7],qr[3],C1,0,0,0),   P1[14],P1[15],0.f,0.f,       pw3[2]=PKW(P1,12),pw3[3]=PKW(P1,14), pw3); \
    l_reg+=sacc; \
    if(GK){DMA_K((t)+3,sl_cur);} if(GV){DMA_V((t)+1,sl_next);} \
    CMASK(C0,C1,t); \
    if constexpr(!FIXM) { float a=MX3(C0[0],C0[1],C1[0]),b=MX3(C0[2],C0[3],C1[1]); a=MX3(a,C1[2],C1[3]); \
      _Pragma("unroll") for(int r=4;r<16;r+=4){a=MX3(a,C0[r],C0[r+1]);b=MX3(b,C0[r+2],C0[r+3]);a=MX3(a,C1[r],C1[r+1]);b=MX3(b,C1[r+2],C1[r+3]);} \
      float rm=__builtin_fmaxf(a,b); { auto rr=__builtin_amdgcn_permlane32_swap(__float_as_uint(rm),__float_as_uint(rm),false,false); rm=__builtin_fmaxf(__uint_as_float(rr[0]),__uint_as_float(rr[1])); } \
      resc=false; \
      if(__builtin_expect(__any(rm>(float)THRL),0)){ const float dl=__builtin_fmaxf(rm,0.f); mhat+=dl; \
        _Pragma("unroll") for(int r=0;r<16;++r){C0[r]-=dl;C1[r]-=dl;} \
        _Pragma("unroll") for(int r=0;r<16;++r)negm[r]=-mhat; asm volatile("":"+v"(negm)); \
        const float f=__builtin_amdgcn_exp2f(-dl); l_reg*=f; if(hi==0)wsf[r32]=f; resc=true; } } \
    SBAR(); \
    GAPB(o[0]=__builtin_amdgcn_mfma_f32_32x32x16_bf16(PAF(0),VFR(0),o[0],0,0,0), C0,0); \
    GAPB(o[1]=__builtin_amdgcn_mfma_f32_32x32x16_bf16(PAF(0),VFR(4),o[1],0,0,0), C0,4); \
    KRD(GL,0); GAPB(o[0]=__builtin_amdgcn_mfma_f32_32x32x16_bf16(PAF(1),VFR(1),o[0],0,0,0), C0,8); \
    KRD(GL,1); GAPB(o[1]=__builtin_amdgcn_mfma_f32_32x32x16_bf16(PAF(1),VFR(5),o[1],0,0,0), C0,12); \
    KRD(GL,2); GAPB(o[0]=__builtin_amdgcn_mfma_f32_32x32x16_bf16(PAF(2),VFR(2),o[0],0,0,0), C1,0); \
    KRD(GL,3); GAPB(o[1]=__builtin_amdgcn_mfma_f32_32x32x16_bf16(PAF(2),VFR(6),o[1],0,0,0), C1,4); \
    GAPB(o[0]=__builtin_amdgcn_mfma_f32_32x32x16_bf16(PAF(3),VFR(3),o[0],0,0,0), C1,8); \
    GAPB(o[1]=__builtin_amdgcn_mfma_f32_32x32x16_bf16(PAF(3),VFR(7),o[1],0,0,0), C1,12); \
    }while(0)
  int t=1;
  #undef CMASK
  #define CMASK(P0,P1,t) do{}while(0)
  for(;t+5<NT;t+=2){
    STEP(pB0,pB1,pA0,pA1,t,true,true,true);     WAIT_BAR(2); RESC(); ROT();
    STEP(pA0,pA1,pB0,pB1,t+1,true,true,true);   WAIT_BAR(2); RESC(); ROT();
  }
  #undef CMASK
  #define CMASK(P0,P1,t) do{}while(0)
  #define ENDW(tt) do{ if((tt)+3<NT){WAIT_BAR(2);} else if((tt)+2<NT){WAIT_BAR(1);} else {WAIT_BAR(0);} }while(0)
  for(;t+1<NT;t+=2){
    STEP(pB0,pB1,pA0,pA1,t,(t+3<NT),(t+1<NT),(t+1<NT));       ENDW(t);   RESC(); ROT();
    STEP(pA0,pA1,pB0,pB1,t+1,(t+4<NT),(t+2<NT),(t+2<NT));     ENDW(t+1); RESC(); ROT();
  }
  STEP(pB0,pB1,pA0,pA1,NT-1,false,false,false); RESC();
  { float sacc=pB0[0]+pB0[1]; _Pragma("unroll") for(int r=2;r<16;++r)sacc+=pB0[r]; _Pragma("unroll") for(int r=0;r<16;++r)sacc+=pB1[r]; l_reg+=sacc;
    pw0=(u32x4){PKW(pB0,0),PKW(pB0,2),PKW(pB0,4),PKW(pB0,6)};pw1=(u32x4){PKW(pB0,8),PKW(pB0,10),PKW(pB0,12),PKW(pB0,14)};pw2=(u32x4){PKW(pB1,0),PKW(pB1,2),PKW(pB1,4),PKW(pB1,6)};pw3=(u32x4){PKW(pB1,8),PKW(pB1,10),PKW(pB1,12),PKW(pB1,14)};
    SBAR(); pv(o,vb0+sl_cur,PAF(0),PAF(1),PAF(2),PAF(3)); }
  #undef PKW
  #undef PAF
  #undef VFR
  #undef PIN
  #undef MX3
  #undef GAPA
  #undef GAPB
  #undef EX
  #undef VRD
  #undef KRD
  #undef STEP
  #undef ENDW
  {auto rr=__builtin_amdgcn_permlane32_swap(__float_as_uint(l_reg),__float_as_uint(l_reg),false,false);l_reg=__uint_as_float(rr[0])+__uint_as_float(rr[1]);}
  if(hi==0)wsf[32+r32]=l_reg;asm volatile("s_waitcnt lgkmcnt(0)":::"memory");
  float rli[16];
  #pragma unroll
  for(int r=0;r<16;++r)rli[r]=__builtin_amdgcn_rcpf(wsf[32+crow(r,hi)]);
  bf16*Ow=O+(rowbase+q0+wid*QBLK)*QP_+h*D;
  { bf16*stg=(bf16*)(shm+LDS_OST)+wid*2048;
    #pragma unroll
    for(int r=0;r<16;++r){const int orow=crow(r,hi);
      #pragma unroll
      for(int d0=0;d0<2;++d0)stg[orow*64+d0*32+r32]=__float2bfloat16(o[d0][r]*rli[r]);}
    asm volatile("s_waitcnt lgkmcnt(0)":::"memory");
    #pragma unroll
    for(int i=0;i<4;++i){const int row=i*8+(lane>>3),ch=lane&7; const u32x4 v=*(const u32x4*)(stg+row*64+ch*8); ATTN_STORE16(Ow+(long)row*QP_+ch*8,v);} }
  asm volatile("s_waitcnt lgkmcnt(0)\n\ts_barrier":::"memory");
  #undef DMA_K
  #undef DMA_V
  #undef CMASK
  #undef START
  #undef RESC
  #undef ROT
}
constexpr int ATTN_LDS_BYTES=LDS_BYTES;
struct AttnTensors { const bf16* Q; const bf16* K; const bf16* V; bf16* O; };
struct AttnUnit { int bh; int qb; };
struct StaticOrder {
  int vcu;
  __device__ __forceinline__ explicit StaticOrder(int grid,int block):vcu((block%8)*(grid/8)+block/8){}
  __device__ __forceinline__ bool next(int i,AttnUnit&u)const{ if(i>=4)return false; const int x=vcu>>5,c=vcu&31,idx=32*i+c; u.bh=2*x+(idx>>6); u.qb=idx&63; return true; }
  __device__ __forceinline__ void a_ready(const AttnUnit&)const{}
  __device__ __forceinline__ void done(const AttnUnit&)const{}
};
template<class Sched,int QP_,int KVP_,int SKV_,int GQ_,bool FIXM,int THRL=8> __device__ __forceinline__ void attn_phase(char*lds,const AttnTensors&T,const Sched&S,float mfix){
  AttnUnit u;
  for(int i=0;S.next(i,u);++i){ S.a_ready(u); attn_unit<THRL,QP_,KVP_,SKV_,GQ_,FIXM>(0,u.bh,u.qb,T.Q,T.K,T.V,T.O,lds,mfix); S.done(u); }
}
struct CrossOrder {
  int vcu;
  __device__ __forceinline__ explicit CrossOrder(int grid,int block):vcu((block%8)*(grid/8)+block/8){}
  __device__ __forceinline__ bool next(int i,AttnUnit&u)const{ if(i>=1||vcu>=256)return false; u.bh=vcu>>6; u.qb=vcu&63; return true; }
  __device__ __forceinline__ void a_ready(const AttnUnit&)const{}
  __device__ __forceinline__ void done(const AttnUnit&)const{}
};
#undef SBAR
#undef WAIT_BAR
}
constexpr int NWAVES = 8;
constexpr int M = 16384, D = 1024, FF = 2816, NIN = 4096, MEMLEN = 256, NCH = 512;
constexpr float C2Q = 0.125f * 1.4426950408889634f;
constexpr size_t MiB = 1u << 20, KiB = 1u << 10;
constexpr size_t WS_CTL = 0, CTL_ZERO_BYTES = 1 * MiB;
constexpr size_t WS_SS2 = 256 * KiB, WS_SS3 = 320 * KiB, WS_SS4 = 384 * KiB, WS_SS5 = 448 * KiB;
constexpr size_t WS_SMALL = 1 * MiB;
constexpr size_t WS_RS1 = WS_SMALL, WS_ROPE = WS_SMALL + 64 * KiB, WS_DFT = WS_SMALL + 112 * KiB, WS_TW = WS_SMALL + 128 * KiB, WS_KC = WS_SMALL + 256 * KiB, WS_VC = WS_SMALL + 384 * KiB;
constexpr size_t WS_W1GU = 2 * MiB, WS_W1D = 13 * MiB, WS_W2GU = 18 * MiB + 512 * KiB, WS_W2D = 29 * MiB + 512 * KiB, WS_WIN = 35 * MiB, WS_WFB = 43 * MiB, WS_WAB = 45 * MiB, WS_WOUT = 47 * MiB,
                 WS_WCQ = 49 * MiB, WS_WCO = 49 * MiB + 512 * KiB;
constexpr size_t WS_HB16 = 56 * MiB;
constexpr size_t WS_R1 = 88 * MiB;
constexpr size_t WS_QO = WS_R1, WS_U = WS_R1 + 32 * MiB, WS_KR = WS_R1 + 64 * MiB, WS_VR = WS_R1 + 72 * MiB, WS_F = WS_R1 + 80 * MiB;
constexpr size_t WS_QC = WS_R1, WS_OC = WS_R1 + 8 * MiB;
constexpr size_t WS_GF = 184 * MiB, WS_GA = 216 * MiB, WS_END = 248 * MiB;
static_assert(WS_W1GU + (size_t)2 * FF * D * 2 == WS_W1D && WS_W1D + (size_t)D * FF * 2 == WS_W2GU && WS_W2GU + (size_t)2 * FF * D * 2 == WS_W2D && WS_W2D + (size_t)D * FF * 2 == WS_WIN, "weights map");
static_assert(WS_R1 + (size_t)M * FF * 2 <= WS_GF && WS_F + (size_t)M * NCH * 2 <= WS_GF, "R1 map");
constexpr int CW_BAR = 4096;
constexpr int RING_BYTES = 131072, LDSCTL_OFF = RING_BYTES, MISC_OFF = LDSCTL_OFF + 320, LDS_BYTES = 147456;

#define GAS __attribute__((address_space(1)))
#define LAS __attribute__((address_space(3)))
typedef unsigned short bf16;
typedef unsigned v4u __attribute__((ext_vector_type(4)));
typedef float f32x4 __attribute__((ext_vector_type(4)));
typedef float f32x2 __attribute__((ext_vector_type(2)));
#define LDS_WAIT() asm volatile("s_waitcnt lgkmcnt(0)" ::: "memory")
#define VM_WAIT() asm volatile("s_waitcnt vmcnt(0)" ::: "memory")
__device__ __forceinline__ unsigned f2bf(float f) { unsigned u = __builtin_bit_cast(unsigned, f); return (u + 0x7fffu + ((u >> 16) & 1u)) >> 16; }
__device__ __forceinline__ unsigned pk2(float lo, float hi) { return f2bf(lo) | (f2bf(hi) << 16); }
__device__ __forceinline__ float bf2f(unsigned short b) { return __uint_as_float((unsigned)b << 16); }
__device__ __forceinline__ float bflo_(unsigned u) { return __uint_as_float(u << 16); }
__device__ __forceinline__ float bfhi_(unsigned u) { return __uint_as_float(u & 0xffff0000u); }
constexpr float RMS_EPSF = 1e-6f;
__device__ __forceinline__ float wave_sum(float v) {
#pragma unroll
    for (int o = 1; o < 64; o <<= 1) v += __shfl_xor(v, o);
    return v;
}
__device__ __forceinline__ void sincos_rev(double x, float& s, float& c) {
    x -= __builtin_floor(x);
    const double q = __builtin_rint(x * 4.0);
    const double r = (x - q * 0.25) * 6.283185307179586476925;
    const double r2 = r * r;
    double sp = 1.0 / 6227020800.0; sp = sp * r2 - 1.0 / 39916800.0; sp = sp * r2 + 1.0 / 362880.0; sp = sp * r2 - 1.0 / 5040.0; sp = sp * r2 + 1.0 / 120.0; sp = sp * r2 - 1.0 / 6.0; sp = sp * r2 + 1.0; sp *= r;
    double cp = -1.0 / 87178291200.0; cp = cp * r2 + 1.0 / 479001600.0; cp = cp * r2 - 1.0 / 3628800.0; cp = cp * r2 + 1.0 / 40320.0; cp = cp * r2 - 1.0 / 720.0; cp = cp * r2 + 1.0 / 24.0; cp = cp * r2 - 0.5; cp = cp * r2 + 1.0;
    const int qi = (int)q & 3;
    const double ss = (qi == 0) ? sp : (qi == 1) ? cp : (qi == 2) ? -sp : -cp;
    const double cc = (qi == 0) ? cp : (qi == 1) ? -sp : (qi == 2) ? -cp : sp;
    s = (float)ss; c = (float)cc;
}

struct Frame {
    LAS unsigned char* lds;
    int tid, lane, wave, G, vcu;
    const float* in[24]; float* out; unsigned char* ws;
};
template <class T> __device__ __forceinline__ T* wsp(const Frame& F, size_t off) { return (T*)(F.ws + off); }

__device__ __forceinline__ void p0_transpose_item(const float* W, const float* gain, int K, int N, bf16* WT, int gu, LAS float* scr, int item, int lane) {
    const int nblk = N / 32, kb = item / nblk, nb = item % nblk, k0 = 64 * kb, n0 = 32 * nb;
    f32x4 v[8];
#pragma unroll
    for (int i = 0; i < 8; ++i) { const int kk = (lane >> 3) + 8 * i; v[i] = *(const GAS f32x4*)(W + (size_t)(k0 + kk) * N + n0 + (lane & 7) * 4); }
#pragma unroll
    for (int i = 0; i < 8; ++i) { const int kk = (lane >> 3) + 8 * i; const float g = gain ? gain[k0 + kk] : 1.0f; LAS float* d = scr + kk * 33 + (lane & 7) * 4;
        d[0] = v[i].x * g; d[1] = v[i].y * g; d[2] = v[i].z * g; d[3] = v[i].w * g; }
    LDS_WAIT(); asm volatile("" ::: "memory");
    const int c = lane & 7;
    const int rb = (gu == 0) ? n0 : (256 * (n0 >> 7) + (n0 & 127) + (gu == 2 ? 128 : 0));
#pragma unroll
    for (int j = 0; j < 4; ++j) { const int n = (lane >> 3) + 8 * j; const LAS float* s = scr + (8 * c) * 33 + n;
        v4u o; o.x = pk2(s[0 * 33], s[1 * 33]); o.y = pk2(s[2 * 33], s[3 * 33]); o.z = pk2(s[4 * 33], s[5 * 33]); o.w = pk2(s[6 * 33], s[7 * 33]);
        *(GAS v4u*)(WT + (size_t)(rb + n) * K + k0 + 8 * c) = o; }
    LDS_WAIT(); asm volatile("" ::: "memory");
}
constexpr int I_GU = (D / 64) * (FF / 32), I_DN = (FF / 64) * (D / 32), I_IN = (D / 64) * (NIN / 32), I_SQ = (D / 64) * (D / 32), I_CQ = (D / 64) * (256 / 32), I_CO = (256 / 64) * (D / 32);
__device__ __forceinline__ void p0_weights_A1(Frame& F, int gw, int NGW) {
    LAS float* scr = (LAS float*)(F.lds + F.wave * 16384);
    constexpr int NITEMS = 2 * I_GU + I_DN + I_IN;
    for (int it = gw; it < NITEMS; it += NGW) {
        int r = it;
        if (r < I_GU) { p0_transpose_item(F.in[3], F.in[2], D, FF, wsp<bf16>(F, WS_W1GU), 1, scr, r, F.lane); continue; } r -= I_GU;
        if (r < I_GU) { p0_transpose_item(F.in[4], F.in[2], D, FF, wsp<bf16>(F, WS_W1GU), 2, scr, r, F.lane); continue; } r -= I_GU;
        if (r < I_DN) { p0_transpose_item(F.in[5], nullptr, FF, D, wsp<bf16>(F, WS_W1D), 0, scr, r, F.lane); continue; } r -= I_DN;
        p0_transpose_item(F.in[7], F.in[6], D, NIN, wsp<bf16>(F, WS_WIN), 0, scr, r, F.lane);
    }
}
__device__ __forceinline__ void p0_weights_A2(Frame& F, int gw, int NGW) {
    LAS float* scr = (LAS float*)(F.lds + F.wave * 16384);
    constexpr int NITEMS = 2 * I_SQ + I_CQ + I_CO;
    for (int it = gw; it < NITEMS; it += NGW) {
        int r = it;
        if (r < I_SQ) { p0_transpose_item(F.in[11], nullptr, D, D, wsp<bf16>(F, WS_WAB), 0, scr, r, F.lane); continue; } r -= I_SQ;
        if (r < I_SQ) { p0_transpose_item(F.in[12], nullptr, D, D, wsp<bf16>(F, WS_WOUT), 0, scr, r, F.lane); continue; } r -= I_SQ;
        if (r < I_CQ) { p0_transpose_item(F.in[15], F.in[13], D, 256, wsp<bf16>(F, WS_WCQ), 0, scr, r, F.lane); continue; } r -= I_CQ;
        p0_transpose_item(F.in[18], nullptr, 256, D, wsp<bf16>(F, WS_WCO), 0, scr, r, F.lane);
    }
}
__device__ __forceinline__ void p0_weights_B(Frame& F, int gw, int NGW) {
    LAS float* scr = (LAS float*)(F.lds + F.wave * 16384);
    constexpr int NITEMS = 2 * I_GU + I_DN;
    for (int it = gw; it < NITEMS; it += NGW) {
        int r = it;
        if (r < I_GU) { p0_transpose_item(F.in[20], F.in[19], D, FF, wsp<bf16>(F, WS_W2GU), 1, scr, r, F.lane); continue; } r -= I_GU;
        if (r < I_GU) { p0_transpose_item(F.in[21], F.in[19], D, FF, wsp<bf16>(F, WS_W2GU), 2, scr, r, F.lane); continue; } r -= I_GU;
        p0_transpose_item(F.in[22], nullptr, FF, D, wsp<bf16>(F, WS_W2D), 0, scr, r, F.lane);
    }
}
__device__ __forceinline__ void p_memkv_item(Frame& F, int item) {
    LAS float* mnT = (LAS float*)F.lds; LAS float* red = (LAS float*)(F.lds + 65536);
    const float* mem = F.in[1]; const float* gm = F.in[14];
    const int rg = item >> 3, cs = item & 7, r0 = 16 * rg;
    __syncthreads();
#pragma unroll
    for (int rr = 0; rr < 2; ++rr) {
        const int r = 2 * F.wave + rr; const GAS f32x4* xr = (const GAS f32x4*)(mem + (size_t)(r0 + r) * D) + F.lane;
        f32x4 v[4]; float s = 0.f;
#pragma unroll
        for (int j = 0; j < 4; ++j) { v[j] = xr[64 * j]; s += (v[j].x * v[j].x + v[j].y * v[j].y) + (v[j].z * v[j].z + v[j].w * v[j].w); }
        const float rinv = 1.0f / sqrtf(wave_sum(s) * (1.0f / D) + RMS_EPSF);
#pragma unroll
        for (int j = 0; j < 4; ++j) { const int k = 4 * F.lane + 256 * j; const f32x4 g = *(const GAS f32x4*)(gm + k);
            mnT[(k + 0) * 16 + r] = v[j].x * rinv * g.x; mnT[(k + 1) * 16 + r] = v[j].y * rinv * g.y; mnT[(k + 2) * 16 + r] = v[j].z * rinv * g.z; mnT[(k + 3) * 16 + r] = v[j].w * rinv * g.w; }
    }
    __syncthreads();
    const int oo = F.tid & 63, ks = F.wave, o = 64 * cs + oo, col = o & 255; const float* W = (o < 256) ? F.in[16] : F.in[17];
    float acc[16];
#pragma unroll
    for (int r = 0; r < 16; ++r) acc[r] = 0.f;
#pragma unroll 8
    for (int kk = 0; kk < 128; ++kk) {
        const int k = 128 * ks + kk; const float w = W[(size_t)k * 256 + col];
        const LAS f32x4* mp = (const LAS f32x4*)(mnT + k * 16);
        const f32x4 m0 = mp[0], m1 = mp[1], m2 = mp[2], m3 = mp[3];
        acc[0] += m0.x * w; acc[1] += m0.y * w; acc[2] += m0.z * w; acc[3] += m0.w * w; acc[4] += m1.x * w; acc[5] += m1.y * w; acc[6] += m1.z * w; acc[7] += m1.w * w;
        acc[8] += m2.x * w; acc[9] += m2.y * w; acc[10] += m2.z * w; acc[11] += m2.w * w; acc[12] += m3.x * w; acc[13] += m3.y * w; acc[14] += m3.z * w; acc[15] += m3.w * w;
    }
#pragma unroll
    for (int r = 0; r < 16; ++r) red[(ks * 16 + r) * 64 + oo] = acc[r];
    __syncthreads();
    bf16* Kc = wsp<bf16>(F, WS_KC); bf16* Vc = wsp<bf16>(F, WS_VC);
#pragma unroll
    for (int j = 0; j < 2; ++j) { const int idx = F.tid + 512 * j, r = idx >> 6, o2 = idx & 63; float t = 0.f;
#pragma unroll
        for (int q = 0; q < 8; ++q) t += red[(q * 16 + r) * 64 + o2];
        const int og = 64 * cs + o2; ((og < 256) ? Kc : Vc)[(r0 + r) * 256 + (og & 255)] = (bf16)f2bf(t); }
    __syncthreads();
}
__device__ __forceinline__ void p0_prologue(Frame& F) {
    const int gw = F.vcu * NWAVES + F.wave, NGW = F.G * NWAVES;
    const int gt = blockIdx.x * (NWAVES * 64) + F.tid, NGT = F.G * NWAVES * 64;
    {
        const float* x = F.in[0]; bf16* xb = wsp<bf16>(F, WS_HB16); float* rs1 = wsp<float>(F, WS_RS1);
        for (int m = gw; m < M; m += 2 * NGW) {
            const int m2 = m + NGW;
            const GAS f32x4* xr = (const GAS f32x4*)(x + (size_t)m * D) + F.lane; const GAS f32x4* xr2 = (const GAS f32x4*)(x + (size_t)m2 * D) + F.lane;
            f32x4 v[4], w[4]; float s = 0.f, s2 = 0.f;
#pragma unroll
            for (int j = 0; j < 4; ++j) { v[j] = xr[64 * j]; w[j] = xr2[64 * j]; }
#pragma unroll
            for (int j = 0; j < 4; ++j) { s += (v[j].x * v[j].x + v[j].y * v[j].y) + (v[j].z * v[j].z + v[j].w * v[j].w); s2 += (w[j].x * w[j].x + w[j].y * w[j].y) + (w[j].z * w[j].z + w[j].w * w[j].w); }
            s = wave_sum(s); s2 = wave_sum(s2);
            GAS unsigned long long* o8 = (GAS unsigned long long*)(xb + (size_t)m * D) + F.lane; GAS unsigned long long* o82 = (GAS unsigned long long*)(xb + (size_t)m2 * D) + F.lane;
#pragma unroll
            for (int j = 0; j < 4; ++j) { o8[64 * j] = (unsigned long long)pk2(v[j].x, v[j].y) | ((unsigned long long)pk2(v[j].z, v[j].w) << 32);
                                          o82[64 * j] = (unsigned long long)pk2(w[j].x, w[j].y) | ((unsigned long long)pk2(w[j].z, w[j].w) << 32); }
            if (F.lane == 0) { rs1[m] = 1.0f / sqrtf(s * (1.0f / D) + RMS_EPSF); rs1[m2] = 1.0f / sqrtf(s2 * (1.0f / D) + RMS_EPSF); }
        }
    }
    p0_weights_A1(F, gw, NGW);
}
__device__ __forceinline__ void p1_tail_work(Frame& F, int gt, int NGT, int gw, int NGW) {
    p0_weights_A2(F, gw, NGW);
    {
        f32x2* tw = wsp<f32x2>(F, WS_TW); f32x2* dft = wsp<f32x2>(F, WS_DFT); float* rope = wsp<float>(F, WS_ROPE);
        for (int i = gt; i < 16384; i += NGT) { float s, c; sincos_rev((double)i * (1.0 / 16384.0), s, c); tw[i] = (f32x2){c, s}; }
        for (int i = gt; i < 128; i += NGT) { float s, c; sincos_rev((double)i * (1.0 / 128.0), s, c); dft[i] = (f32x2){c, s}; }
        for (int i = gt; i < (256 + 64) * 16; i += NGT) {
            const int j = i & 15, p = i >> 4; const int pos = (p < 256) ? p : p - 256;
            double inv = 1.0; for (int q = 0; q < j; ++q) inv *= 0.5623413251903491;
            const float ang = (float)pos * (float)inv;
            float s, c; sincos_rev((double)ang * 0.15915494309189533577, s, c);
            if (p < 256) { rope[p * 16 + j] = c; rope[4096 + p * 16 + j] = s; } else { rope[8192 + pos * 16 + j] = c; rope[8192 + 1024 + pos * 16 + j] = s; }
        }
    }
    __syncthreads();
    {
        LAS f32x2* tab = (LAS f32x2*)F.lds;
        if (F.tid < 128) { float s, c; sincos_rev((double)F.tid * (1.0 / 128.0), s, c); tab[F.tid] = (f32x2){c * 0.08838834764831845f, s * 0.08838834764831845f}; }
        __syncthreads();
        const float* Wfb = F.in[10]; bf16* WT = wsp<bf16>(F, WS_WFB);
        for (int it = gt; it < 1024 * 128; it += NGT) {
            const int n = it & 1023, kb = it >> 10, kk0 = kb * 8, g = kk0 >> 8, ri = (kk0 >> 7) & 1, c0 = kk0 & 127;
            float a[8];
#pragma unroll
            for (int i = 0; i < 8; ++i) a[i] = 0.f;
#pragma unroll 4
            for (int j = 0; j < 128; ++j) {
                const float w = Wfb[(size_t)(g * 128 + j) * 1024 + n];
#pragma unroll
                for (int i = 0; i < 8; ++i) { const f32x2 cs = tab[((c0 + i) * j) & 127]; a[i] += w * (ri ? cs.y : cs.x); }
            }
            v4u o; o.x = pk2(a[0], a[1]); o.y = pk2(a[2], a[3]); o.z = pk2(a[4], a[5]); o.w = pk2(a[6], a[7]);
            *(GAS v4u*)(WT + (size_t)n * 1024 + kk0) = o;
        }
        __syncthreads();
    }
}
__device__ __forceinline__ void p9_idle_work(Frame& F) {
    const int bx = blockIdx.x;
    if (F.G != 256) {
        for (int it = bx; it < 128; it += F.G) p_memkv_item(F, it);
        p0_weights_B(F, bx * NWAVES + F.wave, F.G * NWAVES);
        return;
    }
    if (bx >= 64 && bx < 192) p_memkv_item(F, bx - 64);
    if (bx >= 64) p0_weights_B(F, (bx - 64) * NWAVES + F.wave, 192 * NWAVES);
}

__device__ __forceinline__ void p_prep_qk(Frame& F) {
    bf16* Q = wsp<bf16>(F, WS_QO); bf16* Kr = wsp<bf16>(F, WS_KR); const float* rope = wsp<float>(F, WS_ROPE);
    const float* qg = F.in[8]; const float* kg = F.in[9];
    const int gt = blockIdx.x * (NWAVES * 64) + F.tid, NGT = F.G * NWAVES * 64;
    for (int it = gt; it < M * 20; it += NGT) {
        const int t = it / 20, hh = it - t * 20;
        bf16* p = (hh < 16) ? (Q + (size_t)t * 1024 + hh * 64) : (Kr + (size_t)t * 256 + (hh - 16) * 64);
        const float* gain = (hh < 16) ? qg : kg; const float post = (hh < 16) ? C2Q : 1.0f;
        float v[64];
#pragma unroll
        for (int i = 0; i < 8; ++i) { const v4u w = *(const GAS v4u*)(p + 8 * i);
            v[8 * i + 0] = __uint_as_float(w.x << 16); v[8 * i + 1] = __uint_as_float(w.x & 0xffff0000u); v[8 * i + 2] = __uint_as_float(w.y << 16); v[8 * i + 3] = __uint_as_float(w.y & 0xffff0000u);
            v[8 * i + 4] = __uint_as_float(w.z << 16); v[8 * i + 5] = __uint_as_float(w.z & 0xffff0000u); v[8 * i + 6] = __uint_as_float(w.w << 16); v[8 * i + 7] = __uint_as_float(w.w & 0xffff0000u); }
        float s = 0.f;
#pragma unroll
        for (int i = 0; i < 64; ++i) s += v[i] * v[i];
        const float rinv = 1.0f / sqrtf(s * (1.0f / 64.0f) + RMS_EPSF);
#pragma unroll
        for (int i = 0; i < 64; ++i) v[i] = v[i] * rinv * gain[i];
        const int row = t >> 6, col = t & 63;
#pragma unroll
        for (int j = 0; j < 16; ++j) {
            const float cr = rope[row * 16 + j], sr = rope[4096 + row * 16 + j], cc = rope[8192 + col * 16 + j], sc = rope[8192 + 1024 + col * 16 + j];
            const float a = v[j], b = v[16 + j]; v[j] = a * cr - b * sr; v[16 + j] = b * cr + a * sr;
            const float e = v[32 + j], f = v[48 + j]; v[32 + j] = e * cc - f * sc; v[48 + j] = f * cc + e * sc;
        }
#pragma unroll
        for (int i = 0; i < 8; ++i) { v4u o; o.x = pk2(v[8 * i] * post, v[8 * i + 1] * post); o.y = pk2(v[8 * i + 2] * post, v[8 * i + 3] * post); o.z = pk2(v[8 * i + 4] * post, v[8 * i + 5] * post); o.w = pk2(v[8 * i + 6] * post, v[8 * i + 7] * post);
            *(GAS v4u*)(p + 8 * i) = o; }
    }
}
__device__ __forceinline__ void prep_vec(bf16* p, const float* gain, const float* rope, int t, int sub, float post) {
    const v4u w = *(const GAS v4u*)p;
    float y[8] = {bflo_(w.x), bfhi_(w.x), bflo_(w.y), bfhi_(w.y), bflo_(w.z), bfhi_(w.z), bflo_(w.w), bfhi_(w.w)};
    float s = 0.f;
#pragma unroll
    for (int e = 0; e < 8; ++e) s += y[e] * y[e];
    s += __shfl_xor(s, 1); s += __shfl_xor(s, 2); s += __shfl_xor(s, 4);
    const float rinv = 1.0f / sqrtf(s * (1.0f / 64.0f) + RMS_EPSF);
    const f32x4 g0 = *(const GAS f32x4*)(gain + 8 * sub), g1 = *(const GAS f32x4*)(gain + 8 * sub + 4);
#pragma unroll
    for (int e = 0; e < 4; ++e) { y[e] *= rinv * g0[e]; y[4 + e] *= rinv * g1[e]; }
    const int half = sub >> 2, pos = half ? (t & 63) : (t >> 6);
    const float* ct = rope + (half ? 8192 : 0) + pos * 16 + (sub & 1) * 8; const float* st = ct + (half ? 1024 : 4096);
    const f32x4 c0 = *(const GAS f32x4*)ct, c1 = *(const GAS f32x4*)(ct + 4), s0 = *(const GAS f32x4*)st, s1 = *(const GAS f32x4*)(st + 4);
    const float sgn = (sub & 2) ? 1.0f : -1.0f;
    float o[8];
#pragma unroll
    for (int e = 0; e < 8; ++e) { const float py = __shfl_xor(y[e], 2); const float c = e < 4 ? c0[e] : c1[e - 4], sn = e < 4 ? s0[e] : s1[e - 4]; o[e] = (y[e] * c + sgn * py * sn) * post; }
    v4u r; r.x = pk2(o[0], o[1]); r.y = pk2(o[2], o[3]); r.z = pk2(o[4], o[5]); r.w = pk2(o[6], o[7]);
    *(GAS v4u*)p = r;
}
__device__ __forceinline__ void p_prep_qk2(Frame& F) {
    bf16* Q = wsp<bf16>(F, WS_QO); bf16* Kr = wsp<bf16>(F, WS_KR); const float* rope = wsp<float>(F, WS_ROPE);
    const int sub = F.lane & 7, gv = (blockIdx.x * (NWAVES * 64) + F.tid) >> 3, NGV = (F.G * NWAVES * 64) >> 3;
    for (int v = gv; v < M * 16; v += NGV) prep_vec(Q + (size_t)v * 64 + sub * 8, F.in[8], rope, v >> 4, sub, C2Q);
    for (int v = gv; v < M * 4; v += NGV) prep_vec(Kr + (size_t)v * 64 + sub * 8, F.in[9], rope, v >> 2, sub, 1.0f);
}
__device__ __forceinline__ void p_fftA_simple(Frame& F) {
    const bf16* X = wsp<bf16>(F, WS_F); bf16* A = wsp<bf16>(F, WS_HB16); const f32x2* tw = wsp<f32x2>(F, WS_TW); const f32x2* dft = wsp<f32x2>(F, WS_DFT);
    LAS bf16* Xs = (LAS bf16*)F.lds; LAS f32x2* tab = (LAS f32x2*)(F.lds + 65536);
    if (F.tid < 128) tab[F.tid] = dft[F.tid];
    for (int unit = blockIdx.x; unit < 512; unit += F.G) {
        const int t2 = unit >> 2, g = unit & 3;
        __syncthreads();
#pragma unroll
        for (int i = 0; i < 4; ++i) { const int q = F.tid + 512 * i, row = q >> 4, ch = q & 15;
            *(LAS v4u*)(Xs + row * 128 + ch * 8) = *(const GAS v4u*)(X + (size_t)(128 * row + t2) * NCH + g * 128 + ch * 8); }
        __syncthreads();
        const int c = F.tid & 127, kq = F.tid >> 7;
        for (int k1 = kq * 32; k1 < kq * 32 + 32; ++k1) {
            float ar = 0.f, ai = 0.f; int idx = 0;
#pragma unroll 8
            for (int t1 = 0; t1 < 128; ++t1) { const float x = bf2f(Xs[t1 * 128 + c]); const f32x2 cs = tab[idx]; ar += x * cs.x; ai -= x * cs.y; idx = (idx + k1) & 127; }
            ar *= 0.08838834764831845f; ai *= 0.08838834764831845f;
            const f32x2 w = tw[t2 * k1];
            const float br = ar * w.x + ai * w.y, bi = ai * w.x - ar * w.y;
            bf16* o = A + ((size_t)(k1 * 128 + t2) * 4 + g) * 256 + c;
            o[0] = (bf16)f2bf(br); o[128] = (bf16)f2bf(bi);
        }
    }
    __syncthreads();
}
__device__ __forceinline__ void p_fftB_simple(Frame& F) {
    const bf16* A = wsp<bf16>(F, WS_HB16); bf16* U = wsp<bf16>(F, WS_U); const f32x2* dft = wsp<f32x2>(F, WS_DFT);
    LAS bf16* As = (LAS bf16*)F.lds; LAS f32x2* tab = (LAS f32x2*)(F.lds + 65536);
    if (F.tid < 128) tab[F.tid] = dft[F.tid];
    for (int unit = blockIdx.x; unit < 512; unit += F.G) {
        const int k1 = unit >> 2, g = unit & 3;
        __syncthreads();
#pragma unroll
        for (int i = 0; i < 8; ++i) { const int q = F.tid + 512 * i, row = q >> 5, ch = q & 31;
            *(LAS v4u*)(As + row * 256 + ch * 8) = *(const GAS v4u*)(A + ((size_t)(k1 * 128 + row) * 4 + g) * 256 + ch * 8); }
        __syncthreads();
        const int c = F.tid & 127, kq = F.tid >> 7;
        for (int k2 = kq * 32; k2 < kq * 32 + 32; ++k2) {
            float ur = 0.f, ui = 0.f; int idx = 0;
#pragma unroll 8
            for (int t2 = 0; t2 < 128; ++t2) { const float ar = bf2f(As[t2 * 256 + c]), ai = bf2f(As[t2 * 256 + 128 + c]); const f32x2 cs = tab[idx];
                ur += ar * cs.x + ai * cs.y; ui += ai * cs.x - ar * cs.y; idx = (idx + k2) & 127; }
            bf16* o = U + (size_t)(k1 + 128 * k2) * 1024 + g * 256 + c;
            o[0] = (bf16)f2bf(ur * 0.08838834764831845f); o[128] = (bf16)f2bf(ui * 0.08838834764831845f);
        }
    }
    __syncthreads();
}
__device__ __forceinline__ void p_attn_simple(Frame& F) {
    bf16* Q = wsp<bf16>(F, WS_QO); const bf16* Kr = wsp<bf16>(F, WS_KR); const bf16* Vr = wsp<bf16>(F, WS_VR);
    const int gt = blockIdx.x * (NWAVES * 64) + F.tid, NGT = F.G * NWAVES * 64;
    for (int it = gt; it < M * 16; it += NGT) {
        const int h = it >> 14, t = it & (M - 1), kvh = h >> 2;
        bf16* qp = Q + (size_t)t * 1024 + h * 64;
        float q[64], o[64];
#pragma unroll
        for (int i = 0; i < 8; ++i) { const v4u w = *(const GAS v4u*)(qp + 8 * i);
            q[8 * i + 0] = bflo_(w.x); q[8 * i + 1] = bfhi_(w.x); q[8 * i + 2] = bflo_(w.y); q[8 * i + 3] = bfhi_(w.y); q[8 * i + 4] = bflo_(w.z); q[8 * i + 5] = bfhi_(w.z); q[8 * i + 6] = bflo_(w.w); q[8 * i + 7] = bfhi_(w.w); }
#pragma unroll
        for (int i = 0; i < 64; ++i) o[i] = 0.f;
        float mx = -1e30f, l = 0.f;
        for (int key = 0; key < M; ++key) {
            const bf16* kp = Kr + (size_t)key * 256 + kvh * 64; const bf16* vp = Vr + (size_t)key * 256 + kvh * 64;
            float s = 0.f;
#pragma unroll
            for (int i = 0; i < 8; ++i) { const v4u w = *(const GAS v4u*)(kp + 8 * i);
                s += q[8 * i + 0] * bflo_(w.x) + q[8 * i + 1] * bfhi_(w.x) + q[8 * i + 2] * bflo_(w.y) + q[8 * i + 3] * bfhi_(w.y) + q[8 * i + 4] * bflo_(w.z) + q[8 * i + 5] * bfhi_(w.z) + q[8 * i + 6] * bflo_(w.w) + q[8 * i + 7] * bfhi_(w.w); }
            const float mn = fmaxf(mx, s), al = __builtin_amdgcn_exp2f(mx - mn), p = __builtin_amdgcn_exp2f(s - mn);
            l = l * al + p; mx = mn;
#pragma unroll
            for (int i = 0; i < 8; ++i) { const v4u w = *(const GAS v4u*)(vp + 8 * i);
                o[8 * i + 0] = o[8 * i + 0] * al + p * bflo_(w.x); o[8 * i + 1] = o[8 * i + 1] * al + p * bfhi_(w.x); o[8 * i + 2] = o[8 * i + 2] * al + p * bflo_(w.y); o[8 * i + 3] = o[8 * i + 3] * al + p * bfhi_(w.y);
                o[8 * i + 4] = o[8 * i + 4] * al + p * bflo_(w.z); o[8 * i + 5] = o[8 * i + 5] * al + p * bfhi_(w.z); o[8 * i + 6] = o[8 * i + 6] * al + p * bflo_(w.w); o[8 * i + 7] = o[8 * i + 7] * al + p * bfhi_(w.w); }
        }
        const float li = 1.0f / l;
#pragma unroll
        for (int i = 0; i < 8; ++i) { v4u w; w.x = pk2(o[8 * i] * li, o[8 * i + 1] * li); w.y = pk2(o[8 * i + 2] * li, o[8 * i + 3] * li); w.z = pk2(o[8 * i + 4] * li, o[8 * i + 5] * li); w.w = pk2(o[8 * i + 6] * li, o[8 * i + 7] * li);
            *(GAS v4u*)(qp + 8 * i) = w; }
    }
}
__device__ __forceinline__ void p_cross_simple(Frame& F) {
    const bf16* QC = wsp<bf16>(F, WS_QC); bf16* OC = wsp<bf16>(F, WS_OC); const bf16* Kc = wsp<bf16>(F, WS_KC); const bf16* Vc = wsp<bf16>(F, WS_VC);
    const int gt = blockIdx.x * (NWAVES * 64) + F.tid, NGT = F.G * NWAVES * 64;
    for (int it = gt; it < M * 4; it += NGT) {
        const int h = it >> 14, t = it & (M - 1);
        const bf16* qp = QC + (size_t)t * 256 + h * 64;
        float q[64], o[64];
#pragma unroll
        for (int i = 0; i < 8; ++i) { const v4u w = *(const GAS v4u*)(qp + 8 * i);
            q[8 * i + 0] = bflo_(w.x) * C2Q; q[8 * i + 1] = bfhi_(w.x) * C2Q; q[8 * i + 2] = bflo_(w.y) * C2Q; q[8 * i + 3] = bfhi_(w.y) * C2Q; q[8 * i + 4] = bflo_(w.z) * C2Q; q[8 * i + 5] = bfhi_(w.z) * C2Q; q[8 * i + 6] = bflo_(w.w) * C2Q; q[8 * i + 7] = bfhi_(w.w) * C2Q; }
#pragma unroll
        for (int i = 0; i < 64; ++i) o[i] = 0.f;
        float mx = -1e30f, l = 0.f;
        for (int key = 0; key < MEMLEN; ++key) {
            const bf16* kp = Kc + key * 256 + h * 64; const bf16* vp = Vc + key * 256 + h * 64;
            float s = 0.f;
#pragma unroll
            for (int i = 0; i < 8; ++i) { const v4u w = *(const GAS v4u*)(kp + 8 * i);
                s += q[8 * i + 0] * bflo_(w.x) + q[8 * i + 1] * bfhi_(w.x) + q[8 * i + 2] * bflo_(w.y) + q[8 * i + 3] * bfhi_(w.y) + q[8 * i + 4] * bflo_(w.z) + q[8 * i + 5] * bfhi_(w.z) + q[8 * i + 6] * bflo_(w.w) + q[8 * i + 7] * bfhi_(w.w); }
            const float mn = fmaxf(mx, s), al = __builtin_amdgcn_exp2f(mx - mn), p = __builtin_amdgcn_exp2f(s - mn);
            l = l * al + p; mx = mn;
#pragma unroll
            for (int i = 0; i < 8; ++i) { const v4u w = *(const GAS v4u*)(vp + 8 * i);
                o[8 * i + 0] = o[8 * i + 0] * al + p * bflo_(w.x); o[8 * i + 1] = o[8 * i + 1] * al + p * bfhi_(w.x); o[8 * i + 2] = o[8 * i + 2] * al + p * bflo_(w.y); o[8 * i + 3] = o[8 * i + 3] * al + p * bfhi_(w.y);
                o[8 * i + 4] = o[8 * i + 4] * al + p * bflo_(w.z); o[8 * i + 5] = o[8 * i + 5] * al + p * bfhi_(w.z); o[8 * i + 6] = o[8 * i + 6] * al + p * bflo_(w.w); o[8 * i + 7] = o[8 * i + 7] * al + p * bfhi_(w.w); }
        }
        const float li = 1.0f / l; bf16* op = OC + (size_t)t * 256 + h * 64;
#pragma unroll
        for (int i = 0; i < 8; ++i) { v4u w; w.x = pk2(o[8 * i] * li, o[8 * i + 1] * li); w.y = pk2(o[8 * i + 2] * li, o[8 * i + 3] * li); w.z = pk2(o[8 * i + 4] * li, o[8 * i + 5] * li); w.w = pk2(o[8 * i + 6] * li, o[8 * i + 7] * li);
            *(GAS v4u*)(op + 8 * i) = w; }
    }
}
__device__ __forceinline__ void p_final(Frame& F) {
    const int gw = F.vcu * NWAVES + F.wave, NGW = F.G * NWAVES; const float* gf = F.in[23];
    f32x4 gv[4];
#pragma unroll
    for (int j = 0; j < 4; ++j) gv[j] = ((const GAS f32x4*)gf)[F.lane + 64 * j];
    for (int m = gw; m < M; m += NGW) {
        GAS f32x4* xr = (GAS f32x4*)(F.out + (size_t)m * D) + F.lane;
        f32x4 v[4]; float s = 0.f;
#pragma unroll
        for (int j = 0; j < 4; ++j) { v[j] = xr[64 * j]; s += (v[j].x * v[j].x + v[j].y * v[j].y) + (v[j].z * v[j].z + v[j].w * v[j].w); }
        const float rinv = 1.0f / sqrtf(wave_sum(s) * (1.0f / D) + RMS_EPSF);
#pragma unroll
        for (int j = 0; j < 4; ++j) xr[64 * j] = v[j] * rinv * gv[j];
    }
}
namespace fftm {
typedef short bf16x8 __attribute__((ext_vector_type(8)));
typedef short s16x4 __attribute__((ext_vector_type(4)));
typedef float f32x16 __attribute__((ext_vector_type(16)));
typedef short v4i16_t __attribute__((ext_vector_type(4)));
typedef LAS const unsigned char* lptr;
constexpr int STR_A = 320, STR_B = 576;
constexpr float RSQ128 = 0.08838834764831845f;
#define FFT_MFMA(a, b, c) __builtin_amdgcn_mfma_f32_32x32x16_bf16(a, b, c, 0, 0, 0)
__device__ __forceinline__ s16x4 vtr(lptr p) { return __builtin_bit_cast(s16x4, __builtin_amdgcn_ds_read_tr16_b64_v4i16((LAS v4i16_t*)p)); }
struct DftFrags { bf16x8 c[8], s[8]; };
__device__ __forceinline__ void make_frags(DftFrags& f, const f32x2* dft, int jb, int lane) {
    const int j = 32 * jb + (lane & 31), h = lane >> 5;
#pragma unroll
    for (int s = 0; s < 8; ++s)
#pragma unroll
        for (int e = 0; e < 8; ++e) { const f32x2 cs = dft[(j * (16 * s + 8 * h + e)) & 127]; f.c[s][e] = (short)f2bf(cs.x * RSQ128); f.s[s][e] = (short)f2bf(cs.y * RSQ128); }
}
template <int STRIDE> __device__ __forceinline__ bf16x8 tfrag(lptr p, int s) {
    const s16x4 lo = vtr(p + 16 * s * STRIDE), hi = vtr(p + 16 * s * STRIDE + 4 * STRIDE);
    return (bf16x8){lo[0], lo[1], lo[2], lo[3], hi[0], hi[1], hi[2], hi[3]};
}
template <int STRIDE> __device__ __forceinline__ int tfrag_lane_off(int lane) {
    const int g4 = lane >> 4, c0 = 16 * (g4 & 1), h = g4 >> 1, li = lane & 15, q = li >> 2, p = li & 3;
    return (8 * h + q) * STRIDE + (c0 + 4 * p) * 2;
}
__device__ __forceinline__ unsigned long long pk4(float a, float b, float c, float d) { return (unsigned long long)pg8::cvt_pk_bf16(a, b) | ((unsigned long long)pg8::cvt_pk_bf16(c, d) << 32); }

__device__ __forceinline__ void stageA(Frame& F) {
    const bf16* X = wsp<bf16>(F, WS_F); bf16* A = wsp<bf16>(F, WS_HB16); const f32x2* tw = wsp<f32x2>(F, WS_TW); const f32x2* dft = wsp<f32x2>(F, WS_DFT);
    const int jb = F.wave & 3, chh = F.wave >> 2, lane = F.lane, h = lane >> 5;
    DftFrags fr; make_frags(fr, dft, jb, lane);
    const lptr tp = (lptr)F.lds + tfrag_lane_off<STR_A>(lane) + 128 * chh;
    const int k1 = 32 * jb + (lane & 31);
    v4u pre[4];
    int unit = blockIdx.x;
    if (unit < 512) {
#pragma unroll
        for (int i = 0; i < 4; ++i) { const int q = F.tid + 512 * i, row = q >> 4, ch = q & 15; pre[i] = *(const GAS v4u*)(X + (size_t)(128 * row + (unit >> 2)) * NCH + (unit & 3) * 128 + ch * 8); }
    }
    for (; unit < 512; unit += F.G) {
        const int t2 = unit >> 2, g = unit & 3;
        __syncthreads();
#pragma unroll
        for (int i = 0; i < 4; ++i) { const int q = F.tid + 512 * i, row = q >> 4, ch = q & 15; *(LAS v4u*)(F.lds + row * STR_A + ch * 16) = pre[i]; }
        __syncthreads();
        const int nu = unit + F.G;
        if (nu < 512) {
#pragma unroll
            for (int i = 0; i < 4; ++i) { const int q = F.tid + 512 * i, row = q >> 4, ch = q & 15; pre[i] = *(const GAS v4u*)(X + (size_t)(128 * row + (nu >> 2)) * NCH + (nu & 3) * 128 + ch * 8); }
        }
        f32x16 acc[2][2];
#pragma unroll
        for (int cb = 0; cb < 2; ++cb) { acc[cb][0] = f32x16{}; acc[cb][1] = f32x16{}; }
#pragma unroll
        for (int s = 0; s < 8; ++s)
#pragma unroll
            for (int cb = 0; cb < 2; ++cb) { const bf16x8 a = tfrag<STR_A>(tp + 64 * cb, s); acc[cb][0] = FFT_MFMA(a, fr.c[s], acc[cb][0]); acc[cb][1] = FFT_MFMA(a, fr.s[s], acc[cb][1]); }
        const f32x2 w = tw[t2 * k1];
        bf16* orow = A + ((size_t)(k1 * 128 + t2) * 4 + g) * 256 + 64 * chh + 4 * h;
#pragma unroll
        for (int cb = 0; cb < 2; ++cb)
#pragma unroll
            for (int qd = 0; qd < 4; ++qd) {
                float re[4], im[4];
#pragma unroll
                for (int i = 0; i < 4; ++i) { const float a0 = acc[cb][0][4 * qd + i], a1 = acc[cb][1][4 * qd + i]; re[i] = a0 * w.x - a1 * w.y; im[i] = -a1 * w.x - a0 * w.y; }
                *(GAS unsigned long long*)(orow + 32 * cb + 8 * qd) = pk4(re[0], re[1], re[2], re[3]);
                *(GAS unsigned long long*)(orow + 128 + 32 * cb + 8 * qd) = pk4(im[0], im[1], im[2], im[3]);
            }
    }
    __syncthreads();
}
__device__ __forceinline__ void stageB(Frame& F) {
    const bf16* A = wsp<bf16>(F, WS_HB16); bf16* U = wsp<bf16>(F, WS_U); const f32x2* dft = wsp<f32x2>(F, WS_DFT);
    const int jb = F.wave & 3, chh = F.wave >> 2, lane = F.lane, h = lane >> 5;
    DftFrags fr; make_frags(fr, dft, jb, lane);
    const lptr tp = (lptr)F.lds + tfrag_lane_off<STR_B>(lane) + 128 * chh;
    const int k2 = 32 * jb + (lane & 31);
    v4u pre[8];
    int unit = blockIdx.x;
    if (unit < 512) {
#pragma unroll
        for (int i = 0; i < 8; ++i) { const int q = F.tid + 512 * i, row = q >> 5, ch = q & 31; pre[i] = *(const GAS v4u*)(A + ((size_t)((unit >> 2) * 128 + row) * 4 + (unit & 3)) * 256 + ch * 8); }
    }
    for (; unit < 512; unit += F.G) {
        const int k1 = unit >> 2, g = unit & 3;
        __syncthreads();
#pragma unroll
        for (int i = 0; i < 8; ++i) { const int q = F.tid + 512 * i, row = q >> 5, ch = q & 31; *(LAS v4u*)(F.lds + row * STR_B + ch * 16) = pre[i]; }
        __syncthreads();
        const int nu = unit + F.G;
        if (nu < 512) {
#pragma unroll
            for (int i = 0; i < 8; ++i) { const int q = F.tid + 512 * i, row = q >> 5, ch = q & 31; pre[i] = *(const GAS v4u*)(A + ((size_t)((nu >> 2) * 128 + row) * 4 + (nu & 3)) * 256 + ch * 8); }
        }
        f32x16 accR[2], accI[2];
#pragma unroll
        for (int cb = 0; cb < 2; ++cb) { accR[cb] = f32x16{}; accI[cb] = f32x16{}; }
#pragma unroll
        for (int s = 0; s < 8; ++s) {
            const bf16x8 ns = fr.s[s] ^ (short)0x8000;
#pragma unroll
            for (int cb = 0; cb < 2; ++cb) {
                const bf16x8 ar = tfrag<STR_B>(tp + 64 * cb, s), ai = tfrag<STR_B>(tp + 256 + 64 * cb, s);
                accR[cb] = FFT_MFMA(ar, fr.c[s], accR[cb]); accR[cb] = FFT_MFMA(ai, fr.s[s], accR[cb]);
                accI[cb] = FFT_MFMA(ai, fr.c[s], accI[cb]); accI[cb] = FFT_MFMA(ar, ns, accI[cb]);
            }
        }
        bf16* orow = U + (size_t)(k1 + 128 * k2) * 1024 + g * 256 + 64 * chh + 4 * h;
#pragma unroll
        for (int cb = 0; cb < 2; ++cb)
#pragma unroll
            for (int qd = 0; qd < 4; ++qd) {
                *(GAS unsigned long long*)(orow + 32 * cb + 8 * qd) = pk4(accR[cb][4 * qd], accR[cb][4 * qd + 1], accR[cb][4 * qd + 2], accR[cb][4 * qd + 3]);
                *(GAS unsigned long long*)(orow + 128 + 32 * cb + 8 * qd) = pk4(accI[cb][4 * qd], accI[cb][4 * qd + 1], accI[cb][4 * qd + 2], accI[cb][4 * qd + 3]);
            }
    }
    __syncthreads();
}
#undef FFT_MFMA
}
#define XB_TMO      128
#define XB_XCNT(j)  (256  + 64 * (j))
#define XB_XSUB(j)  (1280 + 64 * (j))
#define XB_XGEN(j)  (2304 + 64 * (j))
#define XB_TOP      3328
#define XB_TOPGEN   3392
#define XCD_BAR_WORDS 3456
#define XB_SPIN_CAP (1u << 18)

__device__ __forceinline__ unsigned xb_ld(unsigned* p)              { return __hip_atomic_load(p, __ATOMIC_RELAXED, __HIP_MEMORY_SCOPE_AGENT); }
__device__ __forceinline__ unsigned xb_add(unsigned* p, unsigned v) { return __hip_atomic_fetch_add(p, v, __ATOMIC_RELAXED, __HIP_MEMORY_SCOPE_AGENT); }
__device__ __forceinline__ unsigned xb_xcc_id() { return (unsigned)__builtin_amdgcn_s_getreg((3 << 11) | 20) & 0xFu; }
#define XB_SPIN(cond, bar) do { unsigned _sp = 0; while (cond) { __builtin_amdgcn_s_sleep(1); \
    if ((++_sp & 255u) == 0u) { if (xb_ld(&(bar)[XB_TMO])) break; if (_sp > XB_SPIN_CAP) { atomicAdd(&(bar)[XB_TMO], 1u); break; } } } } while (0)

struct XcdBarrier {
    unsigned* bar; unsigned x;
    volatile LAS unsigned* st;
};

__device__ __forceinline__ XcdBarrier xcd_barrier_post(unsigned* bar, volatile LAS unsigned* st) {
    XcdBarrier b; b.bar = bar; b.x = xb_xcc_id(); b.st = st;
    if (threadIdx.x == 0) (void)xb_add(&bar[XB_XCNT(b.x)], 1u);
    return b;
}
__device__ __forceinline__ void xcd_barrier_complete(unsigned* bar, unsigned x, unsigned& nloc, unsigned& nx) {
    const unsigned G = gridDim.x * gridDim.y * gridDim.z;
    unsigned sum, cnt, mine, sp = 0u;
    for (;;) {
        sum = 0u; cnt = 0u; mine = 0u;
#pragma unroll
        for (unsigned j = 0; j < 16; ++j) { const unsigned c = xb_ld(&bar[XB_XCNT(j)]); sum += c; cnt += (c > 0u) ? 1u : 0u; mine = (j == x) ? c : mine; }
        if (sum == G) break;
        __builtin_amdgcn_s_sleep(1);
        if ((++sp & 255u) == 0u) { if (xb_ld(&bar[XB_TMO])) break; if (sp > XB_SPIN_CAP) { atomicAdd(&bar[XB_TMO], 1u); break; } }
    }
    nloc = mine > 0u ? mine : 1u; nx = cnt > 0u ? cnt : 1u;
}

__device__ __forceinline__ void xcd_barrier(const XcdBarrier& b) {
    asm volatile("s_waitcnt vmcnt(0)" ::: "memory");
    __syncthreads();
    if (threadIdx.x == 0) {
        unsigned* bar = b.bar;
        __builtin_amdgcn_s_waitcnt(0);
        unsigned nloc = b.st[0], nx = b.st[1];
        if (nloc == 0u) { xcd_barrier_complete(bar, b.x, nloc, nx); b.st[0] = nloc; b.st[1] = nx; }
        const unsigned old = xb_add(&bar[XB_XSUB(b.x)], 1u);
        const unsigned gen = old / nloc;
        if (old + 1u == (gen + 1u) * nloc) {
            __builtin_amdgcn_fence(__ATOMIC_RELEASE, "agent");
            asm volatile("s_waitcnt vmcnt(0)" ::: "memory");
            const unsigned og = xb_add(&bar[XB_TOP], 1u);
            const unsigned tg = og / nx;
            if (og + 1u == (tg + 1u) * nx) xb_add(&bar[XB_TOPGEN], 1u);
            else XB_SPIN(xb_ld(&bar[XB_TOPGEN]) == tg, bar);
            __builtin_amdgcn_fence(__ATOMIC_ACQUIRE, "agent");
            xb_add(&bar[XB_XGEN(b.x)], 1u);
            asm volatile("s_waitcnt vmcnt(0)" ::: "memory");
        } else {
            XB_SPIN(xb_ld(&bar[XB_XGEN(b.x)]) == gen, bar);
            __builtin_amdgcn_fence(__ATOMIC_ACQUIRE, "agent");
            asm volatile("s_waitcnt vmcnt(0)" ::: "memory");
        }
    }
    __syncthreads();
}
constexpr int N_PHASES = 15;
struct Args { const float* in[24]; float* out; unsigned char* ws; int ph_lo, ph_hi; };
__global__ void __launch_bounds__(NWAVES * 64, 2) mk_fwd(Args args) {
    extern __shared__ __attribute__((aligned(16))) unsigned char lds[];
    Frame F;
    F.lds = (LAS unsigned char*)lds;
    F.tid = threadIdx.x; F.lane = F.tid & 63; F.wave = __builtin_amdgcn_readfirstlane(F.tid >> 6);
    F.G = gridDim.x; { const int bx = blockIdx.x; F.vcu = (F.G % 8 == 0) ? (bx % 8) * (F.G / 8) + bx / 8 : bx; }
#pragma unroll
    for (int i = 0; i < 24; ++i) F.in[i] = args.in[i];
    F.out = args.out; F.ws = args.ws;
    const int lo = args.ph_lo, hi = args.ph_hi;
    for (int u = F.tid; u < (LDS_BYTES - LDSCTL_OFF) / 4; u += NWAVES * 64) ((LAS unsigned*)(F.lds + LDSCTL_OFF))[u] = 0u;
    __syncthreads();
    XcdBarrier bar = xcd_barrier_post((unsigned*)(F.ws + WS_CTL) + CW_BAR, (volatile LAS unsigned*)(F.lds + MISC_OFF) + 8);
#define IN(k) (lo <= (k) && (k) < hi)
#define BOTH(k) (IN(k) && IN((k) + 1))
#define GRID_BAR() xcd_barrier(bar)
#define GRID_BAR_CG() do { cooperative_groups::this_grid().sync(); } while (0)
    bf16* const HB16 = wsp<bf16>(F, WS_HB16); bf16* const HH = wsp<bf16>(F, WS_R1);
    bf16* const QO = wsp<bf16>(F, WS_QO); bf16* const UU = wsp<bf16>(F, WS_U); bf16* const KR = wsp<bf16>(F, WS_KR); bf16* const VR = wsp<bf16>(F, WS_VR); bf16* const FB = wsp<bf16>(F, WS_F);
    bf16* const GFB = wsp<bf16>(F, WS_GF); bf16* const GAB = wsp<bf16>(F, WS_GA); bf16* const QC = wsp<bf16>(F, WS_QC); bf16* const OC = wsp<bf16>(F, WS_OC);
    float* const SS2 = wsp<float>(F, WS_SS2); float* const SS3 = wsp<float>(F, WS_SS3); float* const SS4 = wsp<float>(F, WS_SS4);

#if defined(MK_PROBE_MASK)
    unsigned long long pr_prev = __builtin_amdgcn_s_memrealtime(), pr_acc = 0ull;
#define PROBE_END(k) do { const unsigned long long _t = __builtin_amdgcn_s_memrealtime(); if ((MK_PROBE_MASK >> (k)) & 1) pr_acc += _t - pr_prev; pr_prev = _t; } while (0)
#else
#define PROBE_END(k) do { } while (0)
#endif
    if (IN(0)) { p0_prologue(F); if (BOTH(0)) GRID_BAR(); PROBE_END(0); }
    if (IN(1)) {
        pg8::Gemm g{HB16, wsp<bf16>(F, WS_W1GU), M, 2 * FF, D}; pg8::StaticOrder S; S.init(M, 2 * FF, F.G, (int)blockIdx.x);
        pg8::EpiSwiGLU E{HH, FF, wsp<float>(F, WS_RS1), 0};
        pg8::gemm_phase<pg8::EpiSwiGLU, pg8::StaticOrder, true, true>(F.lds, g, S, E);
        if (F.G == 256) { if (blockIdx.x >= 128) p1_tail_work(F, (blockIdx.x - 128) * (NWAVES * 64) + F.tid, 128 * NWAVES * 64, (blockIdx.x - 128) * NWAVES + F.wave, 128 * NWAVES); }
        else p1_tail_work(F, blockIdx.x * (NWAVES * 64) + F.tid, F.G * NWAVES * 64, blockIdx.x * NWAVES + F.wave, F.G * NWAVES);
        if (BOTH(1)) GRID_BAR(); PROBE_END(1);
    }
    if (IN(2)) {
        pg8::Gemm g{HH, wsp<bf16>(F, WS_W1D), M, D, FF}; pg8::StaticOrder S; S.init(M, D, F.G, (int)blockIdx.x);
        pg8::EpiResid E{F.in[0], F.out, HB16, SS2, 0.5f, D};
        pg8::gemm_phase<pg8::EpiResid, pg8::StaticOrder, true, true>(F.lds, g, S, E);
        if (BOTH(2)) GRID_BAR(); PROBE_END(2);
    }
    if (IN(3)) {
        pg8::Gemm g{HB16, wsp<bf16>(F, WS_WIN), M, NIN, D}; pg8::StaticOrder S; S.init(M, NIN, F.G, (int)blockIdx.x);
        pg8::EpiRoute E{{QO, KR, VR, FB, GFB, GAB}, SS2, 1, 1, 0, 1.0f};
        pg8::gemm_phase<pg8::EpiRoute, pg8::StaticOrder, true, true>(F.lds, g, S, E);
        if (BOTH(3)) GRID_BAR(); PROBE_END(3);
    }
    if (IN(4)) {
#if defined(PREP_SIMPLE)
        p_prep_qk(F);
#else
        p_prep_qk2(F);
#endif
#if defined(FFT_SIMPLE) || defined(FFTA_SIMPLE)
        p_fftA_simple(F);
#else
        fftm::stageA(F);
#endif
        if (BOTH(4)) GRID_BAR(); PROBE_END(4); }
    if (IN(5)) {
#if defined(FFT_SIMPLE) || defined(FFTB_SIMPLE)
        p_fftB_simple(F);
#else
        fftm::stageB(F);
#endif
        if (BOTH(5)) GRID_BAR(); PROBE_END(5); }
    if (IN(6)) {
#if defined(ATTN_SIMPLE)
        p_attn_simple(F);
#else
        static_assert(attn_body::ATTN_LDS_BYTES <= RING_BYTES, "attention LDS");
        const attn_body::AttnTensors AT{(const attn_body::bf16*)QO, (const attn_body::bf16*)KR, (const attn_body::bf16*)VR, (attn_body::bf16*)QO};
        const attn_body::StaticOrder S((int)F.G, (int)blockIdx.x);
        float gq = fabsf(F.in[8][F.lane]), gk = fabsf(F.in[9][F.lane]);
#pragma unroll
        for (int o = 1; o < 64; o <<= 1) { gq = fmaxf(gq, __shfl_xor(gq, o)); gk = fmaxf(gk, __shfl_xor(gk, o)); }
        const float mfix = 1.02f * C2Q * 64.0f * gq * gk;
#if defined(ATTN_TRACKMAX)
        attn_body::attn_phase<attn_body::StaticOrder, 1024, 256, 16384, 4, false>((char*)lds, AT, S, 0.f);
#else
        attn_body::attn_phase<attn_body::StaticOrder, 1024, 256, 16384, 4, true>((char*)lds, AT, S, mfix);
#endif
#endif
        if (BOTH(6)) GRID_BAR(); PROBE_END(6);
    }
    if (IN(7)) {
        { pg8::Gemm g{UU, wsp<bf16>(F, WS_WFB), M, D, D}; pg8::StaticOrder S; S.init(M, D, F.G, (int)blockIdx.x);
          pg8::EpiGate E{GFB, nullptr, 1};
          pg8::gemm_phase<pg8::EpiGate, pg8::StaticOrder, true, true>(F.lds, g, S, E); }
        VM_WAIT(); __syncthreads();
        if (F.tid == 0) { __builtin_amdgcn_fence(__ATOMIC_ACQUIRE, "agent"); VM_WAIT(); }
        __syncthreads();
        { pg8::Gemm g{QO, wsp<bf16>(F, WS_WAB), M, D, D}; pg8::StaticOrder S; S.init(M, D, F.G, (int)blockIdx.x);
          pg8::EpiGate E{GAB, GFB, 2};
          pg8::gemm_phase<pg8::EpiGate, pg8::StaticOrder, true, true>(F.lds, g, S, E); }
        if (BOTH(7)) GRID_BAR(); PROBE_END(7);
    }
    if (IN(8)) {
        pg8::Gemm g{GAB, wsp<bf16>(F, WS_WOUT), M, D, D}; pg8::StaticOrder S; S.init(M, D, F.G, (int)blockIdx.x);
        pg8::EpiResid E{F.out, F.out, HB16, SS3, 1.0f, D};
        pg8::gemm_phase<pg8::EpiResid, pg8::StaticOrder, true, true>(F.lds, g, S, E);
        if (BOTH(8)) GRID_BAR(); PROBE_END(8);
    }
    if (IN(9)) {
        pg8::Gemm g{HB16, wsp<bf16>(F, WS_WCQ), M, 256, D}; pg8::StaticOrder S; S.init(M, 256, F.G, (int)blockIdx.x);
        #if defined(CROSS_SIMPLE)
        pg8::EpiRoute E{{QC, nullptr, nullptr, nullptr, nullptr, nullptr}, SS3, 1, 0, 256, 1.0f};
#else
        pg8::EpiRoute E{{QC, nullptr, nullptr, nullptr, nullptr, nullptr}, SS3, 1, 0, 256, C2Q};
#endif
        pg8::gemm_phase<pg8::EpiRoute, pg8::StaticOrder, true, true>(F.lds, g, S, E);
        p9_idle_work(F);
        if (BOTH(9)) GRID_BAR(); PROBE_END(9);
    }
    if (IN(10)) {
#if defined(CROSS_SIMPLE)
        p_cross_simple(F);
#else
        const attn_body::AttnTensors AT{(const attn_body::bf16*)QC, (const attn_body::bf16*)wsp<bf16>(F, WS_KC), (const attn_body::bf16*)wsp<bf16>(F, WS_VC), (attn_body::bf16*)OC};
        const attn_body::CrossOrder S((int)F.G, (int)blockIdx.x);
        attn_body::attn_phase<attn_body::CrossOrder, 256, 256, 256, 1, false>((char*)lds, AT, S, 0.f);
#endif
        if (BOTH(10)) GRID_BAR(); PROBE_END(10);
    }
    if (IN(11)) {
        pg8::Gemm g{OC, wsp<bf16>(F, WS_WCO), M, D, 256}; pg8::StaticOrder S; S.init(M, D, F.G, (int)blockIdx.x);
        pg8::EpiResid E{F.out, F.out, HB16, SS4, 1.0f, D};
        pg8::gemm_phase<pg8::EpiResid, pg8::StaticOrder, true, true>(F.lds, g, S, E);
        if (BOTH(11)) GRID_BAR(); PROBE_END(11);
    }
    if (IN(12)) {
        pg8::Gemm g{HB16, wsp<bf16>(F, WS_W2GU), M, 2 * FF, D}; pg8::StaticOrder S; S.init(M, 2 * FF, F.G, (int)blockIdx.x);
        pg8::EpiSwiGLU E{HH, FF, SS4, 1};
        pg8::gemm_phase<pg8::EpiSwiGLU, pg8::StaticOrder, true, true>(F.lds, g, S, E);
        if (BOTH(12)) GRID_BAR(); PROBE_END(12);
    }
    if (IN(13)) {
        pg8::Gemm g{HH, wsp<bf16>(F, WS_W2D), M, D, FF}; pg8::StaticOrder S; S.init(M, D, F.G, (int)blockIdx.x);
        pg8::EpiResid E{F.out, F.out, nullptr, nullptr, 0.5f, D};
        pg8::gemm_phase<pg8::EpiResid, pg8::StaticOrder, true, true>(F.lds, g, S, E);
        if (BOTH(13)) GRID_BAR(); PROBE_END(13);
    }
    if (IN(14)) { p_final(F); PROBE_END(14); }
#if defined(MK_PROBE_MASK)
    if (blockIdx.x == 0) {
        if (F.tid == 0) { const unsigned long long t0 = __builtin_amdgcn_s_memrealtime(); while (__builtin_amdgcn_s_memrealtime() - t0 < (unsigned long long)MK_PROBE_AMP * pr_acc) __builtin_amdgcn_s_sleep(8); }
        __syncthreads();
    }
#endif
#undef IN
#undef BOTH
}

extern "C" void kernel_launch(void* const* d_in, const int* in_sizes, int n_in, void* d_out, int out_size, void* d_ws, size_t ws_size, hipStream_t stream) {
    static int grid = 0;
    if (grid == 0) {
        if (n_in != 24 || in_sizes[0] != M * D || out_size != M * D || ws_size < WS_END) {
            fprintf(stderr, "kernel_launch: unexpected shapes: n_in %d in0 %d out %d ws %zu (need %zu)\n", n_in, n_in > 0 ? in_sizes[0] : -1, out_size, ws_size, (size_t)WS_END); grid = -1; return; }
        int dev = 0, cus = 0, per_cu = 0;
        if (hipGetDevice(&dev) != hipSuccess || hipDeviceGetAttribute(&cus, hipDeviceAttributeMultiprocessorCount, dev) != hipSuccess) { grid = -1; return; }
        if (hipFuncSetAttribute((const void*)mk_fwd, hipFuncAttributeMaxDynamicSharedMemorySize, LDS_BYTES) != hipSuccess) { fprintf(stderr, "kernel_launch: hipFuncSetAttribute failed\n"); grid = -1; return; }
        if (hipOccupancyMaxActiveBlocksPerMultiprocessor(&per_cu, (const void*)mk_fwd, NWAVES * 64, LDS_BYTES) != hipSuccess || per_cu < 1) { fprintf(stderr, "kernel_launch: occupancy query says %d\n", per_cu); }
        (void)hipGetLastError();
        grid = cus * (per_cu < 1 ? 1 : 1);
        if (per_cu < 1) { grid = -1; return; }
        if (grid != 256) fprintf(stderr, "kernel_launch: %d CUs (built for 256)\n", grid);
    }
    if (grid < 0) return;
    (void)hipMemsetAsync((char*)d_ws + WS_CTL, 0, CTL_ZERO_BYTES, stream);
    Args a{};
    for (int i = 0; i < 24; ++i) a.in[i] = (const float*)d_in[i];
    a.out = (float*)d_out; a.ws = (unsigned char*)d_ws;
#if defined(MK_MULTI)
    for (int ph = 0; ph < N_PHASES; ++ph) {
        a.ph_lo = ph; a.ph_hi = ph + 1;
        hipLaunchKernelGGL(mk_fwd, dim3(grid), dim3(NWAVES * 64), LDS_BYTES, stream, a);
    }
#else
    a.ph_lo = 0; a.ph_hi = N_PHASES;
    void* kargs[] = {&a};
    const hipError_t e = hipLaunchCooperativeKernel((const void*)mk_fwd, dim3(grid), dim3(NWAVES * 64), kargs, LDS_BYTES, stream);
    if (e != hipSuccess) fprintf(stderr, "kernel_launch: cooperative launch failed: %s (grid %d)\n", hipGetErrorString(e), grid);
#endif
}
```
